# Optimizing an MI355X kernel written in HIP

```python
import math
import jax, jax.numpy as jnp
from jax import lax
import numpy as np

D_MODEL = 1024
BATCH = 16
SEQ = 4096
DEPTH = 1

H_A = 8
KV_A = 2
REP_A = H_A // KV_A
HD_A = 64
D_A = H_A * HD_A
IDX_H = 8
IDX_D = 64
TOPK_MAX = 256
H_B = 8
D_NOPE = 64
D_ROPE = 32
V_B = 64
Q_LORA = 384
KV_LORA = 256
D_B = H_B * V_B
D_MIX = D_A + D_B
ROPE_THETA = 10000.0
Q_BLOCK = 128
DEEPNORM_ALPHA = (2.0 * DEPTH) ** 0.25
DEEPNORM_BETA = (8.0 * DEPTH) ** -0.25
NEG_INF = -1e30

IN_SIZES = (
    D_A,
    KV_A * HD_A,
    KV_A * HD_A,
    IDX_H * IDX_D,
    IDX_D,
    IDX_H,
    Q_LORA,
    KV_LORA,
    D_ROPE,
    D_MIX,
)
D_IN = sum(IN_SIZES)

kernel_name = "hybrid_dsa_mla_gated_deepnorm"


def _rms(x, g, eps=1e-6):
    xf = x.astype(jnp.float32)
    y = xf * lax.rsqrt(jnp.mean(xf * xf, axis=-1, keepdims=True) + eps)
    return y.astype(x.dtype) * g


def _layernorm(x, g, b, eps=1e-5):
    xf = x.astype(jnp.float32)
    mu = jnp.mean(xf, axis=-1, keepdims=True)
    var = jnp.mean(jnp.square(xf - mu), axis=-1, keepdims=True)
    return ((xf - mu) * lax.rsqrt(var + eps)).astype(x.dtype) * g + b


def _rope(x, cos, sin):
    half = x.shape[-1] // 2
    x1, x2 = x[..., :half], x[..., half:]
    return jnp.concatenate([x1 * cos - x2 * sin, x1 * sin + x2 * cos], axis=-1).astype(x.dtype)


def _hybrid_layer(x, positions, w_in, g_q_lat, w_uq, g_kv_lat, w_ukv, g_out_a, g_out_b, w_out, ln_g, ln_b):
    B, S, _ = x.shape
    f32 = jnp.float32
    k_top = min(TOPK_MAX, S // 4)
    nb = S // Q_BLOCK

    proj = x @ w_in
    splits = [int(v) for v in np.cumsum(IN_SIZES)[:-1]]
    qa, ka, va, iq, ik, iw, cq, ckv, kr, z = jnp.split(proj, splits, axis=-1)

    q_a = qa.reshape(B, S, KV_A, REP_A, HD_A)
    k_a = ka.reshape(B, S, KV_A, HD_A)
    v_a = va.reshape(B, S, KV_A, HD_A)
    iq = iq.reshape(B, S, IDX_H, IDX_D)
    iw = iw * (IDX_H ** -0.5 * IDX_D ** -0.5)
    slopes = jnp.exp2(-8.0 * jnp.arange(1, H_A + 1, dtype=f32) / H_A).reshape(KV_A, REP_A)

    inv_freq = ROPE_THETA ** (-jnp.arange(0, D_ROPE, 2, dtype=f32) / D_ROPE)
    ang = positions.astype(f32)[..., None] * inv_freq
    cos, sin = jnp.cos(ang), jnp.sin(ang)
    q_b = (_rms(cq, g_q_lat) @ w_uq).reshape(B, S, H_B, D_NOPE + D_ROPE)
    q_nope = q_b[..., :D_NOPE]
    q_rope = _rope(q_b[..., D_NOPE:], cos[:, :, None, :], sin[:, :, None, :])
    kv_b = (_rms(ckv, g_kv_lat) @ w_ukv).reshape(B, S, H_B, D_NOPE + V_B)
    k_nope, v_b = kv_b[..., :D_NOPE], kv_b[..., D_NOPE:]
    k_rope = _rope(kr, cos, sin)
    scale_b = (D_NOPE + D_ROPE) ** -0.5
    s_idx = jnp.arange(S)

    def block(i):
        q0 = i * Q_BLOCK
        sl = lambda a: lax.dynamic_slice_in_dim(a, q0, Q_BLOCK, axis=1)
        t_idx = q0 + jnp.arange(Q_BLOCK)
        causal = s_idx[None, :] <= t_idx[:, None]

        rel = jax.nn.relu(jnp.einsum('bthd,bsd->bths', sl(iq), ik).astype(f32))
        isc = jnp.einsum('bths,bth->bts', rel, sl(iw).astype(f32))
        isc = jnp.where(causal[None], isc, NEG_INF)
        _, sel = lax.top_k(isc, k_top)
        valid = sel <= t_idx[None, :, None]
        k_g = jax.vmap(lambda a, idx: a[idx])(k_a, sel)
        v_g = jax.vmap(lambda a, idx: a[idx])(v_a, sel)
        pos_sel = jnp.take_along_axis(positions, sel.reshape(B, -1), axis=1).reshape(B, Q_BLOCK, k_top)
        dist = (sl(positions)[:, :, None] - pos_sel).astype(f32)
        sa = jnp.einsum('btgrd,btkgd->btgrk', sl(q_a), k_g).astype(f32) * (HD_A ** -0.5)
        sa = sa - slopes[None, None, :, :, None] * jnp.abs(dist)[:, :, None, None, :]
        sa = jnp.where(valid[:, :, None, None, :], sa, NEG_INF)
        pa = jax.nn.softmax(sa, axis=-1).astype(v_g.dtype)
        o_a = jnp.einsum('btgrk,btkgd->btgrd', pa, v_g).reshape(B, Q_BLOCK, D_A)

        sb = (jnp.einsum('bthd,bshd->bhts', sl(q_nope), k_nope)
              + jnp.einsum('bthd,bsd->bhts', sl(q_rope), k_rope)).astype(f32) * scale_b
        sb = jnp.where(causal[None, None], sb, NEG_INF)
        pb = jax.nn.softmax(sb, axis=-1).astype(v_b.dtype)
        o_b = jnp.einsum('bhts,bshd->bthd', pb, v_b).reshape(B, Q_BLOCK, D_B)
        return o_a, o_b

    o_a, o_b = lax.map(block, jnp.arange(nb))
    o_a = o_a.transpose(1, 0, 2, 3).reshape(B, S, D_A)
    o_b = o_b.transpose(1, 0, 2, 3).reshape(B, S, D_B)

    y = jnp.concatenate([_rms(o_a, g_out_a), _rms(o_b, g_out_b)], axis=-1) * jax.nn.silu(z)
    out = y @ w_out
    return _layernorm(DEEPNORM_ALPHA * x + out, ln_g, ln_b)


def setup_inputs(seed: int = 0) -> dict:
    key = jax.random.key(seed)
    ks = jax.random.split(key, 12)
    f32 = jnp.float32
    x = jax.random.normal(ks[0], (BATCH, SEQ, D_MODEL), f32)
    offsets = jax.random.randint(ks[1], (BATCH, 1), 0, 1024, dtype=jnp.int32)
    positions = offsets + jnp.arange(SEQ, dtype=jnp.int32)[None, :]
    off_v = IN_SIZES[0] + IN_SIZES[1]
    col_scale = jnp.ones((D_IN,), f32).at[off_v:off_v + IN_SIZES[2]].set(DEEPNORM_BETA)
    w_in = jax.random.normal(ks[2], (DEPTH, D_MODEL, D_IN), f32) * (D_MODEL ** -0.5) * col_scale
    g_q_lat = 1.0 + 0.01 * jax.random.normal(ks[3], (DEPTH, Q_LORA), f32)
    w_uq = jax.random.normal(ks[4], (DEPTH, Q_LORA, H_B * (D_NOPE + D_ROPE)), f32) * (Q_LORA ** -0.5)
    g_kv_lat = 1.0 + 0.01 * jax.random.normal(ks[5], (DEPTH, KV_LORA), f32)
    w_ukv = jax.random.normal(ks[6], (DEPTH, KV_LORA, H_B, D_NOPE + V_B), f32) * (KV_LORA ** -0.5)
    w_ukv = w_ukv.at[..., D_NOPE:].multiply(DEEPNORM_BETA).reshape(DEPTH, KV_LORA, H_B * (D_NOPE + V_B))
    g_out_a = 1.0 + 0.01 * jax.random.normal(ks[7], (DEPTH, D_A), f32)
    g_out_b = 1.0 + 0.01 * jax.random.normal(ks[8], (DEPTH, D_B), f32)
    w_out = jax.random.normal(ks[9], (DEPTH, D_MIX, D_MODEL), f32) * (D_MIX ** -0.5) * DEEPNORM_BETA
    ln_g = 1.0 + 0.01 * jax.random.normal(ks[10], (DEPTH, D_MODEL), f32)
    ln_b = 0.01 * jax.random.normal(ks[11], (DEPTH, D_MODEL), f32)
    return {"x": x, "positions": positions, "w_in": w_in, "g_q_lat": g_q_lat, "w_uq": w_uq,
            "g_kv_lat": g_kv_lat, "w_ukv": w_ukv, "g_out_a": g_out_a, "g_out_b": g_out_b,
            "w_out": w_out, "ln_g": ln_g, "ln_b": ln_b}


def reference(x, positions, w_in, g_q_lat, w_uq, g_kv_lat, w_ukv, g_out_a, g_out_b, w_out, ln_g, ln_b):
    h = x
    for l in range(DEPTH):
        h = _hybrid_layer(h, positions, w_in[l], g_q_lat[l], w_uq[l], g_kv_lat[l], w_ukv[l],
                          g_out_a[l], g_out_b[l], w_out[l], ln_g[l], ln_b[l])
    return h
```

```cpp
#include <hip/hip_runtime.h>
#include <hip/hip_cooperative_groups.h>
#include <cstdio>
#include <cstdint>
namespace cg = cooperative_groups;

#ifndef MK_N_LAUNCHES
#define MK_N_LAUNCHES 1
#endif

#define LAS __attribute__((address_space(3)))
typedef unsigned short bf16_t;
typedef short bf16x8 __attribute__((ext_vector_type(8)));
typedef short s16x4 __attribute__((ext_vector_type(4)));
typedef float f32x4 __attribute__((ext_vector_type(4)));
typedef float f32x2 __attribute__((ext_vector_type(2)));
typedef float f32x16 __attribute__((ext_vector_type(16)));
typedef unsigned u32x4 __attribute__((ext_vector_type(4)));
typedef unsigned u32x2 __attribute__((ext_vector_type(2)));

constexpr int NB = 16, S = 4096, M = NB * S, DM = 1024;
constexpr int NPROJ = 3072;
constexpr int C_QA = 0, C_KA = 512, C_VA = 640, C_IQ = 768, C_CQ = 1280, C_CKV = 1664, C_IK = 1920, C_KR = 1984, C_IW = 2016, C_Z = 2048;
constexpr int D_IN = 3048;
constexpr int NQB = 768, NKVB = 1024;
constexpr float LOG2E = 1.4426950408889634f;
constexpr float QA_SCALE = 0.125f * LOG2E;
constexpr float QB_SCALE = 0.10206207261596577f * LOG2E;
constexpr float IW_SCALE = 0.04419417382415922f;
constexpr float DN_ALPHA = 1.189207115002721f;
constexpr int KTOP = 256;

constexpr size_t MiB = 1u << 20;
constexpr size_t WS_W1T = 1 * MiB, WS_WUQT = 7 * MiB, WS_WUKVT = 8 * MiB, WS_WOT = 9 * MiB, WS_CS = 11 * MiB, WS_SSQ = 19 * MiB, WS_POSF = 25 * MiB,
                 WS_OSS = 26 * MiB, WS_STATS = 30 * MiB, WS_XB = 64 * MiB, WS_PROJ = 192 * MiB, WS_QB = 576 * MiB, WS_KVB = 672 * MiB, WS_MASK = 800 * MiB, WS_END = 832 * MiB;
constexpr size_t WS_OAB = WS_XB;
constexpr size_t WS_Y = WS_KVB;

constexpr int LDS_BYTES = 132096;

__device__ __forceinline__ unsigned cvt_pk_bf16(float lo, float hi) { unsigned r; asm volatile("v_cvt_pk_bf16_f32 %0, %1, %2" : "=v"(r) : "v"(lo), "v"(hi)); return r; }
__device__ __forceinline__ float bf_lo(unsigned u) { return __uint_as_float(u << 16); }
__device__ __forceinline__ float bf_hi(unsigned u) { return __uint_as_float(u & 0xffff0000u); }
__device__ __forceinline__ int crow(int r, int hi) { return (r & 3) + 8 * (r >> 2) + 4 * hi; }
__device__ __forceinline__ float silu_f(float v) { return v * __builtin_amdgcn_rcpf(1.0f + __builtin_amdgcn_exp2f(-v * LOG2E)); }
__device__ __forceinline__ void glds16(const void* g, LAS unsigned char* l) { __builtin_amdgcn_global_load_lds((const unsigned*)g, (LAS unsigned*)l, 16, 0, 0); }

namespace pg8 {
constexpr int BM = 256, BK = 64, HALF = 128, HTB = HALF * BK * 2, STAGE_BYTES = 8 * HTB, NXCD = 8, WGM = 8;
__host__ __device__ __forceinline__ int lds_byte(int r, int c) { const int st = (r >> 4) * 2 + (c >> 5), rr = r & 15, cc = c & 31, ob = rr * 64 + cc * 2; return st * 1024 + (ob ^ (((ob >> 9) & 1) << 5)); }
__host__ __device__ __forceinline__ void stage_rc(int b, int& R, int& C) { const int st = b / 1024, sb = b % 1024, swz = sb ^ (((sb >> 9) & 1) << 5); R = (st >> 1) * 16 + swz / 64; C = (st & 1) * 32 + (swz % 64) / 2; }
__host__ __device__ __forceinline__ int perm32(int rho) { const int n = rho >> 4, i = rho & 15; return 8 * (i >> 2) + 4 * n + (i & 3); }

struct Unit { int pm, pn; };
struct Gemm { const bf16_t* A; const bf16_t* Bt; int M, N, K, lda; };

struct StaticOrder {
    int nM, nN, nwg, G, c;
    __host__ __device__ void init(int M_, int N_, int G_, int c_) { nM = M_ / BM; nN = N_ / BM; nwg = nM * nN; G = G_; c = c_; }
    __host__ __device__ bool next(int i, Unit& u) const {
        const long L = (long)i * G + c; if (L >= nwg) return false;
        int wgid = (int)L; { const int q = nwg / NXCD, r = nwg % NXCD, xcd = wgid % NXCD, off = wgid / NXCD; wgid = (xcd < r ? xcd * (q + 1) : r * (q + 1) + (xcd - r) * q) + off; }
        const int nig = WGM * nN, gid = wgid / nig, fm = gid * WGM, gsz = (nM - fm) < WGM ? (nM - fm) : WGM;
        u.pm = fm + ((wgid % nig) % gsz); u.pn = (wgid % nig) / gsz; return true;
    }
};

template <class Epi>
__device__ __forceinline__ void gemm_phase(LAS unsigned char* lds, const Gemm g, const StaticOrder& S, const Epi& E) {
    const int tid = threadIdx.x, wid = __builtin_amdgcn_readfirstlane(tid >> 6), lane = tid & 63, wr = wid >> 2, wc = wid & 3, fr = lane & 15, fq = lane >> 4;
    const int K = g.K, nt = K / BK, lda = g.lda;
    unsigned voffA[2], voffB[2];
#pragma unroll
    for (int i = 0; i < 2; ++i) { int R, C; stage_rc(tid * 16 + i * 8192, R, C); const int Rb = Epi::PERM ? ((R & ~31) + perm32(R & 31)) : R;
        voffA[i] = (unsigned)(R * lda + C) * 2u; voffB[i] = (unsigned)(Rb * K + C) * 2u; }
    const size_t kstep = (size_t)(BK * 2);
    const size_t hstepA = (size_t)HALF * lda * 2, tstepA = 2 * hstepA;
    const size_t hstepB = (size_t)HALF * K * 2, tstepB = 2 * hstepB;
    const unsigned ldsw = (unsigned)wid * 1024u;
    const int aoff = lds_byte(wr * 64 + fr, fq * 8), boff = lds_byte(wc * 32 + fr, fq * 8);
#define PG8_SA(b, h) (((b) * 2 + (h)) * HTB)
#define PG8_SB(b, h) ((4 + (b) * 2 + (h)) * HTB)
#define PG8_STAGE(bufoff, gbase, voff) do { _Pragma("unroll") for (int _i = 0; _i < 2; ++_i) \
        __builtin_amdgcn_global_load_lds((const unsigned*)((const char*)(gbase) + (voff)[_i]), (LAS unsigned*)(lds + (bufoff) + ldsw + _i * 8192), 16, 0, 0); } while (0)
#define PG8_LDA(dst, b, h) do { _Pragma("unroll") for (int m = 0; m < 4; ++m) _Pragma("unroll") for (int k = 0; k < 2; ++k) dst[m][k] = *(const LAS bf16x8*)(lds + PG8_SA(b, h) + aoff + m * 2048 + k * 1024); } while (0)
#define PG8_LDB(dst, b, h) do { _Pragma("unroll") for (int n = 0; n < 2; ++n) _Pragma("unroll") for (int k = 0; k < 2; ++k) dst[n][k] = *(const LAS bf16x8*)(lds + PG8_SB(b, h) + boff + n * 2048 + k * 1024); } while (0)
#define PG8_MMA(ai, bj, At, Bt) do { __builtin_amdgcn_s_setprio(1); _Pragma("unroll") for (int m = 0; m < 4; ++m) _Pragma("unroll") for (int n = 0; n < 2; ++n) _Pragma("unroll") for (int k = 0; k < 2; ++k) \
        acc[ai][bj][m][n] = __builtin_amdgcn_mfma_f32_16x16x32_bf16(Bt[n][k], At[m][k], acc[ai][bj][m][n], 0, 0, 0); __builtin_amdgcn_s_setprio(0); } while (0)
#define PG8_WAIT_V(n) asm volatile("s_waitcnt vmcnt(" #n ")" ::: "memory")
#define PG8_WAIT_L(n) asm volatile("s_waitcnt lgkmcnt(" #n ")" ::: "memory")
#define PG8_BAR __builtin_amdgcn_s_barrier()
#define PG8_SCHED __builtin_amdgcn_sched_barrier(0)
    Unit cur, nxt; int ui = 0;
    if (!S.next(0, cur)) return;
    f32x4 acc[2][2][4][2];
#pragma unroll
    for (int a = 0; a < 2; ++a)
#pragma unroll
        for (int b = 0; b < 2; ++b)
#pragma unroll
            for (int m = 0; m < 4; ++m)
#pragma unroll
                for (int n = 0; n < 2; ++n) acc[a][b][m][n] = (f32x4){0.f, 0.f, 0.f, 0.f};
    bf16x8 At[4][2], B0[2][2], B1[2][2];
    const char* cA = (const char*)g.A + (size_t)cur.pm * tstepA; const char* cB = (const char*)g.Bt + (size_t)cur.pn * tstepB;
    PG8_STAGE(PG8_SB(0, 0), cB, voffB); PG8_STAGE(PG8_SB(0, 1), cB + hstepB, voffB); PG8_STAGE(PG8_SA(0, 0), cA, voffA); PG8_STAGE(PG8_SA(0, 1), cA + hstepA, voffA);
    if (wr == 1) PG8_BAR;
    PG8_WAIT_V(2); PG8_BAR;
    PG8_STAGE(PG8_SB(1, 0), cB + kstep, voffB); PG8_STAGE(PG8_SA(1, 0), cA + kstep, voffA); PG8_STAGE(PG8_SB(1, 1), cB + hstepB + kstep, voffB);
    PG8_WAIT_V(6); PG8_BAR;
    for (;;) {
        const bool has_next = S.next(ui + 1, nxt);
        const char* nA = has_next ? (const char*)g.A + (size_t)nxt.pm * tstepA : cA; const char* nB = has_next ? (const char*)g.Bt + (size_t)nxt.pn * tstepB : cB;
        for (int t = 0; t < nt; t += 2) {
            const bool last = (t == nt - 2);
            const char* a1 = cA + (size_t)(t + 1) * kstep;
            const char* a2 = last ? nA : cA + (size_t)(t + 2) * kstep; const char* b2 = last ? nB : cB + (size_t)(t + 2) * kstep;
            const char* a3 = a2 + kstep; const char* b3 = b2 + kstep;
            PG8_LDB(B0, 0, 0); PG8_LDB(B1, 0, 1); PG8_SCHED; PG8_LDA(At, 0, 0); PG8_STAGE(PG8_SA(1, 1), a1 + hstepA, voffA);
            PG8_WAIT_V(8); PG8_WAIT_L(0); PG8_BAR; PG8_MMA(0, 0, At, B0); PG8_MMA(0, 1, At, B1); PG8_BAR; PG8_SCHED;
            PG8_LDA(At, 0, 1); PG8_STAGE(PG8_SB(0, 0), b2, voffB); PG8_STAGE(PG8_SB(0, 1), b2 + hstepB, voffB); PG8_STAGE(PG8_SA(0, 0), a2, voffA);
            PG8_WAIT_V(8); PG8_WAIT_L(0); PG8_BAR; PG8_MMA(1, 0, At, B0); PG8_MMA(1, 1, At, B1); PG8_BAR; PG8_SCHED;
            PG8_LDB(B0, 1, 0); PG8_LDB(B1, 1, 1); PG8_SCHED; PG8_LDA(At, 1, 0); PG8_STAGE(PG8_SA(0, 1), a2 + hstepA, voffA);
            PG8_WAIT_V(8); PG8_WAIT_L(0); PG8_BAR; PG8_MMA(0, 0, At, B0); PG8_MMA(0, 1, At, B1); PG8_BAR; PG8_SCHED;
            PG8_LDA(At, 1, 1); PG8_STAGE(PG8_SB(1, 0), b3, voffB); PG8_STAGE(PG8_SB(1, 1), b3 + hstepB, voffB); PG8_STAGE(PG8_SA(1, 0), a3, voffA);
            PG8_WAIT_V(8); PG8_WAIT_L(0); PG8_BAR; PG8_MMA(1, 0, At, B0); PG8_MMA(1, 1, At, B1); PG8_BAR; PG8_SCHED;
        }
        if (wr == 0) PG8_BAR;
        E(acc, cur, wr, wc, fr, fq);
        if (!has_next) break;
#pragma unroll
        for (int a = 0; a < 2; ++a)
#pragma unroll
            for (int b = 0; b < 2; ++b)
#pragma unroll
                for (int m = 0; m < 4; ++m)
#pragma unroll
                    for (int n = 0; n < 2; ++n) acc[a][b][m][n] = (f32x4){0.f, 0.f, 0.f, 0.f};
        cur = nxt; cA = nA; cB = nB; ++ui;
        if (wr == 1) PG8_BAR;
    }
    PG8_WAIT_V(0);
    PG8_BAR;
#undef PG8_SA
#undef PG8_SB
#undef PG8_STAGE
#undef PG8_LDA
#undef PG8_LDB
#undef PG8_MMA
#undef PG8_WAIT_V
#undef PG8_WAIT_L
#undef PG8_BAR
#undef PG8_SCHED
}
}

__device__ __forceinline__ void rope8(f32x4& v0, f32x4& v1, const float* csrow, int fq) {
    const f32x4 c = *(const f32x4*)(csrow + 4 * fq), s = *(const f32x4*)(csrow + 16 + 4 * fq);
    const float a0 = v0[0] * c[0] - v0[1] * s[0], b0 = v0[0] * s[0] + v0[1] * c[0];
    const float a1 = v0[2] * c[1] - v0[3] * s[1], b1 = v0[2] * s[1] + v0[3] * c[1];
    const float a2 = v1[0] * c[2] - v1[1] * s[2], b2 = v1[0] * s[2] + v1[1] * c[2];
    const float a3 = v1[2] * c[3] - v1[3] * s[3], b3 = v1[2] * s[3] + v1[3] * c[3];
    v0 = (f32x4){a0, b0, a1, b1}; v1 = (f32x4){a2, b2, a3, b3};
}
__device__ __forceinline__ void store8(bf16_t* p, const f32x4& v0, const f32x4& v1) {
    u32x4 w; w.x = cvt_pk_bf16(v0[0], v0[1]); w.y = cvt_pk_bf16(v0[2], v0[3]); w.z = cvt_pk_bf16(v1[0], v1[1]); w.w = cvt_pk_bf16(v1[2], v1[3]);
    *(u32x4*)p = w;
}

struct EpiProj {
    static constexpr bool PERM = true;
    bf16_t* P; const float* cs; float* ssq;
    __device__ __forceinline__ void operator()(const f32x4 (&acc)[2][2][4][2], const pg8::Unit& u, int wr, int wc, int fr, int fq) const {
        const int row0 = u.pm * 256 + wr * 64 + fr, colt = u.pn * 256 + wc * 32 + 8 * fq, pn = u.pn;
#pragma unroll
        for (int ai = 0; ai < 2; ++ai)
#pragma unroll
            for (int m = 0; m < 4; ++m) {
                const int row = row0 + ai * 128 + m * 16; bf16_t* rowp = P + (size_t)row * NPROJ + colt;
#pragma unroll
                for (int bj = 0; bj < 2; ++bj) {
                    f32x4 v0 = acc[ai][bj][m][0], v1 = acc[ai][bj][m][1];
                    if (pn >= 8) {
#pragma unroll
                        for (int j = 0; j < 4; ++j) { v0[j] = silu_f(v0[j]); v1[j] = silu_f(v1[j]); }
                    } else if (pn >= 5) {
                        int slot = -1;
                        if (pn == 5) slot = bj * 4 + wc; else if (pn == 6) slot = (bj == 0) ? 8 + wc : 12 + wc; else if (bj == 0) slot = 16 + wc;
                        if (slot >= 0) {
                            float s = (v0[0] * v0[0] + v0[1] * v0[1]) + (v0[2] * v0[2] + v0[3] * v0[3]) + (v1[0] * v1[0] + v1[1] * v1[1]) + (v1[2] * v1[2] + v1[3] * v1[3]);
                            s += __shfl_xor(s, 16); s += __shfl_xor(s, 32);
                            if (fq == 0) ssq[(size_t)row * 20 + slot] = s;
                        } else if (wc == 2) rope8(v0, v1, cs + (size_t)row * 32, fq);
                    }
                    store8(rowp + bj * 128, v0, v1);
                }
            }
    }
};
struct EpiUp {
    static constexpr bool PERM = true;
    bf16_t* O; int ldc; const float* ssq; int slot0, nslot4; float invK; const float* cs; int rope_pn;
    __device__ __forceinline__ void operator()(const f32x4 (&acc)[2][2][4][2], const pg8::Unit& u, int wr, int wc, int fr, int fq) const {
        const int row0 = u.pm * 256 + wr * 64 + fr, colt = u.pn * 256 + wc * 32 + 8 * fq;
#pragma unroll
        for (int ai = 0; ai < 2; ++ai)
#pragma unroll
            for (int m = 0; m < 4; ++m) {
                const int row = row0 + ai * 128 + m * 16; bf16_t* rowp = O + (size_t)row * ldc + colt;
                float ss = 0.f;
                for (int q = 0; q < nslot4; ++q) { const f32x4 t = *(const f32x4*)(ssq + (size_t)row * 20 + slot0 + 4 * q); ss += (t[0] + t[1]) + (t[2] + t[3]); }
                const float rstd = __builtin_amdgcn_rsqf(ss * invK + 1e-6f);
#pragma unroll
                for (int bj = 0; bj < 2; ++bj) {
                    f32x4 v0 = acc[ai][bj][m][0] * rstd, v1 = acc[ai][bj][m][1] * rstd;
                    if (u.pn == rope_pn) rope8(v0, v1, cs + (size_t)row * 32, fq);
                    store8(rowp + bj * 128, v0, v1);
                }
            }
    }
};
struct EpiOut {
    static constexpr bool PERM = false;
    const float* x; float* out; float* stats;
    __device__ __forceinline__ void operator()(const f32x4 (&acc)[2][2][4][2], const pg8::Unit& u, int wr, int wc, int fr, int fq) const {
        const int row0 = u.pm * 256 + wr * 64 + fr, col0 = u.pn * 256 + wc * 32 + 4 * fq;
#pragma unroll
        for (int ai = 0; ai < 2; ++ai)
#pragma unroll
            for (int m = 0; m < 4; ++m) {
                const int row = row0 + ai * 128 + m * 16; const size_t off = (size_t)row * DM + col0;
                float s = 0.f, q = 0.f;
#pragma unroll
                for (int bj = 0; bj < 2; ++bj)
#pragma unroll
                    for (int n = 0; n < 2; ++n) {
                        const f32x4 xv = *(const f32x4*)(x + off + bj * 128 + n * 16);
                        const f32x4 v = xv * DN_ALPHA + acc[ai][bj][m][n];
                        s += (v[0] + v[1]) + (v[2] + v[3]); q += (v[0] * v[0] + v[1] * v[1]) + (v[2] * v[2] + v[3] * v[3]);
                        *(f32x4*)(out + off + bj * 128 + n * 16) = v;
                    }
                s += __shfl_xor(s, 16); s += __shfl_xor(s, 32); q += __shfl_xor(q, 16); q += __shfl_xor(q, 32);
                if (fq == 0) *(f32x2*)(stats + (size_t)row * 32 + (u.pn * 4 + wc) * 2) = (f32x2){s, q};
            }
    }
};

constexpr int AT_KBYTES = 12288, AT_BUF = 20480;
__device__ __forceinline__ s16x4 vtr(const LAS unsigned char* p) {
    typedef short v4i16_t __attribute__((ext_vector_type(4)));
    return __builtin_bit_cast(s16x4, __builtin_amdgcn_ds_read_tr16_b64_v4i16((LAS v4i16_t*)p));
}
#define AT_SYNC() do { asm volatile("s_waitcnt vmcnt(0) lgkmcnt(0)" ::: "memory"); __syncthreads(); } while (0)

__device__ __forceinline__ void pv_tile(f32x16 (&oT)[2], const f32x16& p0, const f32x16& p1, const LAS unsigned char* vbase) {
    u32x4 pw[4];
#pragma unroll
    for (int s = 0; s < 4; ++s) {
        const f32x16& p = (s < 2) ? p0 : p1; const int o = 8 * (s & 1);
        pw[s] = (u32x4){cvt_pk_bf16(p[o], p[o + 1]), cvt_pk_bf16(p[o + 2], p[o + 3]), cvt_pk_bf16(p[o + 4], p[o + 5]), cvt_pk_bf16(p[o + 6], p[o + 7])};
    }
#pragma unroll
    for (int d0 = 0; d0 < 2; ++d0)
#pragma unroll
        for (int s = 0; s < 4; ++s) {
            const s16x4 lo = vtr(vbase + d0 * 4096 + s * 1024), hi = vtr(vbase + d0 * 4096 + s * 1024 + 512);
            const bf16x8 vf = (bf16x8){lo[0], lo[1], lo[2], lo[3], hi[0], hi[1], hi[2], hi[3]};
            oT[d0] = __builtin_amdgcn_mfma_f32_32x32x16_bf16(vf, __builtin_bit_cast(bf16x8, pw[s]), oT[d0], 0, 0, 0);
        }
}
__device__ __forceinline__ void softmax_tile(f32x16& p0, f32x16& p1, f32x16 (&oT)[2], float& m, float& l) {
    float mx = p0[0];
#pragma unroll
    for (int r = 1; r < 16; ++r) mx = fmaxf(mx, p0[r]);
#pragma unroll
    for (int r = 0; r < 16; ++r) mx = fmaxf(mx, p1[r]);
    mx = fmaxf(mx, __shfl_xor(mx, 32));
    const float mnew = fmaxf(m, mx);
    const float msafe = (mnew == -INFINITY) ? 0.f : mnew;
    const float f = __builtin_amdgcn_exp2f(m - msafe);
    m = mnew;
    float sum = 0.f;
#pragma unroll
    for (int r = 0; r < 16; ++r) { p0[r] = __builtin_amdgcn_exp2f(p0[r] - msafe); p1[r] = __builtin_amdgcn_exp2f(p1[r] - msafe); sum += p0[r] + p1[r]; }
    l = l * f + sum;
#pragma unroll
    for (int d0 = 0; d0 < 2; ++d0)
#pragma unroll
        for (int r = 0; r < 16; ++r) oT[d0][r] *= f;
}
__device__ __forceinline__ void attn_store(const f32x16 (&oT)[2], float l, bf16_t* orow, float* ossp, int hi) {
    l += __shfl_xor(l, 32);
    const float inv = 1.0f / l;
    float ssq = 0.f;
#pragma unroll
    for (int d0 = 0; d0 < 2; ++d0)
#pragma unroll
        for (int c = 0; c < 4; ++c) {
            const float a = oT[d0][4 * c] * inv, b = oT[d0][4 * c + 1] * inv, cc = oT[d0][4 * c + 2] * inv, d = oT[d0][4 * c + 3] * inv;
            ssq += (a * a + b * b) + (cc * cc + d * d);
            *(u32x2*)(orow + 32 * d0 + 8 * c + 4 * hi) = (u32x2){cvt_pk_bf16(a, b), cvt_pk_bf16(cc, d)};
        }
    ssq += __shfl_xor(ssq, 32);
    if (hi == 0) *ossp = ssq;
}

__device__ __forceinline__ void mla_unit(int b, int h, int qb, const bf16_t* QB, const bf16_t* KVB, const bf16_t* PROJ, bf16_t* OAB, float* OSS, LAS unsigned char* lds) {
    const int tid = threadIdx.x, lane = tid & 63, r32 = lane & 31, hi = lane >> 5, wid = __builtin_amdgcn_readfirstlane(tid >> 6);
    const size_t rowbase = (size_t)b * S; const int q0 = qb * 256, tq = q0 + wid * 32 + r32;
    const int NT = 4 * (qb + 1);
    const bf16_t* ksrc = KVB + (rowbase + lane) * NKVB + h * 64 + wid * 8;
    const bf16_t* rsrc = PROJ + (rowbase + lane) * NPROJ + C_KR + (wid & 3) * 8;
    const bf16_t* vsrc = KVB + (rowbase + 16 * (wid & 3) + (lane >> 2)) * NKVB + 512 + h * 64 + (wid >> 2) * 32 + (lane & 3) * 8;
#define MLA_DMA(kt, bsel) do { LAS unsigned char* _b = lds + (bsel) * AT_BUF; glds16(ksrc + (size_t)(kt) * 64 * NKVB, _b + wid * 1024); \
        if (wid >= 4) glds16(rsrc + (size_t)(kt) * 64 * NPROJ, _b + (8 + (wid & 3)) * 1024); \
        glds16(vsrc + (size_t)(kt) * 64 * NKVB, _b + AT_KBYTES + (wid >> 2) * 4096 + (wid & 3) * 1024); } while (0)
    MLA_DMA(0, 0);
    bf16x8 qf[6];
    { const bf16_t* qrow = QB + (rowbase + tq) * NQB;
#pragma unroll
      for (int d0 = 0; d0 < 4; ++d0) qf[d0] = *(const bf16x8*)(qrow + h * 64 + d0 * 16 + hi * 8);
#pragma unroll
      for (int d0 = 4; d0 < 6; ++d0) qf[d0] = *(const bf16x8*)(qrow + 512 + h * 32 + (d0 - 4) * 16 + hi * 8); }
    float m = -INFINITY, l = 0.f; f32x16 oT[2]; oT[0] = f32x16{}; oT[1] = f32x16{};
    const int vboff = ((lane >> 4) & 1) * 32 + (lane & 3) * 8 + (4 * hi + ((lane & 15) >> 2)) * 64;
    AT_SYNC();
    for (int kt = 0; kt < NT; ++kt) {
        const int cur = kt & 1;
        if (kt + 1 < NT) MLA_DMA(kt + 1, cur ^ 1);
        const LAS unsigned char* kb = lds + cur * AT_BUF + hi * 1024 + r32 * 16;
        f32x16 p0 = f32x16{}, p1 = f32x16{};
#pragma unroll
        for (int d0 = 0; d0 < 6; ++d0) {
            const bf16x8 a0 = *(const LAS bf16x8*)(kb + d0 * 2048), a1 = *(const LAS bf16x8*)(kb + d0 * 2048 + 512);
            p0 = __builtin_amdgcn_mfma_f32_32x32x16_bf16(a0, qf[d0], p0, 0, 0, 0);
            p1 = __builtin_amdgcn_mfma_f32_32x32x16_bf16(a1, qf[d0], p1, 0, 0, 0);
        }
        if (kt >= NT - 4) {
            const int kb0 = kt * 64 + 4 * hi;
#pragma unroll
            for (int r = 0; r < 16; ++r) { const int ks = kb0 + (r & 3) + 8 * (r >> 2); if (ks > tq) p0[r] = -INFINITY; if (ks + 32 > tq) p1[r] = -INFINITY; }
        }
        softmax_tile(p0, p1, oT, m, l);
        pv_tile(oT, p0, p1, lds + cur * AT_BUF + AT_KBYTES + vboff);
        AT_SYNC();
    }
#undef MLA_DMA
    attn_store(oT, l, OAB + (rowbase + tq) * DM + 512 + h * 64, OSS + (rowbase + tq) * 16 + 8 + h, hi);
}

__device__ __forceinline__ void dsa_unit(int b, int g, int qb, const bf16_t* PROJ, const unsigned long long* MASK, const float* POSF, bf16_t* OAB, float* OSS, LAS unsigned char* lds) {
    const int tid = threadIdx.x, lane = tid & 63, r32 = lane & 31, hi = lane >> 5, wid = __builtin_amdgcn_readfirstlane(tid >> 6);
    const size_t rowbase = (size_t)b * S; const int q0 = qb * 64, tq = q0 + wid * 8 + (r32 >> 2), head = 4 * g + (r32 & 3);
    const int NT = qb + 1;
    const bf16_t* ksrc = PROJ + (rowbase + lane) * NPROJ + C_KA + g * 64 + wid * 8;
    const bf16_t* vsrc = PROJ + (rowbase + 16 * (wid & 3) + (lane >> 2)) * NPROJ + C_VA + g * 64 + (wid >> 2) * 32 + (lane & 3) * 8;
#define DSA_DMA(kt, bsel) do { LAS unsigned char* _b = lds + (bsel) * AT_BUF; glds16(ksrc + (size_t)(kt) * 64 * NPROJ, _b + wid * 1024); \
        glds16(vsrc + (size_t)(kt) * 64 * NPROJ, _b + AT_KBYTES + (wid >> 2) * 4096 + (wid & 3) * 1024); } while (0)
    DSA_DMA(0, 0);
    bf16x8 qf[4];
    { const bf16_t* qrow = PROJ + (rowbase + tq) * NPROJ + C_QA + head * 64;
#pragma unroll
      for (int d0 = 0; d0 < 4; ++d0) qf[d0] = *(const bf16x8*)(qrow + d0 * 16 + hi * 8); }
    const float pt = POSF[rowbase + tq];
    const float nslope = -__builtin_amdgcn_exp2f(-(float)(head + 1)) * LOG2E;
    const unsigned long long* mrow = MASK + (rowbase + tq) * 64;
    float m = -INFINITY, l = 0.f; f32x16 oT[2]; oT[0] = f32x16{}; oT[1] = f32x16{};
    const int vboff = ((lane >> 4) & 1) * 32 + (lane & 3) * 8 + (4 * hi + ((lane & 15) >> 2)) * 64;
    AT_SYNC();
    for (int kt = 0; kt < NT; ++kt) {
        const int cur = kt & 1;
        if (kt + 1 < NT) DSA_DMA(kt + 1, cur ^ 1);
        const unsigned long long mw = mrow[kt];
        const float* pk = POSF + rowbase + kt * 64 + 4 * hi;
        const LAS unsigned char* kb = lds + cur * AT_BUF + hi * 1024 + r32 * 16;
        f32x16 p0 = f32x16{}, p1 = f32x16{};
#pragma unroll
        for (int d0 = 0; d0 < 4; ++d0) {
            const bf16x8 a0 = *(const LAS bf16x8*)(kb + d0 * 2048), a1 = *(const LAS bf16x8*)(kb + d0 * 2048 + 512);
            p0 = __builtin_amdgcn_mfma_f32_32x32x16_bf16(a0, qf[d0], p0, 0, 0, 0);
            p1 = __builtin_amdgcn_mfma_f32_32x32x16_bf16(a1, qf[d0], p1, 0, 0, 0);
        }
        const unsigned w0 = (unsigned)mw >> (4 * hi), w1 = (unsigned)(mw >> 32) >> (4 * hi);
#pragma unroll
        for (int c = 0; c < 4; ++c) {
            const f32x4 k0 = *(const f32x4*)(pk + 8 * c), k1 = *(const f32x4*)(pk + 32 + 8 * c);
#pragma unroll
            for (int j = 0; j < 4; ++j) {
                const int r = 4 * c + j;
                const float s0 = __builtin_fmaf(nslope, __builtin_fabsf(pt - k0[j]), p0[r]), s1 = __builtin_fmaf(nslope, __builtin_fabsf(pt - k1[j]), p1[r]);
                p0[r] = ((w0 >> (8 * c + j)) & 1u) ? s0 : -INFINITY;
                p1[r] = ((w1 >> (8 * c + j)) & 1u) ? s1 : -INFINITY;
            }
        }
        softmax_tile(p0, p1, oT, m, l);
        pv_tile(oT, p0, p1, lds + cur * AT_BUF + AT_KBYTES + vboff);
        AT_SYNC();
    }
#undef DSA_DMA
    attn_store(oT, l, OAB + (rowbase + tq) * DM + head * 64, OSS + (rowbase + tq) * 16 + head, hi);
}

__device__ __forceinline__ void select_row(int t, const LAS float* sc, unsigned long long* mrow, int lane) {
    const int n = t + 1;
    if (n <= KTOP) {
        const int cnt = n - 64 * lane;
        mrow[lane] = cnt >= 64 ? ~0ull : (cnt <= 0 ? 0ull : ((1ull << cnt) - 1ull));
        return;
    }
    const int nreg = (n + 63) >> 6;
    unsigned ku[64];
#pragma unroll
    for (int i = 0; i < 64; ++i) {
        ku[i] = 0u;
        if (i < nreg) { const int idx = 64 * i + lane; const float x = sc[idx] + 0.0f; const unsigned u = __float_as_uint(x); const unsigned k = u ^ ((unsigned)((int)u >> 31) | 0x80000000u); ku[i] = idx < n ? k : 0u; }
    }
#define SEL_CNT16(base, OP, V) _Pragma("unroll") for (int i = (base); i < (base) + 16; ++i) c += __popcll(__ballot(ku[i] OP (V)));
#define SEL_COUNT(OP, V) do { c = 0; SEL_CNT16(0, OP, V) if (nreg > 16) { SEL_CNT16(16, OP, V) } if (nreg > 32) { SEL_CNT16(32, OP, V) } if (nreg > 48) { SEL_CNT16(48, OP, V) } } while (0)
    unsigned T = 0u; bool exact = false; int c;
#pragma unroll 1
    for (int bit = 31; bit >= 0; --bit) {
        const unsigned cand = T | (1u << bit);
        SEL_COUNT(>=, cand);
        if (c >= KTOP) { T = cand; if (c == KTOP) { exact = true; break; } }
    }
    unsigned long long myw = 0ull;
    if (exact) {
#pragma unroll
        for (int i = 0; i < 64; ++i) { const unsigned long long mk = __ballot(ku[i] >= T); if (lane == i) myw = mk; }
    } else {
        SEL_COUNT(>, T);
        int need = KTOP - c;
#pragma unroll
        for (int i = 0; i < 64; ++i) {
            unsigned long long mk = __ballot(ku[i] > T); const unsigned long long e = __ballot(ku[i] == T);
            const int pe = __popcll(e);
            if (pe <= need) { mk |= e; need -= pe; }
            else { const int rank = __popcll(e & ((1ull << lane) - 1ull)); mk |= __ballot(((e >> lane) & 1ull) && rank < need); need = 0; }
            if (lane == i) myw = mk;
        }
    }
#undef SEL_COUNT
#undef SEL_CNT16
    mrow[lane] = myw;
}

__device__ __forceinline__ void idx_unit(int b, int j, const bf16_t* PROJ, unsigned long long* MASK, LAS unsigned char* lds) {
    const int tid = threadIdx.x, lane = tid & 63, r32 = lane & 31, hi = lane >> 5, wid = __builtin_amdgcn_readfirstlane(tid >> 6);
    const size_t rowbase = (size_t)b * S; const int t0 = 8 * j;
    LAS float* SC = (LAS float*)lds;
    if (t0 + 8 > KTOP) {
        const int qi = 2 * ((r32 >> 2) & 1) + (r32 >> 4), hd = (r32 & 3) + 4 * ((r32 >> 3) & 1);
        bf16x8 af[2][4];
#pragma unroll
        for (int mt = 0; mt < 2; ++mt) { const bf16_t* qrow = PROJ + (rowbase + t0 + 4 * mt + qi) * NPROJ + C_IQ + hd * 64 + hi * 8;
#pragma unroll
            for (int d0 = 0; d0 < 4; ++d0) af[mt][d0] = *(const bf16x8*)(qrow + d0 * 16); }
        float w[2][2][8];
#pragma unroll
        for (int mt = 0; mt < 2; ++mt)
#pragma unroll
            for (int e = 0; e < 2; ++e) { const u32x4 wv = *(const u32x4*)(PROJ + (rowbase + t0 + 4 * mt + 2 * hi + e) * NPROJ + C_IW);
                w[mt][e][0] = bf_lo(wv.x); w[mt][e][1] = bf_hi(wv.x); w[mt][e][2] = bf_lo(wv.y); w[mt][e][3] = bf_hi(wv.y);
                w[mt][e][4] = bf_lo(wv.z); w[mt][e][5] = bf_hi(wv.z); w[mt][e][6] = bf_lo(wv.w); w[mt][e][7] = bf_hi(wv.w); }
        const int NT32 = (t0 + 8 + 31) >> 5;
        const bf16_t* kbase = PROJ + (rowbase + r32) * NPROJ + C_IK + hi * 8;
        bf16x8 bfr[4];
        if (wid < NT32) {
#pragma unroll
            for (int d0 = 0; d0 < 4; ++d0) bfr[d0] = *(const bf16x8*)(kbase + (size_t)wid * 32 * NPROJ + d0 * 16);
        }
        for (int kt = wid; kt < NT32; kt += 8) {
            bf16x8 bn[4];
            const int ktn = (kt + 8 < NT32) ? kt + 8 : kt;
#pragma unroll
            for (int d0 = 0; d0 < 4; ++d0) bn[d0] = *(const bf16x8*)(kbase + (size_t)ktn * 32 * NPROJ + d0 * 16);
            f32x16 a0 = f32x16{}, a1 = f32x16{};
#pragma unroll
            for (int d0 = 0; d0 < 4; ++d0) { a0 = __builtin_amdgcn_mfma_f32_32x32x16_bf16(af[0][d0], bfr[d0], a0, 0, 0, 0); a1 = __builtin_amdgcn_mfma_f32_32x32x16_bf16(af[1][d0], bfr[d0], a1, 0, 0, 0); }
#pragma unroll
            for (int mt = 0; mt < 2; ++mt)
#pragma unroll
                for (int e = 0; e < 2; ++e) {
                    float s = 0.f;
#pragma unroll
                    for (int h8 = 0; h8 < 8; ++h8) s = __builtin_fmaf(w[mt][e][h8], fmaxf(mt == 0 ? a0[8 * e + h8] : a1[8 * e + h8], 0.f), s);
                    SC[(4 * mt + 2 * hi + e) * 4096 + kt * 32 + r32] = s;
                }
#pragma unroll
            for (int d0 = 0; d0 < 4; ++d0) bfr[d0] = bn[d0];
        }
        asm volatile("s_waitcnt lgkmcnt(0)" ::: "memory");
        __syncthreads();
    }
    select_row(t0 + wid, SC + wid * 4096, MASK + (rowbase + t0 + wid) * 64, lane);
    asm volatile("s_waitcnt lgkmcnt(0)" ::: "memory");
    __syncthreads();
}

struct Args { const float* x; const int* pos; const float* w_in; const float* g_q; const float* w_uq; const float* g_kv; const float* w_ukv; const float* g_oa; const float* g_ob;
              const float* w_out; const float* ln_g; const float* ln_b; float* out; unsigned char* ws; int ph_lo, ph_hi; };

__device__ __forceinline__ void src_map(int kind, int n, int& src, float& sc) {
    sc = 1.f;
    if (kind == 0) {
        if (n < 512) { src = n; sc = QA_SCALE; }
        else if (n < 1280) src = n;
        else if (n < 1664) src = n - 1280 + 1352;
        else if (n < 1920) src = n - 1664 + 1736;
        else if (n < 1984) src = n - 1920 + 1280;
        else if (n < 2016) { const int e = n - 1984; src = 1992 + (e >> 1) + 16 * (e & 1); }
        else if (n < 2024) { src = n - 2016 + 1344; sc = IW_SCALE; }
        else if (n < 2048) src = -1;
        else src = n - 2048 + 2024;
    } else if (kind == 1) {
        if (n < 512) { const int h = n >> 6, d = n & 63; src = h * 96 + d; }
        else { const int e = n - 512, h = e >> 5, r = e & 31; src = h * 96 + 64 + (r >> 1) + 16 * (r & 1); }
        sc = QB_SCALE;
    } else if (kind == 2) {
        if (n < 512) { const int h = n >> 6, d = n & 63; src = h * 128 + d; }
        else { const int e = n - 512, h = e >> 6, d = e & 63; src = h * 128 + 64 + d; }
    } else src = n;
}
__device__ __forceinline__ void p0_transpose_item(const float* W, int K, int Nsrc, int Ndst, bf16_t* WT, int kind, const float* ks0, const float* ks1, LAS float* scr, int item, int lane) {
    const int nblk = Ndst / 32, kb = item / nblk, nb = item % nblk, k0 = 64 * kb, n0 = 32 * nb;
    int src; float sc; src_map(kind, n0 + (lane & 31), src, sc);
#pragma unroll 8
    for (int i = 0; i < 32; ++i) { const int kk = 2 * i + (lane >> 5), k = k0 + kk;
        float ksc = 1.f; if (ks0) ksc = (k < 512 || !ks1) ? ks0[k] : ks1[k - 512];
        scr[kk * 33 + (lane & 31)] = src >= 0 ? W[(size_t)k * Nsrc + src] * (sc * ksc) : 0.f; }
    asm volatile("s_waitcnt lgkmcnt(0)" ::: "memory");
    const int c = lane & 7;
#pragma unroll
    for (int jj = 0; jj < 4; ++jj) { const int n = (lane >> 3) + 8 * jj; const LAS float* s = scr + (8 * c) * 33 + n;
        u32x4 o; o.x = cvt_pk_bf16(s[0 * 33], s[1 * 33]); o.y = cvt_pk_bf16(s[2 * 33], s[3 * 33]); o.z = cvt_pk_bf16(s[4 * 33], s[5 * 33]); o.w = cvt_pk_bf16(s[6 * 33], s[7 * 33]);
        *(u32x4*)(WT + (size_t)(n0 + n) * K + k0 + 8 * c) = o; }
    asm volatile("s_waitcnt lgkmcnt(0)" ::: "memory");
}
__device__ __forceinline__ float wave_sum(float v) {
#pragma unroll
    for (int o = 1; o < 64; o <<= 1) v += __shfl_xor(v, o);
    return v;
}

__global__ void __launch_bounds__(512, 2) hybrid_fwd(Args a) {
    extern __shared__ __attribute__((aligned(16))) unsigned char lds_raw[];
    LAS unsigned char* lds = (LAS unsigned char*)lds_raw;
    const int tid = threadIdx.x, lane = tid & 63, wave = __builtin_amdgcn_readfirstlane(tid >> 6);
    const int G = gridDim.x, bx = blockIdx.x, vcu = (G % 8 == 0) ? (bx % 8) * (G / 8) + bx / 8 : bx;
    unsigned char* ws = a.ws;
    bf16_t* W1T = (bf16_t*)(ws + WS_W1T); bf16_t* WUQT = (bf16_t*)(ws + WS_WUQT); bf16_t* WUKVT = (bf16_t*)(ws + WS_WUKVT); bf16_t* WOT = (bf16_t*)(ws + WS_WOT);
    float* CS = (float*)(ws + WS_CS); float* SSQ = (float*)(ws + WS_SSQ); float* POSF = (float*)(ws + WS_POSF); float* OSS = (float*)(ws + WS_OSS); float* STATS = (float*)(ws + WS_STATS);
    bf16_t* XB = (bf16_t*)(ws + WS_XB); bf16_t* PROJ = (bf16_t*)(ws + WS_PROJ); bf16_t* QB = (bf16_t*)(ws + WS_QB); bf16_t* KVB = (bf16_t*)(ws + WS_KVB);
    unsigned long long* MASK = (unsigned long long*)(ws + WS_MASK); bf16_t* OAB = (bf16_t*)(ws + WS_OAB); bf16_t* Y = (bf16_t*)(ws + WS_Y);
    const int lo = a.ph_lo, hi_ph = a.ph_hi;
#define IN(k) (lo <= (k) && (k) < hi_ph)
#define SEAM(k) do { if (IN(k) && IN((k) + 1)) { cg::this_grid().sync(); } } while (0)
    const int gw = vcu * 8 + wave, NGW = G * 8;
    const size_t gt = (size_t)vcu * 512 + tid, NGT = (size_t)G * 512;

    if (IN(0)) {
        LAS float* scr = (LAS float*)(lds + wave * 16384);
        constexpr int I1 = (1024 / 64) * (NPROJ / 32), I2 = (384 / 64) * (NQB / 32), I3 = (256 / 64) * (NKVB / 32), I4 = (1024 / 64) * (1024 / 32);
        for (int it = gw; it < I1 + I2 + I3 + I4; it += NGW) {
            int r = it;
            if (r < I1) { p0_transpose_item(a.w_in, 1024, D_IN, NPROJ, W1T, 0, nullptr, nullptr, scr, r, lane); continue; } r -= I1;
            if (r < I2) { p0_transpose_item(a.w_uq, 384, NQB, NQB, WUQT, 1, a.g_q, nullptr, scr, r, lane); continue; } r -= I2;
            if (r < I3) { p0_transpose_item(a.w_ukv, 256, NKVB, NKVB, WUKVT, 2, a.g_kv, nullptr, scr, r, lane); continue; } r -= I3;
            p0_transpose_item(a.w_out, 1024, 1024, 1024, WOT, 3, a.g_oa, a.g_ob, scr, r, lane);
        }
        for (size_t c = gt; c < (size_t)M * 128; c += NGT) {
            const f32x4 v0 = *(const f32x4*)(a.x + c * 8), v1 = *(const f32x4*)(a.x + c * 8 + 4);
            *(u32x4*)(XB + c * 8) = (u32x4){cvt_pk_bf16(v0[0], v0[1]), cvt_pk_bf16(v0[2], v0[3]), cvt_pk_bf16(v1[0], v1[1]), cvt_pk_bf16(v1[2], v1[3])};
        }
        for (size_t i = gt; i < (size_t)M * 16; i += NGT) {
            const size_t t = i >> 4; const int k = (int)(i & 15);
            const float p = (float)a.pos[t];
            const float invf = exp2f(-(float)k * 0.8304820237218406f);
            const float ang = p * invf;
            const double ad = (double)ang;
            const double kk = rint(ad * 0.15915494309189535);
            const double r = fma(-kk, 6.283185307179586, ad) - kk * 2.4492935982947064e-16;
            const double r2 = r * r;
            double sn = -8.2206352466243297e-18; sn = fma(sn, r2, 2.8114572543455206e-15); sn = fma(sn, r2, -7.6471637318198165e-13); sn = fma(sn, r2, 1.6059043836821613e-10);
            sn = fma(sn, r2, -2.5052108385441720e-08); sn = fma(sn, r2, 2.7557319223985893e-06); sn = fma(sn, r2, -1.9841269841269841e-04); sn = fma(sn, r2, 8.3333333333333332e-03);
            sn = fma(sn, r2, -1.6666666666666666e-01); sn = fma(sn * r2, r, r);
            double cn = 4.1103176233121648e-19; cn = fma(cn, r2, -1.5619206968586226e-16); cn = fma(cn, r2, 4.7794773323873853e-14); cn = fma(cn, r2, -1.1470745597729725e-11);
            cn = fma(cn, r2, 2.0876756987868099e-09); cn = fma(cn, r2, -2.7557319223985888e-07); cn = fma(cn, r2, 2.4801587301587302e-05); cn = fma(cn, r2, -1.3888888888888889e-03);
            cn = fma(cn, r2, 4.1666666666666664e-02); cn = fma(cn, r2, -0.5); cn = fma(cn, r2, 1.0);
            CS[t * 32 + k] = (float)cn; CS[t * 32 + 16 + k] = (float)sn;
            if (k == 0) POSF[t] = p;
        }
    }
    SEAM(0);
    if (IN(1)) {
        pg8::Gemm g{XB, W1T, M, NPROJ, 1024, 1024}; pg8::StaticOrder So; So.init(M, NPROJ, G, bx);
        EpiProj E{PROJ, CS, SSQ};
        pg8::gemm_phase<EpiProj>(lds, g, So, E);
    }
    SEAM(1);
    if (IN(2)) {
        { pg8::Gemm g{PROJ + C_CQ, WUQT, M, NQB, 384, NPROJ}; pg8::StaticOrder So; So.init(M, NQB, G, bx);
          EpiUp E{QB, NQB, SSQ, 0, 3, 1.0f / 384.0f, CS, 2};
          pg8::gemm_phase<EpiUp>(lds, g, So, E); }
        { pg8::Gemm g{PROJ + C_CKV, WUKVT, M, NKVB, 256, NPROJ}; pg8::StaticOrder So; So.init(M, NKVB, G, bx);
          EpiUp E{KVB, NKVB, SSQ, 12, 2, 1.0f / 256.0f, CS, -1};
          pg8::gemm_phase<EpiUp>(lds, g, So, E); }
        __syncthreads();
        { const int b = vcu >> 4, s = vcu & 15;
          for (int i = 0; i < 32; ++i) { const int j = 16 * i + ((i & 1) ? 15 - s : s); idx_unit(b, j, PROJ, MASK, lds); } }
    }
    SEAM(2);
    if (IN(3)) {
        { const int bh = vcu >> 1, s = vcu & 1, b = bh >> 3, h = bh & 7;
          for (int i = 0; i < 4; ++i) { const int qa = 2 * i + s; mla_unit(b, h, 15 - qa, QB, KVB, PROJ, OAB, OSS, lds); mla_unit(b, h, qa, QB, KVB, PROJ, OAB, OSS, lds); } }
        { const int bg = vcu >> 3, s = vcu & 7, b = bg >> 1, g = bg & 1;
          for (int i = 0; i < 4; ++i) { const int qa = 8 * i + s; dsa_unit(b, g, 63 - qa, PROJ, MASK, POSF, OAB, OSS, lds); dsa_unit(b, g, qa, PROJ, MASK, POSF, OAB, OSS, lds); } }
    }
    SEAM(3);
    if (IN(4)) {
        for (size_t c = gt; c < (size_t)M * 128; c += NGT) {
            const size_t row = c >> 7; const int col = (int)(c & 127) * 8, grp = col >> 9;
            const f32x4 s0 = *(const f32x4*)(OSS + row * 16 + grp * 8), s1 = *(const f32x4*)(OSS + row * 16 + grp * 8 + 4);
            const float rstd = __builtin_amdgcn_rsqf(((s0[0] + s0[1]) + (s0[2] + s0[3]) + (s1[0] + s1[1]) + (s1[2] + s1[3])) * (1.0f / 512.0f) + 1e-6f);
            const u32x4 o = *(const u32x4*)(OAB + row * DM + col), z = *(const u32x4*)(PROJ + row * NPROJ + C_Z + col);
            u32x4 y;
            y.x = cvt_pk_bf16(bf_lo(o.x) * rstd * bf_lo(z.x), bf_hi(o.x) * rstd * bf_hi(z.x)); y.y = cvt_pk_bf16(bf_lo(o.y) * rstd * bf_lo(z.y), bf_hi(o.y) * rstd * bf_hi(z.y));
            y.z = cvt_pk_bf16(bf_lo(o.z) * rstd * bf_lo(z.z), bf_hi(o.z) * rstd * bf_hi(z.z)); y.w = cvt_pk_bf16(bf_lo(o.w) * rstd * bf_lo(z.w), bf_hi(o.w) * rstd * bf_hi(z.w));
            *(u32x4*)(Y + row * DM + col) = y;
        }
    }
    SEAM(4);
    if (IN(5)) {
        pg8::Gemm g{Y, WOT, M, DM, 1024, 1024}; pg8::StaticOrder So; So.init(M, DM, G, bx);
        EpiOut E{a.x, a.out, STATS};
        pg8::gemm_phase<EpiOut>(lds, g, So, E);
    }
    SEAM(5);
    if (IN(6)) {
        for (int row = gw; row < M; row += NGW) {
            float s = 0.f, q = 0.f;
            if (lane < 16) { const f32x2 t = *(const f32x2*)(STATS + (size_t)row * 32 + 2 * lane); s = t.x; q = t.y; }
            s = wave_sum(s); q = wave_sum(q);
            const float mean = s * (1.0f / DM), var = q * (1.0f / DM) - mean * mean, rstd = 1.0f / sqrtf(fmaxf(var, 0.f) + 1e-5f);
            float* orow = a.out + (size_t)row * DM;
#pragma unroll
            for (int jj = 0; jj < 4; ++jj) { const int col = jj * 256 + lane * 4;
                const f32x4 v = *(const f32x4*)(orow + col), gg = *(const f32x4*)(a.ln_g + col), bb = *(const f32x4*)(a.ln_b + col);
                *(f32x4*)(orow + col) = (v - mean) * rstd * gg + bb; }
        }
    }
#undef IN
#undef SEAM
}

constexpr int N_PHASES = 7;
extern "C" void kernel_launch(void* const* d_in, const int* in_sizes, int n_in, void* d_out, int out_size, void* d_ws, size_t ws_size, hipStream_t stream) {
    static int grid = 0;
    if (grid == 0) {
        if (n_in != 12 || in_sizes[0] != M * DM || out_size != M * DM || ws_size < WS_END) { fprintf(stderr, "kernel_launch: unexpected shapes (n_in %d, in0 %d, out %d, ws %zu)\n", n_in, n_in > 0 ? in_sizes[0] : -1, out_size, ws_size); grid = -1; return; }
        int dev = 0, cus = 0, per_cu = 0;
        if (hipGetDevice(&dev) != hipSuccess || hipDeviceGetAttribute(&cus, hipDeviceAttributeMultiprocessorCount, dev) != hipSuccess) { grid = -1; return; }
        if (hipFuncSetAttribute((const void*)hybrid_fwd, hipFuncAttributeMaxDynamicSharedMemorySize, LDS_BYTES) != hipSuccess) { fprintf(stderr, "kernel_launch: hipFuncSetAttribute failed\n"); grid = -1; return; }
        if (hipOccupancyMaxActiveBlocksPerMultiprocessor(&per_cu, (const void*)hybrid_fwd, 512, LDS_BYTES) != hipSuccess || per_cu < 1) { fprintf(stderr, "kernel_launch: occupancy query says %d\n", per_cu); per_cu = 1; }
        (void)hipGetLastError();
        grid = cus;
        if (grid != 256) fprintf(stderr, "kernel_launch: %d CUs; this kernel's work deals assume 256\n", grid);
    }
    if (grid < 0) return;
    Args a{};
    a.x = (const float*)d_in[0]; a.pos = (const int*)d_in[1]; a.w_in = (const float*)d_in[2]; a.g_q = (const float*)d_in[3]; a.w_uq = (const float*)d_in[4]; a.g_kv = (const float*)d_in[5];
    a.w_ukv = (const float*)d_in[6]; a.g_oa = (const float*)d_in[7]; a.g_ob = (const float*)d_in[8]; a.w_out = (const float*)d_in[9]; a.ln_g = (const float*)d_in[10]; a.ln_b = (const float*)d_in[11];
    a.out = (float*)d_out; a.ws = (unsigned char*)d_ws;
#if MK_N_LAUNCHES == 1
    a.ph_lo = 0; a.ph_hi = N_PHASES;
    void* args[] = {&a};
    hipError_t e = hipLaunchCooperativeKernel((const void*)hybrid_fwd, dim3(grid), dim3(512), args, LDS_BYTES, stream);
    if (e != hipSuccess) fprintf(stderr, "kernel_launch: cooperative launch failed: %s (grid %d)\n", hipGetErrorString(e), grid);
#else
    for (int p = 0; p < N_PHASES; ++p) {
        a.ph_lo = p; a.ph_hi = p + 1;
        hipLaunchKernelGGL(hybrid_fwd, dim3(grid), dim3(512), LDS_BYTES, stream, a);
    }
#endif
}
```

```cpp
#include <hip/hip_runtime.h>
#include <hip/hip_cooperative_groups.h>
#include <cstdio>
#include <cstdint>
namespace cg = cooperative_groups;

#ifndef MK_N_LAUNCHES
#define MK_N_LAUNCHES 1
#endif

#define LAS __attribute__((address_space(3)))
typedef unsigned short bf16_t;
typedef short bf16x8 __attribute__((ext_vector_type(8)));
typedef short s16x4 __attribute__((ext_vector_type(4)));
typedef float f32x4 __attribute__((ext_vector_type(4)));
typedef float f32x2 __attribute__((ext_vector_type(2)));
typedef float f32x16 __attribute__((ext_vector_type(16)));
typedef unsigned u32x4 __attribute__((ext_vector_type(4)));
typedef unsigned u32x2 __attribute__((ext_vector_type(2)));

constexpr int NB = 16, S = 4096, M = NB * S, DM = 1024;
constexpr int NPROJ = 3072;
constexpr int C_QA = 0, C_KA = 512, C_VA = 640, C_IQ = 768, C_CQ = 1280, C_CKV = 1664, C_IK = 1920, C_KR = 1984, C_IW = 2016, C_Z = 2048;
constexpr int D_IN = 3048;
constexpr int NQB = 768, NKVB = 1024;
constexpr float LOG2E = 1.4426950408889634f;
constexpr float QA_SCALE = 0.125f * LOG2E;
constexpr float QB_SCALE = 0.10206207261596577f * LOG2E;
constexpr float IW_SCALE = 0.04419417382415922f;
constexpr float DN_ALPHA = 1.189207115002721f;
constexpr int KTOP = 256;

constexpr size_t MiB = 1u << 20;
constexpr size_t WS_W1T = 1 * MiB, WS_WUQT = 7 * MiB, WS_WUKVT = 8 * MiB, WS_WOT = 9 * MiB, WS_CS = 11 * MiB, WS_SSQ = 19 * MiB, WS_POSF = 25 * MiB,
                 WS_OSS = 26 * MiB, WS_STATS = 30 * MiB, WS_XB = 64 * MiB, WS_PROJ = 192 * MiB, WS_QB = 576 * MiB, WS_KVB = 672 * MiB, WS_MASK = 800 * MiB,
                 WS_IKC = 832 * MiB, WS_KRC = 840 * MiB, WS_KAC = 848 * MiB, WS_VAC = 864 * MiB, WS_CQC = 880 * MiB, WS_CKVC = 928 * MiB, WS_END = 960 * MiB;
constexpr size_t WS_KNC = WS_KVB, WS_VBC = WS_KVB + 64 * MiB;
constexpr size_t WS_OAB = WS_XB;
constexpr size_t WS_Y = WS_KVB;

constexpr int LDS_BYTES = 132096;

__device__ __forceinline__ unsigned cvt_pk_bf16(float lo, float hi) { unsigned r; asm volatile("v_cvt_pk_bf16_f32 %0, %1, %2" : "=v"(r) : "v"(lo), "v"(hi)); return r; }
__device__ __forceinline__ float bf_lo(unsigned u) { return __uint_as_float(u << 16); }
__device__ __forceinline__ float bf_hi(unsigned u) { return __uint_as_float(u & 0xffff0000u); }
__device__ __forceinline__ int crow(int r, int hi) { return (r & 3) + 8 * (r >> 2) + 4 * hi; }
__device__ __forceinline__ float silu_f(float v) { return v * __builtin_amdgcn_rcpf(1.0f + __builtin_amdgcn_exp2f(-v * LOG2E)); }
__device__ __forceinline__ void glds16(const void* g, LAS unsigned char* l) { __builtin_amdgcn_global_load_lds((const unsigned*)g, (LAS unsigned*)l, 16, 0, 0); }

namespace pg8 {
constexpr int BM = 256, BK = 64, HALF = 128, HTB = HALF * BK * 2, STAGE_BYTES = 8 * HTB, NXCD = 8, WGM = 8;
__host__ __device__ __forceinline__ int lds_byte(int r, int c) { const int st = (r >> 4) * 2 + (c >> 5), rr = r & 15, cc = c & 31, ob = rr * 64 + cc * 2; return st * 1024 + (ob ^ (((ob >> 9) & 1) << 5)); }
__host__ __device__ __forceinline__ void stage_rc(int b, int& R, int& C) { const int st = b / 1024, sb = b % 1024, swz = sb ^ (((sb >> 9) & 1) << 5); R = (st >> 1) * 16 + swz / 64; C = (st & 1) * 32 + (swz % 64) / 2; }
__host__ __device__ __forceinline__ int perm32(int rho) { const int n = rho >> 4, i = rho & 15; return 8 * (i >> 2) + 4 * n + (i & 3); }

struct Unit { int pm, pn; };
struct Gemm { const bf16_t* A; const bf16_t* Bt; int M, N, K, lda; };

struct StaticOrder {
    int nM, nN, nwg, G, c;
    __host__ __device__ void init(int M_, int N_, int G_, int c_) { nM = M_ / BM; nN = N_ / BM; nwg = nM * nN; G = G_; c = c_; }
    __host__ __device__ bool next(int i, Unit& u) const {
        const long L = (long)i * G + c; if (L >= nwg) return false;
        int wgid = (int)L; { const int q = nwg / NXCD, r = nwg % NXCD, xcd = wgid % NXCD, off = wgid / NXCD; wgid = (xcd < r ? xcd * (q + 1) : r * (q + 1) + (xcd - r) * q) + off; }
        const int nig = WGM * nN, gid = wgid / nig, fm = gid * WGM, gsz = (nM - fm) < WGM ? (nM - fm) : WGM;
        u.pm = fm + ((wgid % nig) % gsz); u.pn = (wgid % nig) / gsz; return true;
    }
};

template <class Epi>
__device__ __forceinline__ void gemm_phase(LAS unsigned char* lds, const Gemm g, const StaticOrder& S, const Epi& E) {
    const int tid = threadIdx.x, wid = __builtin_amdgcn_readfirstlane(tid >> 6), lane = tid & 63, wr = wid >> 2, wc = wid & 3, fr = lane & 15, fq = lane >> 4;
    const int K = g.K, nt = K / BK, lda = g.lda;
    unsigned voffA[2], voffB[2];
#pragma unroll
    for (int i = 0; i < 2; ++i) { int R, C; stage_rc(tid * 16 + i * 8192, R, C); const int Rb = Epi::PERM ? ((R & ~31) + perm32(R & 31)) : R;
        voffA[i] = (unsigned)(R * lda + C) * 2u; voffB[i] = (unsigned)(Rb * K + C) * 2u; }
    const size_t kstep = (size_t)(BK * 2);
    const size_t hstepA = (size_t)HALF * lda * 2, tstepA = 2 * hstepA;
    const size_t hstepB = (size_t)HALF * K * 2, tstepB = 2 * hstepB;
    const unsigned ldsw = (unsigned)wid * 1024u;
    const int aoff = lds_byte(wr * 64 + fr, fq * 8), boff = lds_byte(wc * 32 + fr, fq * 8);
#define PG8_SA(b, h) (((b) * 2 + (h)) * HTB)
#define PG8_SB(b, h) ((4 + (b) * 2 + (h)) * HTB)
#define PG8_STAGE(bufoff, gbase, voff) do { _Pragma("unroll") for (int _i = 0; _i < 2; ++_i) \
        __builtin_amdgcn_global_load_lds((const unsigned*)((const char*)(gbase) + (voff)[_i]), (LAS unsigned*)(lds + (bufoff) + ldsw + _i * 8192), 16, 0, 0); } while (0)
#define PG8_LDA(dst, b, h) do { _Pragma("unroll") for (int m = 0; m < 4; ++m) _Pragma("unroll") for (int k = 0; k < 2; ++k) dst[m][k] = *(const LAS bf16x8*)(lds + PG8_SA(b, h) + aoff + m * 2048 + k * 1024); } while (0)
#define PG8_LDB(dst, b, h) do { _Pragma("unroll") for (int n = 0; n < 2; ++n) _Pragma("unroll") for (int k = 0; k < 2; ++k) dst[n][k] = *(const LAS bf16x8*)(lds + PG8_SB(b, h) + boff + n * 2048 + k * 1024); } while (0)
#define PG8_MMA(ai, bj, At, Bt) do { __builtin_amdgcn_s_setprio(1); _Pragma("unroll") for (int m = 0; m < 4; ++m) _Pragma("unroll") for (int n = 0; n < 2; ++n) _Pragma("unroll") for (int k = 0; k < 2; ++k) \
        acc[ai][bj][m][n] = __builtin_amdgcn_mfma_f32_16x16x32_bf16(Bt[n][k], At[m][k], acc[ai][bj][m][n], 0, 0, 0); __builtin_amdgcn_s_setprio(0); } while (0)
#define PG8_WAIT_V(n) asm volatile("s_waitcnt vmcnt(" #n ")" ::: "memory")
#define PG8_WAIT_L(n) asm volatile("s_waitcnt lgkmcnt(" #n ")" ::: "memory")
#define PG8_BAR __builtin_amdgcn_s_barrier()
#define PG8_SCHED __builtin_amdgcn_sched_barrier(0)
    Unit cur, nxt; int ui = 0;
    if (!S.next(0, cur)) return;
    f32x4 acc[2][2][4][2];
#pragma unroll
    for (int a = 0; a < 2; ++a)
#pragma unroll
        for (int b = 0; b < 2; ++b)
#pragma unroll
            for (int m = 0; m < 4; ++m)
#pragma unroll
                for (int n = 0; n < 2; ++n) acc[a][b][m][n] = (f32x4){0.f, 0.f, 0.f, 0.f};
    bf16x8 At[4][2], B0[2][2], B1[2][2];
    const char* cA = (const char*)g.A + (size_t)cur.pm * tstepA; const char* cB = (const char*)g.Bt + (size_t)cur.pn * tstepB;
    PG8_STAGE(PG8_SB(0, 0), cB, voffB); PG8_STAGE(PG8_SB(0, 1), cB + hstepB, voffB); PG8_STAGE(PG8_SA(0, 0), cA, voffA); PG8_STAGE(PG8_SA(0, 1), cA + hstepA, voffA);
    if (wr == 1) PG8_BAR;
    PG8_WAIT_V(2); PG8_BAR;
    PG8_STAGE(PG8_SB(1, 0), cB + kstep, voffB); PG8_STAGE(PG8_SA(1, 0), cA + kstep, voffA); PG8_STAGE(PG8_SB(1, 1), cB + hstepB + kstep, voffB);
    PG8_WAIT_V(6); PG8_BAR;
    for (;;) {
        const bool has_next = S.next(ui + 1, nxt);
        const char* nA = has_next ? (const char*)g.A + (size_t)nxt.pm * tstepA : cA; const char* nB = has_next ? (const char*)g.Bt + (size_t)nxt.pn * tstepB : cB;
        for (int t = 0; t < nt; t += 2) {
            const bool last = (t == nt - 2);
            const char* a1 = cA + (size_t)(t + 1) * kstep;
            const char* a2 = last ? nA : cA + (size_t)(t + 2) * kstep; const char* b2 = last ? nB : cB + (size_t)(t + 2) * kstep;
            const char* a3 = a2 + kstep; const char* b3 = b2 + kstep;
            PG8_LDB(B0, 0, 0); PG8_LDB(B1, 0, 1); PG8_SCHED; PG8_LDA(At, 0, 0); PG8_STAGE(PG8_SA(1, 1), a1 + hstepA, voffA);
            PG8_WAIT_V(8); PG8_WAIT_L(0); PG8_BAR; PG8_MMA(0, 0, At, B0); PG8_MMA(0, 1, At, B1); PG8_BAR; PG8_SCHED;
            PG8_LDA(At, 0, 1); PG8_STAGE(PG8_SB(0, 0), b2, voffB); PG8_STAGE(PG8_SB(0, 1), b2 + hstepB, voffB); PG8_STAGE(PG8_SA(0, 0), a2, voffA);
            PG8_WAIT_V(8); PG8_WAIT_L(0); PG8_BAR; PG8_MMA(1, 0, At, B0); PG8_MMA(1, 1, At, B1); PG8_BAR; PG8_SCHED;
            PG8_LDB(B0, 1, 0); PG8_LDB(B1, 1, 1); PG8_SCHED; PG8_LDA(At, 1, 0); PG8_STAGE(PG8_SA(0, 1), a2 + hstepA, voffA);
            PG8_WAIT_V(8); PG8_WAIT_L(0); PG8_BAR; PG8_MMA(0, 0, At, B0); PG8_MMA(0, 1, At, B1); PG8_BAR; PG8_SCHED;
            PG8_LDA(At, 1, 1); PG8_STAGE(PG8_SB(1, 0), b3, voffB); PG8_STAGE(PG8_SB(1, 1), b3 + hstepB, voffB); PG8_STAGE(PG8_SA(1, 0), a3, voffA);
            PG8_WAIT_V(8); PG8_WAIT_L(0); PG8_BAR; PG8_MMA(1, 0, At, B0); PG8_MMA(1, 1, At, B1); PG8_BAR; PG8_SCHED;
        }
        if (wr == 0) PG8_BAR;
        E(acc, cur, wr, wc, fr, fq);
        if (!has_next) break;
#pragma unroll
        for (int a = 0; a < 2; ++a)
#pragma unroll
            for (int b = 0; b < 2; ++b)
#pragma unroll
                for (int m = 0; m < 4; ++m)
#pragma unroll
                    for (int n = 0; n < 2; ++n) acc[a][b][m][n] = (f32x4){0.f, 0.f, 0.f, 0.f};
        cur = nxt; cA = nA; cB = nB; ++ui;
        if (wr == 1) PG8_BAR;
    }
    PG8_WAIT_V(0);
    PG8_BAR;
#undef PG8_SA
#undef PG8_SB
#undef PG8_STAGE
#undef PG8_LDA
#undef PG8_LDB
#undef PG8_MMA
#undef PG8_WAIT_V
#undef PG8_WAIT_L
#undef PG8_BAR
#undef PG8_SCHED
}
}

__device__ __forceinline__ int lane_id_nohoist() { int l; asm volatile("v_mbcnt_lo_u32_b32 %0, -1, 0\n\tv_mbcnt_hi_u32_b32 %0, -1, %0" : "=v"(l)); return l; }

__device__ __forceinline__ void rope8(f32x4& v0, f32x4& v1, const float* csrow, int fq) {
    const f32x4 c = *(const f32x4*)(csrow + 4 * fq), s = *(const f32x4*)(csrow + 16 + 4 * fq);
    const float a0 = v0[0] * c[0] - v0[1] * s[0], b0 = v0[0] * s[0] + v0[1] * c[0];
    const float a1 = v0[2] * c[1] - v0[3] * s[1], b1 = v0[2] * s[1] + v0[3] * c[1];
    const float a2 = v1[0] * c[2] - v1[1] * s[2], b2 = v1[0] * s[2] + v1[1] * c[2];
    const float a3 = v1[2] * c[3] - v1[3] * s[3], b3 = v1[2] * s[3] + v1[3] * c[3];
    v0 = (f32x4){a0, b0, a1, b1}; v1 = (f32x4){a2, b2, a3, b3};
}
__device__ __forceinline__ void store8(bf16_t* p, const f32x4& v0, const f32x4& v1) {
    u32x4 w; w.x = cvt_pk_bf16(v0[0], v0[1]); w.y = cvt_pk_bf16(v0[2], v0[3]); w.z = cvt_pk_bf16(v1[0], v1[1]); w.w = cvt_pk_bf16(v1[2], v1[3]);
    *(u32x4*)p = w;
}

struct EpiProj {
    static constexpr bool PERM = true;
    bf16_t* P; const float* cs; float* ssq; bf16_t* IKC; bf16_t* KRC; bf16_t* KAC; bf16_t* VAC; bf16_t* CQC; bf16_t* CKVC;
    __device__ __forceinline__ void operator()(const f32x4 (&acc)[2][2][4][2], const pg8::Unit& u, int wr, int wc, int fr_, int fq_) const {
        const int l_ = lane_id_nohoist(), fr = l_ & 15, fq = l_ >> 4;
        const int row0 = u.pm * 256 + wr * 64 + fr, colt = u.pn * 256 + wc * 32 + 8 * fq, pn = u.pn;
#pragma unroll
        for (int ai = 0; ai < 2; ++ai)
#pragma unroll
            for (int m = 0; m < 4; ++m) {
                const int row = row0 + ai * 128 + m * 16; bf16_t* rowp = P + (size_t)row * NPROJ + colt;
#pragma unroll
                for (int bj = 0; bj < 2; ++bj) {
                    f32x4 v0 = acc[ai][bj][m][0], v1 = acc[ai][bj][m][1];
                    bf16_t* dst = rowp + bj * 128;
                    if (pn >= 8) {
#pragma unroll
                        for (int j = 0; j < 4; ++j) { v0[j] = silu_f(v0[j]); v1[j] = silu_f(v1[j]); }
                    } else if (pn == 2) {
                        const size_t tb = (size_t)((row >> 12) * 2 + (wc >> 1)) * 64 + ((row & 4095) >> 6); const int k = row & 63;
                        dst = (bj == 0) ? KAC + (tb * 8 + 4 * (wc & 1) + fq) * 512 + k * 8 : VAC + (tb * 2 + (wc & 1)) * 2048 + k * 32 + 8 * fq;
                    } else if (pn >= 5) {
                        int slot = -1;
                        if (pn == 5) { slot = bj * 4 + wc; dst = CQC + (size_t)row * 384 + bj * 128 + wc * 32 + 8 * fq; }
                        else if (pn == 6) { if (bj == 0) { slot = 8 + wc; dst = CQC + (size_t)row * 384 + 256 + wc * 32 + 8 * fq; } else { slot = 12 + wc; dst = CKVC + (size_t)row * 256 + wc * 32 + 8 * fq; } }
                        else if (bj == 0) { slot = 16 + wc; dst = CKVC + (size_t)row * 256 + 128 + wc * 32 + 8 * fq; }
                        if (slot >= 0) {
                            float s = (v0[0] * v0[0] + v0[1] * v0[1]) + (v0[2] * v0[2] + v0[3] * v0[3]) + (v1[0] * v1[0] + v1[1] * v1[1]) + (v1[2] * v1[2] + v1[3] * v1[3]);
                            s += __shfl_xor(s, 16); s += __shfl_xor(s, 32);
                            if (fq == 0) ssq[(size_t)row * 20 + slot] = s;
                        } else if (wc < 2) dst = IKC + ((size_t)(row >> 5) * 8 + 4 * wc + fq) * 256 + (row & 31) * 8;
                        else if (wc == 2) { rope8(v0, v1, cs + (size_t)row * 32, fq); dst = KRC + ((size_t)(row >> 6) * 4 + fq) * 512 + (row & 63) * 8; }
                    }
                    store8(dst, v0, v1);
                }
                asm volatile("" ::: "memory");
            }
    }
};
struct EpiUp {
    static constexpr bool PERM = true;
    bf16_t* O; int ldc; const float* ssq; int slot0, nslot4; float invK; const float* cs; int rope_pn; bf16_t* HK; bf16_t* HV;
    __device__ __forceinline__ void operator()(const f32x4 (&acc)[2][2][4][2], const pg8::Unit& u, int wr, int wc, int fr_, int fq_) const {
        const int l_ = lane_id_nohoist(), fr = l_ & 15, fq = l_ >> 4;
        const int row0 = u.pm * 256 + wr * 64 + fr, colt = u.pn * 256 + wc * 32 + 8 * fq;
#pragma unroll
        for (int ai = 0; ai < 2; ++ai)
#pragma unroll
            for (int m = 0; m < 4; ++m) {
                const int row = row0 + ai * 128 + m * 16; bf16_t* rowp = O + (size_t)row * ldc + colt;
                float ss = 0.f;
                for (int q = 0; q < nslot4; ++q) { const f32x4 t = *(const f32x4*)(ssq + (size_t)row * 20 + slot0 + 4 * q); ss += (t[0] + t[1]) + (t[2] + t[3]); }
                const float rstd = __builtin_amdgcn_rsqf(ss * invK + 1e-6f);
#pragma unroll
                for (int bj = 0; bj < 2; ++bj) {
                    f32x4 v0 = acc[ai][bj][m][0] * rstd, v1 = acc[ai][bj][m][1] * rstd;
                    if (u.pn == rope_pn) rope8(v0, v1, cs + (size_t)row * 32, fq);
                    bf16_t* dst = rowp + bj * 128;
                    if (HK) { const int h = 4 * (u.pn & 1) + 2 * bj + (wc >> 1);
                        const size_t tb = (size_t)((row >> 12) * 8 + h) * 64 + ((row & 4095) >> 6); const int k = row & 63;
                        dst = (u.pn < 2) ? HK + (tb * 8 + 4 * (wc & 1) + fq) * 512 + k * 8 : HV + (tb * 2 + (wc & 1)) * 2048 + k * 32 + 8 * fq; }
                    store8(dst, v0, v1);
                }
                asm volatile("" ::: "memory");
            }
    }
};
struct EpiOut {
    static constexpr bool PERM = false;
    const float* x; float* out; float* stats;
    __device__ __forceinline__ void operator()(const f32x4 (&acc)[2][2][4][2], const pg8::Unit& u, int wr, int wc, int fr_, int fq_) const {
        const int l_ = lane_id_nohoist(), fr = l_ & 15, fq = l_ >> 4;
        const int row0 = u.pm * 256 + wr * 64 + fr, col0 = u.pn * 256 + wc * 32 + 4 * fq;
#pragma unroll
        for (int ai = 0; ai < 2; ++ai)
#pragma unroll
            for (int m = 0; m < 4; ++m) {
                const int row = row0 + ai * 128 + m * 16; const size_t off = (size_t)row * DM + col0;
                float s = 0.f, q = 0.f;
#pragma unroll
                for (int bj = 0; bj < 2; ++bj)
#pragma unroll
                    for (int n = 0; n < 2; ++n) {
                        const f32x4 xv = *(const f32x4*)(x + off + bj * 128 + n * 16);
                        const f32x4 v = xv * DN_ALPHA + acc[ai][bj][m][n];
                        s += (v[0] + v[1]) + (v[2] + v[3]); q += (v[0] * v[0] + v[1] * v[1]) + (v[2] * v[2] + v[3] * v[3]);
                        *(f32x4*)(out + off + bj * 128 + n * 16) = v;
                    }
                s += __shfl_xor(s, 16); s += __shfl_xor(s, 32); q += __shfl_xor(q, 16); q += __shfl_xor(q, 32);
                if (fq == 0) *(f32x2*)(stats + (size_t)row * 32 + (u.pn * 4 + wc) * 2) = (f32x2){s, q};
            }
    }
};

constexpr int AT_KBYTES = 12288, AT_BUF = 20480;
__device__ __forceinline__ s16x4 vtr(const LAS unsigned char* p) {
    typedef short v4i16_t __attribute__((ext_vector_type(4)));
    return __builtin_bit_cast(s16x4, __builtin_amdgcn_ds_read_tr16_b64_v4i16((LAS v4i16_t*)p));
}
#define AT_SYNC() do { asm volatile("s_waitcnt vmcnt(0) lgkmcnt(0)" ::: "memory"); __syncthreads(); } while (0)

__device__ __forceinline__ void pv_tile(f32x16 (&oT)[2], const f32x16& p0, const f32x16& p1, const LAS unsigned char* vbase) {
    u32x4 pw[4];
#pragma unroll
    for (int s = 0; s < 4; ++s) {
        const f32x16& p = (s < 2) ? p0 : p1; const int o = 8 * (s & 1);
        pw[s] = (u32x4){cvt_pk_bf16(p[o], p[o + 1]), cvt_pk_bf16(p[o + 2], p[o + 3]), cvt_pk_bf16(p[o + 4], p[o + 5]), cvt_pk_bf16(p[o + 6], p[o + 7])};
    }
#pragma unroll
    for (int d0 = 0; d0 < 2; ++d0)
#pragma unroll
        for (int s = 0; s < 4; ++s) {
            const s16x4 lo = vtr(vbase + d0 * 4096 + s * 1024), hi = vtr(vbase + d0 * 4096 + s * 1024 + 512);
            const bf16x8 vf = (bf16x8){lo[0], lo[1], lo[2], lo[3], hi[0], hi[1], hi[2], hi[3]};
            oT[d0] = __builtin_amdgcn_mfma_f32_32x32x16_bf16(vf, __builtin_bit_cast(bf16x8, pw[s]), oT[d0], 0, 0, 0);
        }
}
__device__ __forceinline__ void softmax_tile(f32x16& p0, f32x16& p1, f32x16 (&oT)[2], float& m, float& l) {
    float mx = p0[0];
#pragma unroll
    for (int r = 1; r < 16; ++r) mx = fmaxf(mx, p0[r]);
#pragma unroll
    for (int r = 0; r < 16; ++r) mx = fmaxf(mx, p1[r]);
    mx = fmaxf(mx, __shfl_xor(mx, 32));
    const float mnew = fmaxf(m, mx);
    const float msafe = (mnew == -INFINITY) ? 0.f : mnew;
    const float f = __builtin_amdgcn_exp2f(m - msafe);
    m = mnew;
    float sum = 0.f;
#pragma unroll
    for (int r = 0; r < 16; ++r) { p0[r] = __builtin_amdgcn_exp2f(p0[r] - msafe); p1[r] = __builtin_amdgcn_exp2f(p1[r] - msafe); sum += p0[r] + p1[r]; }
    l = l * f + sum;
#pragma unroll
    for (int d0 = 0; d0 < 2; ++d0)
#pragma unroll
        for (int r = 0; r < 16; ++r) oT[d0][r] *= f;
}
__device__ __forceinline__ void attn_store(const f32x16 (&oT)[2], float l, bf16_t* orow, float* ossp, int hi) {
    l += __shfl_xor(l, 32);
    const float inv = 1.0f / l;
    float ssq = 0.f;
#pragma unroll
    for (int d0 = 0; d0 < 2; ++d0)
#pragma unroll
        for (int c = 0; c < 4; ++c) {
            const float a = oT[d0][4 * c] * inv, b = oT[d0][4 * c + 1] * inv, cc = oT[d0][4 * c + 2] * inv, d = oT[d0][4 * c + 3] * inv;
            ssq += (a * a + b * b) + (cc * cc + d * d);
            *(u32x2*)(orow + 32 * d0 + 8 * c + 4 * hi) = (u32x2){cvt_pk_bf16(a, b), cvt_pk_bf16(cc, d)};
        }
    ssq += __shfl_xor(ssq, 32);
    if (hi == 0) *ossp = ssq;
}

__device__ __forceinline__ void mla_unit(int b, int h, int qb, const bf16_t* QB, const bf16_t* KNC, const bf16_t* VBC, const bf16_t* KRC, bf16_t* OAB, float* OSS, LAS unsigned char* lds) {
    const int tid = threadIdx.x, lane = tid & 63, r32 = lane & 31, hi = lane >> 5, wid = __builtin_amdgcn_readfirstlane(tid >> 6);
    const size_t rowbase = (size_t)b * S; const int q0 = qb * 256, tq = q0 + wid * 32 + r32;
    const int NT = 4 * (qb + 1);
    const size_t hb = ((size_t)(b * 8 + h) * S) * 64;
    const bf16_t* ksrc = KNC + hb + wid * 512 + lane * 8;
    const bf16_t* rsrc = KRC + rowbase * 32 + (wid & 3) * 512 + lane * 8;
    const bf16_t* vsrc = VBC + hb + (wid >> 2) * 2048 + (wid & 3) * 512 + lane * 8;
#define MLA_DMA(kt, bsel) do { LAS unsigned char* _b = lds + (bsel) * AT_BUF; glds16(ksrc + (size_t)(kt) * 4096, _b + wid * 1024); \
        if (wid >= 4) glds16(rsrc + (size_t)(kt) * 2048, _b + (8 + (wid & 3)) * 1024); \
        glds16(vsrc + (size_t)(kt) * 4096, _b + AT_KBYTES + (wid >> 2) * 4096 + (wid & 3) * 1024); } while (0)
    MLA_DMA(0, 0);
    bf16x8 qf[6];
    { const bf16_t* qrow = QB + (rowbase + tq) * NQB;
#pragma unroll
      for (int d0 = 0; d0 < 4; ++d0) qf[d0] = *(const bf16x8*)(qrow + h * 64 + d0 * 16 + hi * 8);
#pragma unroll
      for (int d0 = 4; d0 < 6; ++d0) qf[d0] = *(const bf16x8*)(qrow + 512 + h * 32 + (d0 - 4) * 16 + hi * 8); }
    float m = -INFINITY, l = 0.f; f32x16 oT[2]; oT[0] = f32x16{}; oT[1] = f32x16{};
    const int vboff = ((lane >> 4) & 1) * 32 + (lane & 3) * 8 + (4 * hi + ((lane & 15) >> 2)) * 64;
    AT_SYNC();
    for (int kt = 0; kt < NT; ++kt) {
        const int cur = kt & 1;
        if (kt + 1 < NT) MLA_DMA(kt + 1, cur ^ 1);
        const LAS unsigned char* kb = lds + cur * AT_BUF + hi * 1024 + r32 * 16;
        f32x16 p0 = f32x16{}, p1 = f32x16{};
#pragma unroll
        for (int d0 = 0; d0 < 6; ++d0) {
            const bf16x8 a0 = *(const LAS bf16x8*)(kb + d0 * 2048), a1 = *(const LAS bf16x8*)(kb + d0 * 2048 + 512);
            p0 = __builtin_amdgcn_mfma_f32_32x32x16_bf16(a0, qf[d0], p0, 0, 0, 0);
            p1 = __builtin_amdgcn_mfma_f32_32x32x16_bf16(a1, qf[d0], p1, 0, 0, 0);
        }
        if (kt >= NT - 4) {
            const int kb0 = kt * 64 + 4 * hi;
#pragma unroll
            for (int r = 0; r < 16; ++r) { const int ks = kb0 + (r & 3) + 8 * (r >> 2); if (ks > tq) p0[r] = -INFINITY; if (ks + 32 > tq) p1[r] = -INFINITY; }
        }
        softmax_tile(p0, p1, oT, m, l);
        pv_tile(oT, p0, p1, lds + cur * AT_BUF + AT_KBYTES + vboff);
        AT_SYNC();
    }
#undef MLA_DMA
    attn_store(oT, l, OAB + (rowbase + tq) * DM + 512 + h * 64, OSS + (rowbase + tq) * 16 + 8 + h, hi);
}

__device__ __forceinline__ void dsa_unit(int b, int g, int qb, const bf16_t* PROJ, const bf16_t* KAC, const bf16_t* VAC, const unsigned long long* MASK, const float* POSF, bf16_t* OAB, float* OSS, LAS unsigned char* lds) {
    const int tid = threadIdx.x, lane = tid & 63, r32 = lane & 31, hi = lane >> 5, wid = __builtin_amdgcn_readfirstlane(tid >> 6);
    const size_t rowbase = (size_t)b * S; const int q0 = qb * 64, tq = q0 + wid * 8 + (r32 >> 2), head = 4 * g + (r32 & 3);
    const int NT = qb + 1;
    const size_t gb = ((size_t)(b * 2 + g) * S) * 64;
    const bf16_t* ksrc = KAC + gb + wid * 512 + lane * 8;
    const bf16_t* vsrc = VAC + gb + (wid >> 2) * 2048 + (wid & 3) * 512 + lane * 8;
#define DSA_DMA(kt, bsel) do { LAS unsigned char* _b = lds + (bsel) * AT_BUF; glds16(ksrc + (size_t)(kt) * 4096, _b + wid * 1024); \
        glds16(vsrc + (size_t)(kt) * 4096, _b + AT_KBYTES + (wid >> 2) * 4096 + (wid & 3) * 1024); } while (0)
    DSA_DMA(0, 0);
    bf16x8 qf[4];
    { const bf16_t* qrow = PROJ + (rowbase + tq) * NPROJ + C_QA + head * 64;
#pragma unroll
      for (int d0 = 0; d0 < 4; ++d0) qf[d0] = *(const bf16x8*)(qrow + d0 * 16 + hi * 8); }
    const float pt = POSF[rowbase + tq];
    const float nslope = -__builtin_amdgcn_exp2f(-(float)(head + 1)) * LOG2E;
    const unsigned long long* mrow = MASK + (rowbase + tq) * 64;
    float m = -INFINITY, l = 0.f; f32x16 oT[2]; oT[0] = f32x16{}; oT[1] = f32x16{};
    const int vboff = ((lane >> 4) & 1) * 32 + (lane & 3) * 8 + (4 * hi + ((lane & 15) >> 2)) * 64;
    AT_SYNC();
    for (int kt = 0; kt < NT; ++kt) {
        const int cur = kt & 1;
        if (kt + 1 < NT) DSA_DMA(kt + 1, cur ^ 1);
        const unsigned long long mw = mrow[kt];
        const float* pk = POSF + rowbase + kt * 64 + 4 * hi;
        const LAS unsigned char* kb = lds + cur * AT_BUF + hi * 1024 + r32 * 16;
        f32x16 p0 = f32x16{}, p1 = f32x16{};
#pragma unroll
        for (int d0 = 0; d0 < 4; ++d0) {
            const bf16x8 a0 = *(const LAS bf16x8*)(kb + d0 * 2048), a1 = *(const LAS bf16x8*)(kb + d0 * 2048 + 512);
            p0 = __builtin_amdgcn_mfma_f32_32x32x16_bf16(a0, qf[d0], p0, 0, 0, 0);
            p1 = __builtin_amdgcn_mfma_f32_32x32x16_bf16(a1, qf[d0], p1, 0, 0, 0);
        }
        const unsigned w0 = (unsigned)mw >> (4 * hi), w1 = (unsigned)(mw >> 32) >> (4 * hi);
#pragma unroll
        for (int c = 0; c < 4; ++c) {
            const f32x4 k0 = *(const f32x4*)(pk + 8 * c), k1 = *(const f32x4*)(pk + 32 + 8 * c);
#pragma unroll
            for (int j = 0; j < 4; ++j) {
                const int r = 4 * c + j;
                const float s0 = __builtin_fmaf(nslope, __builtin_fabsf(pt - k0[j]), p0[r]), s1 = __builtin_fmaf(nslope, __builtin_fabsf(pt - k1[j]), p1[r]);
                p0[r] = ((w0 >> (8 * c + j)) & 1u) ? s0 : -INFINITY;
                p1[r] = ((w1 >> (8 * c + j)) & 1u) ? s1 : -INFINITY;
            }
        }
        softmax_tile(p0, p1, oT, m, l);
        pv_tile(oT, p0, p1, lds + cur * AT_BUF + AT_KBYTES + vboff);
        AT_SYNC();
    }
#undef DSA_DMA
    attn_store(oT, l, OAB + (rowbase + tq) * DM + head * 64, OSS + (rowbase + tq) * 16 + head, hi);
}

__device__ __forceinline__ int wave_sum_i(int x) {
    x += __builtin_amdgcn_update_dpp(0, x, 0xB1, 0xf, 0xf, true);
    x += __builtin_amdgcn_update_dpp(0, x, 0x4E, 0xf, 0xf, true);
    x += __builtin_amdgcn_update_dpp(0, x, 0x141, 0xf, 0xf, true);
    x += __builtin_amdgcn_update_dpp(0, x, 0x140, 0xf, 0xf, true);
    { auto r = __builtin_amdgcn_permlane16_swap((unsigned)x, (unsigned)x, false, false); x = (int)(r[0] + r[1]); }
    { auto r = __builtin_amdgcn_permlane32_swap((unsigned)x, (unsigned)x, false, false); x = (int)(r[0] + r[1]); }
    return __builtin_amdgcn_readfirstlane(x);
}
__device__ __forceinline__ float wave_max_f(float x) {
    x = fmaxf(x, __uint_as_float(__builtin_amdgcn_update_dpp(0, __float_as_uint(x), 0xB1, 0xf, 0xf, true)));
    x = fmaxf(x, __uint_as_float(__builtin_amdgcn_update_dpp(0, __float_as_uint(x), 0x4E, 0xf, 0xf, true)));
    x = fmaxf(x, __uint_as_float(__builtin_amdgcn_update_dpp(0, __float_as_uint(x), 0x141, 0xf, 0xf, true)));
    x = fmaxf(x, __uint_as_float(__builtin_amdgcn_update_dpp(0, __float_as_uint(x), 0x140, 0xf, 0xf, true)));
    { auto r = __builtin_amdgcn_permlane16_swap(__float_as_uint(x), __float_as_uint(x), false, false); x = fmaxf(__uint_as_float(r[0]), __uint_as_float(r[1])); }
    { auto r = __builtin_amdgcn_permlane32_swap(__float_as_uint(x), __float_as_uint(x), false, false); x = fmaxf(__uint_as_float(r[0]), __uint_as_float(r[1])); }
    return __uint_as_float(__builtin_amdgcn_readfirstlane(__float_as_uint(x)));
}
#define SEL_GE(cnt, xv, thr) asm volatile("v_cmp_ge_f32 vcc, %1, %2\n\tv_addc_co_u32 %0, vcc, 0, %0, vcc" : "+v"(cnt) : "v"(xv), "v"(thr) : "vcc")
#define SEL_GT(cnt, xv, thr) asm volatile("v_cmp_gt_f32 vcc, %1, %2\n\tv_addc_co_u32 %0, vcc, 0, %0, vcc" : "+v"(cnt) : "v"(xv), "v"(thr) : "vcc")
__device__ __forceinline__ void select_row(int t, const LAS float* sc, unsigned long long* mrow, int lane) {
    const int n = t + 1;
    if (n <= KTOP) {
        const int cnt = n - 64 * lane;
        mrow[lane] = cnt >= 64 ? ~0ull : (cnt <= 0 ? 0ull : ((1ull << cnt) - 1ull));
        return;
    }
    const int nreg = (n + 63) >> 6;
    float xv[64];
#define SEL_LD16(base) _Pragma("unroll") for (int i = (base); i < (base) + 16; ++i) xv[i] = sc[64 * i + lane];
#define SEL_NO16(base) _Pragma("unroll") for (int i = (base); i < (base) + 16; ++i) xv[i] = -INFINITY;
    SEL_LD16(0)
    if (nreg > 16) { SEL_LD16(16) } else { SEL_NO16(16) }
    if (nreg > 32) { SEL_LD16(32) } else { SEL_NO16(32) }
    if (nreg > 48) { SEL_LD16(48) } else { SEL_NO16(48) }
#undef SEL_LD16
#undef SEL_NO16
    float mx = -INFINITY, mn = INFINITY;
    const int nl = n - lane;
#define SEL_MM16(base) _Pragma("unroll") for (int i = (base); i < (base) + 16; ++i) { const bool ok = 64 * i < nl; const float v = xv[i]; xv[i] = ok ? v : -INFINITY; mx = fmaxf(mx, xv[i]); mn = fminf(mn, ok ? v : INFINITY); }
    SEL_MM16(0) if (nreg > 16) { SEL_MM16(16) } if (nreg > 32) { SEL_MM16(32) } if (nreg > 48) { SEL_MM16(48) }
#undef SEL_MM16
    mx = wave_max_f(mx); mn = -wave_max_f(-mn);
#define SEL_CNT16(base, MAC, V) _Pragma("unroll") for (int i = (base); i < (base) + 16; ++i) MAC(c, xv[i], V);
#define SEL_COUNT(MAC, V) do { c = 0; SEL_CNT16(0, MAC, V) if (nreg > 16) { SEL_CNT16(16, MAC, V) } if (nreg > 32) { SEL_CNT16(32, MAC, V) } if (nreg > 48) { SEL_CNT16(48, MAC, V) } c = wave_sum_i(c); } while (0)
    int c;
    float lo = mn, hi = mx, theta = mx; bool exact = false;
    SEL_COUNT(SEL_GE, mx);
    if (c >= KTOP) { if (c == KTOP) exact = true; else { lo = mx; hi = INFINITY; } }
    else {
#pragma unroll 1
        for (int it = 0; it < 64; ++it) {
            const float mid = __uint_as_float(__builtin_amdgcn_readfirstlane(__float_as_uint(lo + 0.5f * (hi - lo))));
            if (!(mid > lo) || !(mid < hi)) break;
            SEL_COUNT(SEL_GE, mid);
            if (c == KTOP) { exact = true; theta = mid; break; }
            if (c > KTOP) lo = mid; else hi = mid;
        }
    }
    unsigned long long myw = 0ull;
    if (exact) {
#define SEL_OUT16(base) _Pragma("unroll") for (int i = (base); i < (base) + 16; ++i) { const unsigned long long mk = __ballot(xv[i] >= theta); if (lane == i) myw = mk; }
        SEL_OUT16(0) if (nreg > 16) { SEL_OUT16(16) } if (nreg > 32) { SEL_OUT16(32) } if (nreg > 48) { SEL_OUT16(48) }
#undef SEL_OUT16
    } else {
        SEL_COUNT(SEL_GT, lo);
        int need = KTOP - c;
#pragma unroll
        for (int i = 0; i < 64; ++i) {
            if (i < nreg) {
                unsigned long long mk = __ballot(xv[i] > lo); const unsigned long long e = __ballot(xv[i] == lo);
                const int pe = __popcll(e);
                if (pe <= need) { mk |= e; need -= pe; }
                else { const int rank = __popcll(e & ((1ull << lane) - 1ull)); mk |= __ballot(((e >> lane) & 1ull) && rank < need); need = 0; }
                if (lane == i) myw = mk;
            }
        }
    }
#undef SEL_COUNT
#undef SEL_CNT16
    mrow[lane] = myw;
}

#define IDX_BAR() asm volatile("s_waitcnt lgkmcnt(0)\n\ts_barrier" ::: "memory")
__device__ __forceinline__ void idx_phase(int b, int sdeal, const bf16_t* PROJ, const bf16_t* IKC, unsigned long long* MASK, LAS unsigned char* lds) {
    const int tid = threadIdx.x, lane = tid & 63, r32 = lane & 31, hi = lane >> 5, wid = __builtin_amdgcn_readfirstlane(tid >> 6);
    const size_t rowbase = (size_t)b * S;
    LAS float* SC = (LAS float*)lds;
    const int qi = 2 * ((r32 >> 2) & 1) + (r32 >> 4), hd = (r32 & 3) + 4 * ((r32 >> 3) & 1);
    const bf16_t* qbase = PROJ + (rowbase + qi) * NPROJ + C_IQ + hd * 64 + hi * 8;
    const bf16_t* wbase = PROJ + (rowbase + 2 * hi) * NPROJ + C_IW;
    const bf16_t* kbase = IKC + (rowbase + wid * 32) * 64 + hi * 256 + r32 * 8;
    bf16x8 af[2][4]; u32x4 wv[2][2]; bf16x8 f0[4], f1[4], f2[4], f3[4];
#define IDX_J(u) (16 * (u) + (((u) & 1) ? 15 - sdeal : sdeal))
#define IDX_CNT(t0) ((((t0) + 8 + 31) >> 5) - wid + 7) >> 3
#define IDX_LOAD(dst, i, cnt) do { const int _i = ((i) < (cnt)) ? (i) : ((cnt) - 1); const bf16_t* _p = kbase + (size_t)_i * (256 * 64); \
        _Pragma("unroll") for (int d0 = 0; d0 < 4; ++d0) dst[d0] = *(const bf16x8*)(_p + d0 * 512); } while (0)
#define IDX_PREFETCH(t0) do { if ((t0) + 8 > KTOP) { const int _c = IDX_CNT(t0); \
        _Pragma("unroll") for (int mt = 0; mt < 2; ++mt) { const bf16_t* _q = qbase + (size_t)((t0) + 4 * mt) * NPROJ; \
            _Pragma("unroll") for (int d0 = 0; d0 < 4; ++d0) af[mt][d0] = *(const bf16x8*)(_q + d0 * 16); \
            _Pragma("unroll") for (int e = 0; e < 2; ++e) wv[mt][e] = *(const u32x4*)(wbase + (size_t)((t0) + 4 * mt + e) * NPROJ); } \
        IDX_LOAD(f0, 0, _c); IDX_LOAD(f1, 1, _c); IDX_LOAD(f2, 2, _c); } } while (0)
#define IDX_W(mt, e, h8) ((h8) == 0 ? bf_lo(wv[mt][e].x) : (h8) == 1 ? bf_hi(wv[mt][e].x) : (h8) == 2 ? bf_lo(wv[mt][e].y) : (h8) == 3 ? bf_hi(wv[mt][e].y) : \
                          (h8) == 4 ? bf_lo(wv[mt][e].z) : (h8) == 5 ? bf_hi(wv[mt][e].z) : (h8) == 6 ? bf_lo(wv[mt][e].w) : bf_hi(wv[mt][e].w))
#define IDX_COMP(src, i) do { f32x16 a0 = f32x16{}, a1 = f32x16{}; \
        _Pragma("unroll") for (int d0 = 0; d0 < 4; ++d0) { a0 = __builtin_amdgcn_mfma_f32_32x32x16_bf16(af[0][d0], src[d0], a0, 0, 0, 0); a1 = __builtin_amdgcn_mfma_f32_32x32x16_bf16(af[1][d0], src[d0], a1, 0, 0, 0); } \
        _Pragma("unroll") for (int mt = 0; mt < 2; ++mt) _Pragma("unroll") for (int e = 0; e < 2; ++e) { float s = 0.f; \
            _Pragma("unroll") for (int h8 = 0; h8 < 8; ++h8) s = __builtin_fmaf(w[mt][e][h8], fmaxf(mt == 0 ? a0[8 * e + h8] : a1[8 * e + h8], 0.f), s); \
            SC[(4 * mt + 2 * hi + e) * 4096 + (wid + 8 * (i)) * 32 + r32] = s; } } while (0)
    { const int t0 = 8 * IDX_J(0); IDX_PREFETCH(t0); }
    for (int u = 0; u < 32; ++u) {
        const int t0 = 8 * IDX_J(u);
        if (t0 + 8 > KTOP) {
            float w[2][2][8];
#pragma unroll
            for (int mt = 0; mt < 2; ++mt)
#pragma unroll
                for (int e = 0; e < 2; ++e)
#pragma unroll
                    for (int h8 = 0; h8 < 8; ++h8) w[mt][e][h8] = IDX_W(mt, e, h8);
            const int cnt = IDX_CNT(t0);
            for (int i = 0; i < cnt; i += 4) {
                IDX_LOAD(f3, i + 3, cnt); IDX_COMP(f0, i);
                if (i + 1 < cnt) { IDX_LOAD(f0, i + 4, cnt); IDX_COMP(f1, i + 1); }
                if (i + 2 < cnt) { IDX_LOAD(f1, i + 5, cnt); IDX_COMP(f2, i + 2); }
                if (i + 3 < cnt) { IDX_LOAD(f2, i + 6, cnt); IDX_COMP(f3, i + 3); }
            }
        }
        IDX_BAR();
        if (u + 1 < 32) { const int t1 = 8 * IDX_J(u + 1); IDX_PREFETCH(t1); }
        select_row(t0 + wid, SC + wid * 4096, MASK + (rowbase + t0 + wid) * 64, lane);
        IDX_BAR();
    }
#undef IDX_J
#undef IDX_CNT
#undef IDX_LOAD
#undef IDX_PREFETCH
#undef IDX_W
#undef IDX_COMP
}

struct Args { const float* x; const int* pos; const float* w_in; const float* g_q; const float* w_uq; const float* g_kv; const float* w_ukv; const float* g_oa; const float* g_ob;
              const float* w_out; const float* ln_g; const float* ln_b; float* out; unsigned char* ws; int ph_lo, ph_hi; };

__device__ __forceinline__ void src_map(int kind, int n, int& src, float& sc) {
    sc = 1.f;
    if (kind == 0) {
        if (n < 512) { src = n; sc = QA_SCALE; }
        else if (n < 1280) src = n;
        else if (n < 1664) src = n - 1280 + 1352;
        else if (n < 1920) src = n - 1664 + 1736;
        else if (n < 1984) src = n - 1920 + 1280;
        else if (n < 2016) { const int e = n - 1984; src = 1992 + (e >> 1) + 16 * (e & 1); }
        else if (n < 2024) { src = n - 2016 + 1344; sc = IW_SCALE; }
        else if (n < 2048) src = -1;
        else src = n - 2048 + 2024;
    } else if (kind == 1) {
        if (n < 512) { const int h = n >> 6, d = n & 63; src = h * 96 + d; }
        else { const int e = n - 512, h = e >> 5, r = e & 31; src = h * 96 + 64 + (r >> 1) + 16 * (r & 1); }
        sc = QB_SCALE;
    } else if (kind == 2) {
        if (n < 512) { const int h = n >> 6, d = n & 63; src = h * 128 + d; }
        else { const int e = n - 512, h = e >> 6, d = e & 63; src = h * 128 + 64 + d; }
    } else src = n;
}
__device__ __forceinline__ void p0_transpose_item(const float* W, int K, int Nsrc, int Ndst, bf16_t* WT, int kind, const float* ks0, const float* ks1, LAS float* scr, int item, int lane) {
    const int nblk = Ndst / 32, kb = item / nblk, nb = item % nblk, k0 = 64 * kb, n0 = 32 * nb;
    int src; float sc; src_map(kind, n0 + (lane & 31), src, sc);
#pragma unroll 8
    for (int i = 0; i < 32; ++i) { const int kk = 2 * i + (lane >> 5), k = k0 + kk;
        float ksc = 1.f; if (ks0) ksc = (k < 512 || !ks1) ? ks0[k] : ks1[k - 512];
        scr[kk * 33 + (lane & 31)] = src >= 0 ? W[(size_t)k * Nsrc + src] * (sc * ksc) : 0.f; }
    asm volatile("s_waitcnt lgkmcnt(0)" ::: "memory");
    const int c = lane & 7;
#pragma unroll
    for (int jj = 0; jj < 4; ++jj) { const int n = (lane >> 3) + 8 * jj; const LAS float* s = scr + (8 * c) * 33 + n;
        u32x4 o; o.x = cvt_pk_bf16(s[0 * 33], s[1 * 33]); o.y = cvt_pk_bf16(s[2 * 33], s[3 * 33]); o.z = cvt_pk_bf16(s[4 * 33], s[5 * 33]); o.w = cvt_pk_bf16(s[6 * 33], s[7 * 33]);
        *(u32x4*)(WT + (size_t)(n0 + n) * K + k0 + 8 * c) = o; }
    asm volatile("s_waitcnt lgkmcnt(0)" ::: "memory");
}
__device__ __forceinline__ float wave_sum(float v) {
#pragma unroll
    for (int o = 1; o < 64; o <<= 1) v += __shfl_xor(v, o);
    return v;
}

__global__ void __launch_bounds__(512, 2) hybrid_fwd(Args a) {
    extern __shared__ __attribute__((aligned(16))) unsigned char lds_raw[];
    LAS unsigned char* lds = (LAS unsigned char*)lds_raw;
    const int tid = threadIdx.x, lane = tid & 63, wave = __builtin_amdgcn_readfirstlane(tid >> 6);
    const int G = gridDim.x, bx = blockIdx.x, vcu = (G % 8 == 0) ? (bx % 8) * (G / 8) + bx / 8 : bx;
    unsigned char* ws = a.ws;
    bf16_t* W1T = (bf16_t*)(ws + WS_W1T); bf16_t* WUQT = (bf16_t*)(ws + WS_WUQT); bf16_t* WUKVT = (bf16_t*)(ws + WS_WUKVT); bf16_t* WOT = (bf16_t*)(ws + WS_WOT);
    float* CS = (float*)(ws + WS_CS); float* SSQ = (float*)(ws + WS_SSQ); float* POSF = (float*)(ws + WS_POSF); float* OSS = (float*)(ws + WS_OSS); float* STATS = (float*)(ws + WS_STATS);
    bf16_t* XB = (bf16_t*)(ws + WS_XB); bf16_t* PROJ = (bf16_t*)(ws + WS_PROJ); bf16_t* QB = (bf16_t*)(ws + WS_QB); bf16_t* KVB = (bf16_t*)(ws + WS_KVB);
    bf16_t* IKC = (bf16_t*)(ws + WS_IKC); bf16_t* KRC = (bf16_t*)(ws + WS_KRC); bf16_t* KAC = (bf16_t*)(ws + WS_KAC); bf16_t* VAC = (bf16_t*)(ws + WS_VAC);
    bf16_t* CQC = (bf16_t*)(ws + WS_CQC); bf16_t* CKVC = (bf16_t*)(ws + WS_CKVC); bf16_t* KNC = (bf16_t*)(ws + WS_KNC); bf16_t* VBC = (bf16_t*)(ws + WS_VBC);
    unsigned long long* MASK = (unsigned long long*)(ws + WS_MASK); bf16_t* OAB = (bf16_t*)(ws + WS_OAB); bf16_t* Y = (bf16_t*)(ws + WS_Y);
    const int lo = a.ph_lo, hi_ph = a.ph_hi;
#define IN(k) (lo <= (k) && (k) < hi_ph)
#define SEAM(k) do { if (IN(k) && IN((k) + 1)) { cg::this_grid().sync(); } } while (0)
#define NOSEAM(k) do { if (IN(k) && IN((k) + 1)) { __syncthreads(); } } while (0)
    const int gw = vcu * 8 + wave, NGW = G * 8;
    const size_t gt = (size_t)vcu * 512 + tid, NGT = (size_t)G * 512;

    if (IN(0)) {
        LAS float* scr = (LAS float*)(lds + wave * 16384);
        constexpr int I1 = (1024 / 64) * (NPROJ / 32), I2 = (384 / 64) * (NQB / 32), I3 = (256 / 64) * (NKVB / 32), I4 = (1024 / 64) * (1024 / 32);
        for (int it = gw; it < I1 + I2 + I3 + I4; it += NGW) {
            int r = it;
            if (r < I1) { p0_transpose_item(a.w_in, 1024, D_IN, NPROJ, W1T, 0, nullptr, nullptr, scr, r, lane); continue; } r -= I1;
            if (r < I2) { p0_transpose_item(a.w_uq, 384, NQB, NQB, WUQT, 1, a.g_q, nullptr, scr, r, lane); continue; } r -= I2;
            if (r < I3) { p0_transpose_item(a.w_ukv, 256, NKVB, NKVB, WUKVT, 2, a.g_kv, nullptr, scr, r, lane); continue; } r -= I3;
            p0_transpose_item(a.w_out, 1024, 1024, 1024, WOT, 3, a.g_oa, a.g_ob, scr, r, lane);
        }
        for (size_t c = gt; c < (size_t)M * 128; c += NGT) {
            const f32x4 v0 = *(const f32x4*)(a.x + c * 8), v1 = *(const f32x4*)(a.x + c * 8 + 4);
            *(u32x4*)(XB + c * 8) = (u32x4){cvt_pk_bf16(v0[0], v0[1]), cvt_pk_bf16(v0[2], v0[3]), cvt_pk_bf16(v1[0], v1[1]), cvt_pk_bf16(v1[2], v1[3])};
        }
        for (size_t i = gt; i < (size_t)M * 16; i += NGT) {
            const size_t t = i >> 4; const int k = (int)(i & 15);
            const float p = (float)a.pos[t];
            const float invf = exp2f(-(float)k * 0.8304820237218406f);
            const float ang = p * invf;
            const double ad = (double)ang;
            const double kk = rint(ad * 0.15915494309189535);
            const double r = fma(-kk, 6.283185307179586, ad) - kk * 2.4492935982947064e-16;
            const double r2 = r * r;
            double sn = -8.2206352466243297e-18; sn = fma(sn, r2, 2.8114572543455206e-15); sn = fma(sn, r2, -7.6471637318198165e-13); sn = fma(sn, r2, 1.6059043836821613e-10);
            sn = fma(sn, r2, -2.5052108385441720e-08); sn = fma(sn, r2, 2.7557319223985893e-06); sn = fma(sn, r2, -1.9841269841269841e-04); sn = fma(sn, r2, 8.3333333333333332e-03);
            sn = fma(sn, r2, -1.6666666666666666e-01); sn = fma(sn * r2, r, r);
            double cn = 4.1103176233121648e-19; cn = fma(cn, r2, -1.5619206968586226e-16); cn = fma(cn, r2, 4.7794773323873853e-14); cn = fma(cn, r2, -1.1470745597729725e-11);
            cn = fma(cn, r2, 2.0876756987868099e-09); cn = fma(cn, r2, -2.7557319223985888e-07); cn = fma(cn, r2, 2.4801587301587302e-05); cn = fma(cn, r2, -1.3888888888888889e-03);
            cn = fma(cn, r2, 4.1666666666666664e-02); cn = fma(cn, r2, -0.5); cn = fma(cn, r2, 1.0);
            CS[t * 32 + k] = (float)cn; CS[t * 32 + 16 + k] = (float)sn;
            if (k == 0) POSF[t] = p;
        }
    }
    SEAM(0);
    if (IN(1)) {
        pg8::Gemm g{XB, W1T, M, NPROJ, 1024, 1024}; pg8::StaticOrder So; So.init(M, NPROJ, G, bx);
        EpiProj E{PROJ, CS, SSQ, IKC, KRC, KAC, VAC, CQC, CKVC};
        pg8::gemm_phase<EpiProj>(lds, g, So, E);
    }
    SEAM(1);
    if (IN(2)) {
        { pg8::Gemm g{CQC, WUQT, M, NQB, 384, 384}; pg8::StaticOrder So; So.init(M, NQB, G, bx);
          EpiUp E{QB, NQB, SSQ, 0, 3, 1.0f / 384.0f, CS, 2, nullptr, nullptr};
          pg8::gemm_phase<EpiUp>(lds, g, So, E); }
        { pg8::Gemm g{CKVC, WUKVT, M, NKVB, 256, 256}; pg8::StaticOrder So; So.init(M, NKVB, G, bx);
          EpiUp E{KVB, NKVB, SSQ, 12, 2, 1.0f / 256.0f, CS, -1, KNC, VBC};
          pg8::gemm_phase<EpiUp>(lds, g, So, E); }
    }
    NOSEAM(2);
    if (IN(3)) {
        idx_phase(vcu >> 4, vcu & 15, PROJ, IKC, MASK, lds);
    }
    SEAM(3);
    if (IN(4)) {
        const int bh = vcu >> 1, s = vcu & 1, b = bh >> 3, h = bh & 7;
        for (int i = 0; i < 4; ++i) { const int qa = 2 * i + s; mla_unit(b, h, 15 - qa, QB, KNC, VBC, KRC, OAB, OSS, lds); mla_unit(b, h, qa, QB, KNC, VBC, KRC, OAB, OSS, lds); }
    }
    NOSEAM(4);
    if (IN(5)) {
        const int bg = vcu >> 3, s = vcu & 7, b = bg >> 1, g = bg & 1;
        for (int i = 0; i < 4; ++i) { const int qa = 8 * i + s; dsa_unit(b, g, 63 - qa, PROJ, KAC, VAC, MASK, POSF, OAB, OSS, lds); dsa_unit(b, g, qa, PROJ, KAC, VAC, MASK, POSF, OAB, OSS, lds); }
    }
    SEAM(5);
    if (IN(6)) {
        for (size_t c = gt; c < (size_t)M * 128; c += NGT) {
            const size_t row = c >> 7; const int col = (int)(c & 127) * 8, grp = col >> 9;
            const f32x4 s0 = *(const f32x4*)(OSS + row * 16 + grp * 8), s1 = *(const f32x4*)(OSS + row * 16 + grp * 8 + 4);
            const float rstd = __builtin_amdgcn_rsqf(((s0[0] + s0[1]) + (s0[2] + s0[3]) + (s1[0] + s1[1]) + (s1[2] + s1[3])) * (1.0f / 512.0f) + 1e-6f);
            const u32x4 o = *(const u32x4*)(OAB + row * DM + col), z = *(const u32x4*)(PROJ + row * NPROJ + C_Z + col);
            u32x4 y;
            y.x = cvt_pk_bf16(bf_lo(o.x) * rstd * bf_lo(z.x), bf_hi(o.x) * rstd * bf_hi(z.x)); y.y = cvt_pk_bf16(bf_lo(o.y) * rstd * bf_lo(z.y), bf_hi(o.y) * rstd * bf_hi(z.y));
            y.z = cvt_pk_bf16(bf_lo(o.z) * rstd * bf_lo(z.z), bf_hi(o.z) * rstd * bf_hi(z.z)); y.w = cvt_pk_bf16(bf_lo(o.w) * rstd * bf_lo(z.w), bf_hi(o.w) * rstd * bf_hi(z.w));
            *(u32x4*)(Y + row * DM + col) = y;
        }
    }
    SEAM(6);
    if (IN(7)) {
        pg8::Gemm g{Y, WOT, M, DM, 1024, 1024}; pg8::StaticOrder So; So.init(M, DM, G, bx);
        EpiOut E{a.x, a.out, STATS};
        pg8::gemm_phase<EpiOut>(lds, g, So, E);
    }
    SEAM(7);
    if (IN(8)) {
        for (int row = gw; row < M; row += NGW) {
            float s = 0.f, q = 0.f;
            if (lane < 16) { const f32x2 t = *(const f32x2*)(STATS + (size_t)row * 32 + 2 * lane); s = t.x; q = t.y; }
            s = wave_sum(s); q = wave_sum(q);
            const float mean = s * (1.0f / DM), var = q * (1.0f / DM) - mean * mean, rstd = 1.0f / sqrtf(fmaxf(var, 0.f) + 1e-5f);
            float* orow = a.out + (size_t)row * DM;
#pragma unroll
            for (int jj = 0; jj < 4; ++jj) { const int col = jj * 256 + lane * 4;
                const f32x4 v = *(const f32x4*)(orow + col), gg = *(const f32x4*)(a.ln_g + col), bb = *(const f32x4*)(a.ln_b + col);
                *(f32x4*)(orow + col) = (v - mean) * rstd * gg + bb; }
        }
    }
#undef IN
#undef SEAM
#undef NOSEAM
}

constexpr int N_PHASES = 9;
#ifndef PROBE_PHASE
#define PROBE_PHASE -1
#endif
extern "C" void kernel_launch(void* const* d_in, const int* in_sizes, int n_in, void* d_out, int out_size, void* d_ws, size_t ws_size, hipStream_t stream) {
    static int grid = 0;
    if (grid == 0) {
        if (n_in != 12 || in_sizes[0] != M * DM || out_size != M * DM || ws_size < WS_END) { fprintf(stderr, "kernel_launch: unexpected shapes (n_in %d, in0 %d, out %d, ws %zu)\n", n_in, n_in > 0 ? in_sizes[0] : -1, out_size, ws_size); grid = -1; return; }
        int dev = 0, cus = 0, per_cu = 0;
        if (hipGetDevice(&dev) != hipSuccess || hipDeviceGetAttribute(&cus, hipDeviceAttributeMultiprocessorCount, dev) != hipSuccess) { grid = -1; return; }
        if (hipFuncSetAttribute((const void*)hybrid_fwd, hipFuncAttributeMaxDynamicSharedMemorySize, LDS_BYTES) != hipSuccess) { fprintf(stderr, "kernel_launch: hipFuncSetAttribute failed\n"); grid = -1; return; }
        if (hipOccupancyMaxActiveBlocksPerMultiprocessor(&per_cu, (const void*)hybrid_fwd, 512, LDS_BYTES) != hipSuccess || per_cu < 1) { fprintf(stderr, "kernel_launch: occupancy query says %d\n", per_cu); per_cu = 1; }
        (void)hipGetLastError();
        grid = cus;
        if (grid != 256) fprintf(stderr, "kernel_launch: %d CUs; this kernel's work deals assume 256\n", grid);
    }
    if (grid < 0) return;
    Args a{};
    a.x = (const float*)d_in[0]; a.pos = (const int*)d_in[1]; a.w_in = (const float*)d_in[2]; a.g_q = (const float*)d_in[3]; a.w_uq = (const float*)d_in[4]; a.g_kv = (const float*)d_in[5];
    a.w_ukv = (const float*)d_in[6]; a.g_oa = (const float*)d_in[7]; a.g_ob = (const float*)d_in[8]; a.w_out = (const float*)d_in[9]; a.ln_g = (const float*)d_in[10]; a.ln_b = (const float*)d_in[11];
    a.out = (float*)d_out; a.ws = (unsigned char*)d_ws;
#if MK_N_LAUNCHES == 1
    a.ph_lo = 0; a.ph_hi = N_PHASES;
    void* args[] = {&a};
    hipError_t e = hipLaunchCooperativeKernel((const void*)hybrid_fwd, dim3(grid), dim3(512), args, LDS_BYTES, stream);
    if (e != hipSuccess) fprintf(stderr, "kernel_launch: cooperative launch failed: %s (grid %d)\n", hipGetErrorString(e), grid);
#else
    for (int p = 0; p < N_PHASES; ++p) {
        a.ph_lo = p; a.ph_hi = p + 1;
        for (int rep = 0; rep < ((p == PROBE_PHASE) ? 2 : 1); ++rep) hipLaunchKernelGGL(hybrid_fwd, dim3(grid), dim3(512), LDS_BYTES, stream, a);
    }
#endif
}
```

```cpp
#include <hip/hip_runtime.h>
#include <hip/hip_cooperative_groups.h>
#include <cstdio>
#include <cstdint>
namespace cg = cooperative_groups;

#ifndef MK_N_LAUNCHES
#define MK_N_LAUNCHES 1
#endif

#define LAS __attribute__((address_space(3)))
typedef unsigned short bf16_t;
typedef short bf16x8 __attribute__((ext_vector_type(8)));
typedef short s16x4 __attribute__((ext_vector_type(4)));
typedef float f32x4 __attribute__((ext_vector_type(4)));
typedef float f32x2 __attribute__((ext_vector_type(2)));
typedef float f32x16 __attribute__((ext_vector_type(16)));
typedef unsigned u32x4 __attribute__((ext_vector_type(4)));
typedef unsigned u32x2 __attribute__((ext_vector_type(2)));

constexpr int NB = 16, S = 4096, M = NB * S, DM = 1024;
constexpr int NPROJ = 3072;
constexpr int C_QA = 0, C_KA = 512, C_VA = 640, C_IQ = 768, C_CQ = 1280, C_CKV = 1664, C_IK = 1920, C_KR = 1984, C_IW = 2016, C_Z = 2048;
constexpr int D_IN = 3048;
constexpr int NQB = 768, NKVB = 1024;
constexpr float LOG2E = 1.4426950408889634f;
constexpr float QA_SCALE = 0.125f * LOG2E;
constexpr float QB_SCALE = 0.10206207261596577f * LOG2E;
constexpr float IW_SCALE = 0.04419417382415922f;
constexpr float DN_ALPHA = 1.189207115002721f;
constexpr int KTOP = 256;

constexpr size_t MiB = 1u << 20;
constexpr size_t WS_W1T = 1 * MiB, WS_WUQT = 7 * MiB, WS_WUKVT = 8 * MiB, WS_WOT = 9 * MiB, WS_CS = 11 * MiB, WS_SSQ = 19 * MiB, WS_POSF = 25 * MiB,
                 WS_OSS = 26 * MiB, WS_STATS = 30 * MiB, WS_XB = 64 * MiB, WS_PROJ = 192 * MiB, WS_QB = 576 * MiB, WS_KVB = 672 * MiB, WS_MASK = 800 * MiB,
                 WS_IKC = 832 * MiB, WS_KRC = 840 * MiB, WS_KAC = 848 * MiB, WS_VAC = 864 * MiB, WS_CQC = 880 * MiB, WS_CKVC = 928 * MiB, WS_END = 960 * MiB;
constexpr size_t WS_KNC = WS_KVB, WS_VBC = WS_KVB + 64 * MiB;
constexpr size_t WS_OAB = WS_XB;
constexpr size_t WS_Y = WS_KVB;

constexpr int LDS_BYTES = 132096;

__device__ __forceinline__ unsigned cvt_pk_bf16(float lo, float hi) { unsigned r; asm volatile("v_cvt_pk_bf16_f32 %0, %1, %2" : "=v"(r) : "v"(lo), "v"(hi)); return r; }
__device__ __forceinline__ float bf_lo(unsigned u) { return __uint_as_float(u << 16); }
__device__ __forceinline__ float bf_hi(unsigned u) { return __uint_as_float(u & 0xffff0000u); }
__device__ __forceinline__ int crow(int r, int hi) { return (r & 3) + 8 * (r >> 2) + 4 * hi; }
__device__ __forceinline__ float silu_f(float v) { return v * __builtin_amdgcn_rcpf(1.0f + __builtin_amdgcn_exp2f(-v * LOG2E)); }
__device__ __forceinline__ int lane_id() { return (int)__builtin_amdgcn_mbcnt_hi(~0u, __builtin_amdgcn_mbcnt_lo(~0u, 0u)); }
__device__ __forceinline__ void glds16(const void* g, LAS unsigned char* l) { __builtin_amdgcn_global_load_lds((const unsigned*)g, (LAS unsigned*)l, 16, 0, 0); }

namespace pg8 {
constexpr int BM = 256, BK = 64, HALF = 128, HTB = HALF * BK * 2, STAGE_BYTES = 8 * HTB, NXCD = 8, WGM = 8;
__host__ __device__ __forceinline__ int lds_byte(int r, int c) { const int st = (r >> 4) * 2 + (c >> 5), rr = r & 15, cc = c & 31, ob = rr * 64 + cc * 2; return st * 1024 + (ob ^ (((ob >> 9) & 1) << 5)); }
__host__ __device__ __forceinline__ void stage_rc(int b, int& R, int& C) { const int st = b / 1024, sb = b % 1024, swz = sb ^ (((sb >> 9) & 1) << 5); R = (st >> 1) * 16 + swz / 64; C = (st & 1) * 32 + (swz % 64) / 2; }
__host__ __device__ __forceinline__ int perm32(int rho) { const int n = rho >> 4, i = rho & 15; return 8 * (i >> 2) + 4 * n + (i & 3); }

struct Unit { int pm, pn; };
struct Gemm { const bf16_t* A; const bf16_t* Bt; int M, N, K, lda; };

struct StaticOrder {
    int nM, nN, nwg, G, c;
    __host__ __device__ void init(int M_, int N_, int G_, int c_) { nM = M_ / BM; nN = N_ / BM; nwg = nM * nN; G = G_; c = c_; }
    __host__ __device__ bool next(int i, Unit& u) const {
        const long L = (long)i * G + c; if (L >= nwg) return false;
        int wgid = (int)L; { const int q = nwg / NXCD, r = nwg % NXCD, xcd = wgid % NXCD, off = wgid / NXCD; wgid = (xcd < r ? xcd * (q + 1) : r * (q + 1) + (xcd - r) * q) + off; }
        const int nig = WGM * nN, gid = wgid / nig, fm = gid * WGM, gsz = (nM - fm) < WGM ? (nM - fm) : WGM;
        u.pm = fm + ((wgid % nig) % gsz); u.pn = (wgid % nig) / gsz; return true;
    }
};

template <class Epi>
__device__ __forceinline__ void gemm_phase(LAS unsigned char* lds, const Gemm g, const StaticOrder& S, const Epi& E, const int wid) {
    const int lane = lane_id(), tid = wid * 64 + lane, wr = wid >> 2, wc = wid & 3, fr = lane & 15, fq = lane >> 4;
    const int K = g.K, nt = K / BK, lda = g.lda;
    unsigned voffA[2], voffB[2];
#pragma unroll
    for (int i = 0; i < 2; ++i) { int R, C; stage_rc(tid * 16 + i * 8192, R, C); const int Rb = Epi::PERM ? ((R & ~31) + perm32(R & 31)) : R;
        voffA[i] = (unsigned)(R * lda + C) * 2u; voffB[i] = (unsigned)(Rb * K + C) * 2u; }
    const size_t kstep = (size_t)(BK * 2);
    const size_t hstepA = (size_t)HALF * lda * 2, tstepA = 2 * hstepA;
    const size_t hstepB = (size_t)HALF * K * 2, tstepB = 2 * hstepB;
    const unsigned ldsw = (unsigned)wid * 1024u;
    const int aoff = lds_byte(wr * 64 + fr, fq * 8), boff = lds_byte(wc * 32 + fr, fq * 8);
#define PG8_SA(b, h) (((b) * 2 + (h)) * HTB)
#define PG8_SB(b, h) ((4 + (b) * 2 + (h)) * HTB)
#define PG8_STAGE(bufoff, gbase, voff) do { _Pragma("unroll") for (int _i = 0; _i < 2; ++_i) \
        __builtin_amdgcn_global_load_lds((const unsigned*)((const char*)(gbase) + (voff)[_i]), (LAS unsigned*)(lds + (bufoff) + ldsw + _i * 8192), 16, 0, 0); } while (0)
#define PG8_LDA(dst, b, h) do { _Pragma("unroll") for (int m = 0; m < 4; ++m) _Pragma("unroll") for (int k = 0; k < 2; ++k) dst[m][k] = *(const LAS bf16x8*)(lds + PG8_SA(b, h) + aoff + m * 2048 + k * 1024); } while (0)
#define PG8_LDB(dst, b, h) do { _Pragma("unroll") for (int n = 0; n < 2; ++n) _Pragma("unroll") for (int k = 0; k < 2; ++k) dst[n][k] = *(const LAS bf16x8*)(lds + PG8_SB(b, h) + boff + n * 2048 + k * 1024); } while (0)
#define PG8_MMA(ai, bj, At, Bt) do { __builtin_amdgcn_s_setprio(1); _Pragma("unroll") for (int m = 0; m < 4; ++m) _Pragma("unroll") for (int n = 0; n < 2; ++n) _Pragma("unroll") for (int k = 0; k < 2; ++k) \
        acc[ai][bj][m][n] = __builtin_amdgcn_mfma_f32_16x16x32_bf16(Bt[n][k], At[m][k], acc[ai][bj][m][n], 0, 0, 0); __builtin_amdgcn_s_setprio(0); } while (0)
#define PG8_WAIT_V(n) asm volatile("s_waitcnt vmcnt(" #n ")" ::: "memory")
#define PG8_WAIT_L(n) asm volatile("s_waitcnt lgkmcnt(" #n ")" ::: "memory")
#define PG8_BAR __builtin_amdgcn_s_barrier()
#define PG8_SCHED __builtin_amdgcn_sched_barrier(0)
    Unit cur, nxt; int ui = 0;
    if (!S.next(0, cur)) return;
    f32x4 acc[2][2][4][2];
#pragma unroll
    for (int a = 0; a < 2; ++a)
#pragma unroll
        for (int b = 0; b < 2; ++b)
#pragma unroll
            for (int m = 0; m < 4; ++m)
#pragma unroll
                for (int n = 0; n < 2; ++n) acc[a][b][m][n] = (f32x4){0.f, 0.f, 0.f, 0.f};
    bf16x8 At[4][2], B0[2][2], B1[2][2];
    const char* cA = (const char*)g.A + (size_t)cur.pm * tstepA; const char* cB = (const char*)g.Bt + (size_t)cur.pn * tstepB;
    PG8_STAGE(PG8_SB(0, 0), cB, voffB); PG8_STAGE(PG8_SB(0, 1), cB + hstepB, voffB); PG8_STAGE(PG8_SA(0, 0), cA, voffA); PG8_STAGE(PG8_SA(0, 1), cA + hstepA, voffA);
    if (wr == 1) PG8_BAR;
    PG8_WAIT_V(2); PG8_BAR;
    PG8_STAGE(PG8_SB(1, 0), cB + kstep, voffB); PG8_STAGE(PG8_SA(1, 0), cA + kstep, voffA); PG8_STAGE(PG8_SB(1, 1), cB + hstepB + kstep, voffB);
    PG8_WAIT_V(6); PG8_BAR;
    for (;;) {
        const bool has_next = S.next(ui + 1, nxt);
        const char* nA = has_next ? (const char*)g.A + (size_t)nxt.pm * tstepA : cA; const char* nB = has_next ? (const char*)g.Bt + (size_t)nxt.pn * tstepB : cB;
        for (int t = 0; t < nt; t += 2) {
            const bool last = (t == nt - 2);
            const char* a1 = cA + (size_t)(t + 1) * kstep;
            const char* a2 = last ? nA : cA + (size_t)(t + 2) * kstep; const char* b2 = last ? nB : cB + (size_t)(t + 2) * kstep;
            const char* a3 = a2 + kstep; const char* b3 = b2 + kstep;
            PG8_LDB(B0, 0, 0); PG8_LDB(B1, 0, 1); PG8_SCHED; PG8_LDA(At, 0, 0); PG8_STAGE(PG8_SA(1, 1), a1 + hstepA, voffA);
            PG8_WAIT_V(8); PG8_WAIT_L(0); PG8_BAR; PG8_MMA(0, 0, At, B0); PG8_MMA(0, 1, At, B1); PG8_BAR; PG8_SCHED;
            PG8_LDA(At, 0, 1); PG8_STAGE(PG8_SB(0, 0), b2, voffB); PG8_STAGE(PG8_SB(0, 1), b2 + hstepB, voffB); PG8_STAGE(PG8_SA(0, 0), a2, voffA);
            PG8_WAIT_V(8); PG8_WAIT_L(0); PG8_BAR; PG8_MMA(1, 0, At, B0); PG8_MMA(1, 1, At, B1); PG8_BAR; PG8_SCHED;
            PG8_LDB(B0, 1, 0); PG8_LDB(B1, 1, 1); PG8_SCHED; PG8_LDA(At, 1, 0); PG8_STAGE(PG8_SA(0, 1), a2 + hstepA, voffA);
            PG8_WAIT_V(8); PG8_WAIT_L(0); PG8_BAR; PG8_MMA(0, 0, At, B0); PG8_MMA(0, 1, At, B1); PG8_BAR; PG8_SCHED;
            PG8_LDA(At, 1, 1); PG8_STAGE(PG8_SB(1, 0), b3, voffB); PG8_STAGE(PG8_SB(1, 1), b3 + hstepB, voffB); PG8_STAGE(PG8_SA(1, 0), a3, voffA);
            PG8_WAIT_V(8); PG8_WAIT_L(0); PG8_BAR; PG8_MMA(1, 0, At, B0); PG8_MMA(1, 1, At, B1); PG8_BAR; PG8_SCHED;
        }
        if (wr == 0) PG8_BAR;
        E(acc, cur, wr, wc, fr, fq);
        if (!has_next) break;
#pragma unroll
        for (int a = 0; a < 2; ++a)
#pragma unroll
            for (int b = 0; b < 2; ++b)
#pragma unroll
                for (int m = 0; m < 4; ++m)
#pragma unroll
                    for (int n = 0; n < 2; ++n) acc[a][b][m][n] = (f32x4){0.f, 0.f, 0.f, 0.f};
        cur = nxt; cA = nA; cB = nB; ++ui;
        if (wr == 1) PG8_BAR;
    }
    PG8_WAIT_V(0);
    PG8_BAR;
#undef PG8_SA
#undef PG8_SB
#undef PG8_STAGE
#undef PG8_LDA
#undef PG8_LDB
#undef PG8_MMA
#undef PG8_WAIT_V
#undef PG8_WAIT_L
#undef PG8_BAR
#undef PG8_SCHED
}
}

__device__ __forceinline__ int lane_id_nohoist() { int l; asm volatile("v_mbcnt_lo_u32_b32 %0, -1, 0\n\tv_mbcnt_hi_u32_b32 %0, -1, %0" : "=v"(l)); return l; }

__device__ __forceinline__ void rope8(f32x4& v0, f32x4& v1, const float* csrow, int fq) {
    const f32x4 c = *(const f32x4*)(csrow + 4 * fq), s = *(const f32x4*)(csrow + 16 + 4 * fq);
    const float a0 = v0[0] * c[0] - v0[1] * s[0], b0 = v0[0] * s[0] + v0[1] * c[0];
    const float a1 = v0[2] * c[1] - v0[3] * s[1], b1 = v0[2] * s[1] + v0[3] * c[1];
    const float a2 = v1[0] * c[2] - v1[1] * s[2], b2 = v1[0] * s[2] + v1[1] * c[2];
    const float a3 = v1[2] * c[3] - v1[3] * s[3], b3 = v1[2] * s[3] + v1[3] * c[3];
    v0 = (f32x4){a0, b0, a1, b1}; v1 = (f32x4){a2, b2, a3, b3};
}
__device__ __forceinline__ void store8(bf16_t* p, const f32x4& v0, const f32x4& v1) {
    u32x4 w; w.x = cvt_pk_bf16(v0[0], v0[1]); w.y = cvt_pk_bf16(v0[2], v0[3]); w.z = cvt_pk_bf16(v1[0], v1[1]); w.w = cvt_pk_bf16(v1[2], v1[3]);
    *(u32x4*)p = w;
}

struct EpiProj {
    static constexpr bool PERM = true;
    bf16_t* P; const float* cs; float* ssq; bf16_t* IKC; bf16_t* KRC; bf16_t* KAC; bf16_t* VAC; bf16_t* CQC; bf16_t* CKVC;
    __device__ __forceinline__ void operator()(const f32x4 (&acc)[2][2][4][2], const pg8::Unit& u, int wr, int wc, int fr_, int fq_) const {
        const int l_ = lane_id_nohoist(), fr = l_ & 15, fq = l_ >> 4;
        const int row0 = u.pm * 256 + wr * 64 + fr, colt = u.pn * 256 + wc * 32 + 8 * fq, pn = u.pn;
#pragma unroll
        for (int ai = 0; ai < 2; ++ai)
#pragma unroll
            for (int m = 0; m < 4; ++m) {
                const int row = row0 + ai * 128 + m * 16; bf16_t* rowp = P + (size_t)row * NPROJ + colt;
#pragma unroll
                for (int bj = 0; bj < 2; ++bj) {
                    f32x4 v0 = acc[ai][bj][m][0], v1 = acc[ai][bj][m][1];
                    bf16_t* dst = rowp + bj * 128;
                    if (pn >= 8) {
#pragma unroll
                        for (int j = 0; j < 4; ++j) { v0[j] = silu_f(v0[j]); v1[j] = silu_f(v1[j]); }
                    } else if (pn == 2) {
                        const size_t tb = (size_t)((row >> 12) * 2 + (wc >> 1)) * 64 + ((row & 4095) >> 6); const int k = row & 63;
                        dst = (bj == 0) ? KAC + (tb * 8 + 4 * (wc & 1) + fq) * 512 + k * 8 : VAC + (tb * 2 + (wc & 1)) * 2048 + k * 32 + 8 * fq;
                    } else if (pn >= 5) {
                        int slot = -1;
                        if (pn == 5) { slot = bj * 4 + wc; dst = CQC + (size_t)row * 384 + bj * 128 + wc * 32 + 8 * fq; }
                        else if (pn == 6) { if (bj == 0) { slot = 8 + wc; dst = CQC + (size_t)row * 384 + 256 + wc * 32 + 8 * fq; } else { slot = 12 + wc; dst = CKVC + (size_t)row * 256 + wc * 32 + 8 * fq; } }
                        else if (bj == 0) { slot = 16 + wc; dst = CKVC + (size_t)row * 256 + 128 + wc * 32 + 8 * fq; }
                        if (slot >= 0) {
                            float s = (v0[0] * v0[0] + v0[1] * v0[1]) + (v0[2] * v0[2] + v0[3] * v0[3]) + (v1[0] * v1[0] + v1[1] * v1[1]) + (v1[2] * v1[2] + v1[3] * v1[3]);
                            s += __shfl_xor(s, 16); s += __shfl_xor(s, 32);
                            if (fq == 0) ssq[(size_t)row * 20 + slot] = s;
                        } else if (wc < 2) dst = IKC + ((size_t)(row >> 5) * 8 + 4 * wc + fq) * 256 + (row & 31) * 8;
                        else if (wc == 2) { rope8(v0, v1, cs + (size_t)row * 32, fq); dst = KRC + ((size_t)(row >> 6) * 4 + fq) * 512 + (row & 63) * 8; }
                    }
                    store8(dst, v0, v1);
                }
                asm volatile("" ::: "memory");
            }
    }
};
struct EpiUp {
    static constexpr bool PERM = true;
    bf16_t* O; int ldc; const float* ssq; int slot0, nslot4; float invK; const float* cs; int rope_pn; bf16_t* HK; bf16_t* HV;
    __device__ __forceinline__ void operator()(const f32x4 (&acc)[2][2][4][2], const pg8::Unit& u, int wr, int wc, int fr_, int fq_) const {
        const int l_ = lane_id_nohoist(), fr = l_ & 15, fq = l_ >> 4;
        const int row0 = u.pm * 256 + wr * 64 + fr, colt = u.pn * 256 + wc * 32 + 8 * fq;
#pragma unroll
        for (int ai = 0; ai < 2; ++ai)
#pragma unroll
            for (int m = 0; m < 4; ++m) {
                const int row = row0 + ai * 128 + m * 16; bf16_t* rowp = O + (size_t)row * ldc + colt;
                float ss = 0.f;
                for (int q = 0; q < nslot4; ++q) { const f32x4 t = *(const f32x4*)(ssq + (size_t)row * 20 + slot0 + 4 * q); ss += (t[0] + t[1]) + (t[2] + t[3]); }
                const float rstd = __builtin_amdgcn_rsqf(ss * invK + 1e-6f);
#pragma unroll
                for (int bj = 0; bj < 2; ++bj) {
                    f32x4 v0 = acc[ai][bj][m][0] * rstd, v1 = acc[ai][bj][m][1] * rstd;
                    if (u.pn == rope_pn) rope8(v0, v1, cs + (size_t)row * 32, fq);
                    bf16_t* dst = rowp + bj * 128;
                    if (HK) { const int h = 4 * (u.pn & 1) + 2 * bj + (wc >> 1);
                        const size_t tb = (size_t)((row >> 12) * 8 + h) * 64 + ((row & 4095) >> 6); const int k = row & 63;
                        dst = (u.pn < 2) ? HK + (tb * 8 + 4 * (wc & 1) + fq) * 512 + k * 8 : HV + (tb * 2 + (wc & 1)) * 2048 + k * 32 + 8 * fq; }
                    store8(dst, v0, v1);
                }
                asm volatile("" ::: "memory");
            }
    }
};
struct EpiOut {
    static constexpr bool PERM = false;
    const float* x; float* out; float* stats;
    __device__ __forceinline__ void operator()(const f32x4 (&acc)[2][2][4][2], const pg8::Unit& u, int wr, int wc, int fr_, int fq_) const {
        const int l_ = lane_id_nohoist(), fr = l_ & 15, fq = l_ >> 4;
        const int row0 = u.pm * 256 + wr * 64 + fr, col0 = u.pn * 256 + wc * 32 + 4 * fq;
#pragma unroll
        for (int ai = 0; ai < 2; ++ai)
#pragma unroll
            for (int m = 0; m < 4; ++m) {
                const int row = row0 + ai * 128 + m * 16; const size_t off = (size_t)row * DM + col0;
                float s = 0.f, q = 0.f;
#pragma unroll
                for (int bj = 0; bj < 2; ++bj)
#pragma unroll
                    for (int n = 0; n < 2; ++n) {
                        const f32x4 xv = *(const f32x4*)(x + off + bj * 128 + n * 16);
                        const f32x4 v = xv * DN_ALPHA + acc[ai][bj][m][n];
                        s += (v[0] + v[1]) + (v[2] + v[3]); q += (v[0] * v[0] + v[1] * v[1]) + (v[2] * v[2] + v[3] * v[3]);
                        *(f32x4*)(out + off + bj * 128 + n * 16) = v;
                    }
                s += __shfl_xor(s, 16); s += __shfl_xor(s, 32); q += __shfl_xor(q, 16); q += __shfl_xor(q, 32);
                if (fq == 0) *(f32x2*)(stats + (size_t)row * 32 + (u.pn * 4 + wc) * 2) = (f32x2){s, q};
            }
    }
};

constexpr int AT_KB = 12288, AT_VOFF = 3 * AT_KB, AT_VB = 8192, AT_POS = 8192, AT_MSK = 8448;
__device__ __forceinline__ s16x4 vtr(const LAS unsigned char* p) {
    typedef short v4i16_t __attribute__((ext_vector_type(4)));
    return __builtin_bit_cast(s16x4, __builtin_amdgcn_ds_read_tr16_b64_v4i16((LAS v4i16_t*)p));
}
typedef __bf16 bf16x2_t __attribute__((ext_vector_type(2)));
__device__ __forceinline__ unsigned cvtpk(float lo, float hi) { f32x2 v = {lo, hi}; bf16x2_t bb = __builtin_convertvector(v, bf16x2_t); return __builtin_bit_cast(unsigned, bb); }
__device__ __forceinline__ float swap32_max(float x) { auto r = __builtin_amdgcn_permlane32_swap(__float_as_uint(x), __float_as_uint(x), false, false); return fmaxf(__uint_as_float(r[0]), __uint_as_float(r[1])); }
__device__ __forceinline__ float swap32_sum(float x) { auto r = __builtin_amdgcn_permlane32_swap(__float_as_uint(x), __float_as_uint(x), false, false); return __uint_as_float(r[0]) + __uint_as_float(r[1]); }
__device__ __forceinline__ void dma16(const void* gsrc, unsigned lds_dst) { unsigned keep;
    asm volatile("s_mov_b32 %0, m0\n\ts_mov_b32 m0, %2\n\ts_nop 0\n\tglobal_load_lds_dwordx4 %1, off\n\ts_mov_b32 m0, %0" : "=&s"(keep) : "v"(gsrc), "s"(lds_dst) : "memory"); }
__device__ __forceinline__ void dma4(const void* gsrc, unsigned lds_dst) { unsigned keep;
    asm volatile("s_mov_b32 %0, m0\n\ts_mov_b32 m0, %2\n\ts_nop 0\n\tglobal_load_lds_dword %1, off\n\ts_mov_b32 m0, %0" : "=&s"(keep) : "v"(gsrc), "s"(lds_dst) : "memory"); }
#define AT_SYNC() asm volatile("s_waitcnt vmcnt(0) lgkmcnt(0)\n\ts_barrier" ::: "memory")

constexpr int AT_BUF = AT_KB + AT_VB;
constexpr float AT_THR = 8.0f;
constexpr int AT_MSK2 = AT_MSK + 1024;
template <int MODE>
__device__ __forceinline__ void attn_core(const bf16x8 (&qf)[2][6], const int NT, const int tlast, const int tqa, const int tqb, const bf16_t* ksrc, const bf16_t* rsrc, const bf16_t* vsrc,
                                          const unsigned long long* msrc, const float* psrc, const float pta, const float ptb, const float nslope, const int qja, const int qjb,
                                          LAS unsigned char* lds, const int wid, const int lane, f32x16 (&oT)[2][2], float (&l_out)[2]) {
    constexpr int NKS = (MODE == 0) ? 6 : 4;
    const int r32 = lane & 31, hi = lane >> 5;
    const int vboff = ((lane >> 4) & 1) * 32 + (lane & 3) * 8 + (4 * hi + ((lane & 15) >> 2)) * 64;
    const unsigned lds0 = (unsigned)(uintptr_t)lds;
#define AT_DMA(t, bsel) do { const unsigned _b = lds0 + (bsel) * AT_BUF; \
        dma16(ksrc + (size_t)(t) * 4096, (unsigned)__builtin_amdgcn_readfirstlane(_b + wid * 1024)); \
        if (MODE == 0) { if (wid >= 4) dma16(rsrc + (size_t)(t) * 2048, (unsigned)__builtin_amdgcn_readfirstlane(_b + (8 + (wid & 3)) * 1024)); } \
        else { if (wid == 0) dma4(psrc + (size_t)(t) * 64, (unsigned)__builtin_amdgcn_readfirstlane(_b + AT_POS)); \
               if (wid == 1) dma16(msrc + (size_t)(t) * 64, (unsigned)__builtin_amdgcn_readfirstlane(_b + AT_MSK)); } \
        dma16(vsrc + (size_t)(t) * 4096, (unsigned)__builtin_amdgcn_readfirstlane(_b + AT_KB + wid * 1024)); } while (0)
#define AT_SOFTMAX(p0, p1, o, mref, l, first) do { \
        float a = fmaxf(fmaxf(p0[0], p1[0]), p0[1]), bq = fmaxf(fmaxf(p1[1], p0[2]), p1[2]); \
        _Pragma("unroll") for (int r = 3; r < 15; r += 2) { a = fmaxf(fmaxf(a, p0[r]), p1[r]); bq = fmaxf(fmaxf(bq, p0[r + 1]), p1[r + 1]); } \
        const float mx = swap32_max(fmaxf(fmaxf(a, bq), fmaxf(p0[15], p1[15]))) - mref; \
        const bool mv = first ? (mx > -INFINITY) : (mx > AT_THR); \
        if (__any(mv)) { const float dl = (mx > -INFINITY && (first || mx > 0.f)) ? mx : 0.f; mref += dl; const float f = first ? 0.f : __builtin_amdgcn_exp2f(-dl); \
            _Pragma("unroll") for (int r = 0; r < 16; ++r) { o[0][r] *= f; o[1][r] *= f; } \
            l *= f; if (mx > -INFINITY) first = false; } \
        float sacc = 0.f; \
        _Pragma("unroll") for (int r = 0; r < 16; ++r) { p0[r] = __builtin_amdgcn_exp2f(p0[r] - mref); p1[r] = __builtin_amdgcn_exp2f(p1[r] - mref); sacc += p0[r] + p1[r]; } \
        l += sacc; } while (0)
#define AT_PACK(pw, p0, p1) _Pragma("unroll") for (int s4 = 0; s4 < 4; ++s4) { const f32x16& p = (s4 < 2) ? p0 : p1; const int o = 8 * (s4 & 1); \
            pw[s4] = (u32x4){cvtpk(p[o], p[o + 1]), cvtpk(p[o + 2], p[o + 3]), cvtpk(p[o + 4], p[o + 5]), cvtpk(p[o + 6], p[o + 7])}; }
    float mrefa = 0.f, mrefb = 0.f, la = 0.f, lb = 0.f; bool firsta = true, firstb = true;
    oT[0][0] = f32x16{}; oT[0][1] = f32x16{}; oT[1][0] = f32x16{}; oT[1][1] = f32x16{};
    AT_DMA(0, 0);
    AT_SYNC();
    for (int t = 0; t < NT; ++t) {
        const int cur = t & 1;
        if (t + 1 < NT) AT_DMA(t + 1, cur ^ 1);
        if (t <= tlast) {
        const LAS unsigned char* buf = lds + cur * AT_BUF;
        f32x16 pa0 = f32x16{}, pa1 = f32x16{}, pb0 = f32x16{}, pb1 = f32x16{};
        { const LAS unsigned char* kb = buf + hi * 1024 + r32 * 16;
#pragma unroll
          for (int d0 = 0; d0 < NKS; ++d0) { const bf16x8 a0 = *(const LAS bf16x8*)(kb + d0 * 2048), a1 = *(const LAS bf16x8*)(kb + d0 * 2048 + 512);
              pa0 = __builtin_amdgcn_mfma_f32_32x32x16_bf16(a0, qf[0][d0], pa0, 0, 0, 0); pa1 = __builtin_amdgcn_mfma_f32_32x32x16_bf16(a1, qf[0][d0], pa1, 0, 0, 0);
              pb0 = __builtin_amdgcn_mfma_f32_32x32x16_bf16(a0, qf[1][d0], pb0, 0, 0, 0); pb1 = __builtin_amdgcn_mfma_f32_32x32x16_bf16(a1, qf[1][d0], pb1, 0, 0, 0); } }
        if (MODE == 0) {
            if (t * 64 + 63 > tqa - r32) { const int kb0 = t * 64 + 4 * hi;
#pragma unroll
                for (int r = 0; r < 16; ++r) { const int ks = kb0 + (r & 3) + 8 * (r >> 2);
                    if (ks > tqa) pa0[r] = -INFINITY; if (ks + 32 > tqa) pa1[r] = -INFINITY; if (ks > tqb) pb0[r] = -INFINITY; if (ks + 32 > tqb) pb1[r] = -INFINITY; } }
        } else {
            const u32x2 mwa = *(const LAS u32x2*)(buf + AT_MSK + qja * 8), mwb = *(const LAS u32x2*)(buf + AT_MSK + qjb * 8);
            const unsigned wa0 = ~(mwa.x >> (4 * hi)), wa1 = ~(mwa.y >> (4 * hi)), wb0 = ~(mwb.x >> (4 * hi)), wb1 = ~(mwb.y >> (4 * hi));
#pragma unroll
            for (int c = 0; c < 4; ++c) { const f32x4 k0 = *(const LAS f32x4*)(buf + AT_POS + (4 * hi + 8 * c) * 4), k1 = *(const LAS f32x4*)(buf + AT_POS + (32 + 4 * hi + 8 * c) * 4);
#pragma unroll
                for (int j = 0; j < 4; ++j) { const int r = 4 * c + j;
                    pa0[r] = __builtin_fmaf(nslope, __builtin_fabsf(pta - k0[j]), pa0[r]) + __uint_as_float((unsigned)__builtin_amdgcn_sbfe((int)wa0, 8 * c + j, 1) & 0xff800000u);
                    pa1[r] = __builtin_fmaf(nslope, __builtin_fabsf(pta - k1[j]), pa1[r]) + __uint_as_float((unsigned)__builtin_amdgcn_sbfe((int)wa1, 8 * c + j, 1) & 0xff800000u);
                    pb0[r] = __builtin_fmaf(nslope, __builtin_fabsf(ptb - k0[j]), pb0[r]) + __uint_as_float((unsigned)__builtin_amdgcn_sbfe((int)wb0, 8 * c + j, 1) & 0xff800000u);
                    pb1[r] = __builtin_fmaf(nslope, __builtin_fabsf(ptb - k1[j]), pb1[r]) + __uint_as_float((unsigned)__builtin_amdgcn_sbfe((int)wb1, 8 * c + j, 1) & 0xff800000u); } }
        }
        AT_SOFTMAX(pa0, pa1, oT[0], mrefa, la, firsta);
        AT_SOFTMAX(pb0, pb1, oT[1], mrefb, lb, firstb);
        u32x4 pwa[4], pwb[4];
        AT_PACK(pwa, pa0, pa1)
        AT_PACK(pwb, pb0, pb1)
        { const LAS unsigned char* vbase = buf + AT_KB + vboff;
#pragma unroll
          for (int d0 = 0; d0 < 2; ++d0)
#pragma unroll
              for (int s4 = 0; s4 < 4; ++s4) {
                  const s16x4 vlo = vtr(vbase + d0 * 4096 + s4 * 1024), vhi = vtr(vbase + d0 * 4096 + s4 * 1024 + 512);
                  const bf16x8 vf = (bf16x8){vlo[0], vlo[1], vlo[2], vlo[3], vhi[0], vhi[1], vhi[2], vhi[3]};
                  oT[0][d0] = __builtin_amdgcn_mfma_f32_32x32x16_bf16(vf, __builtin_bit_cast(bf16x8, pwa[s4]), oT[0][d0], 0, 0, 0);
                  oT[1][d0] = __builtin_amdgcn_mfma_f32_32x32x16_bf16(vf, __builtin_bit_cast(bf16x8, pwb[s4]), oT[1][d0], 0, 0, 0);
              } }
        }
        AT_SYNC();
    }
    l_out[0] = la; l_out[1] = lb;
#undef AT_DMA
#undef AT_SOFTMAX
#undef AT_PACK
}
__device__ __forceinline__ void attn_store(const f32x16 (&oT)[2], float l, bf16_t* orow, float* ossp, int hi) {
    l = swap32_sum(l);
    const float inv = 1.0f / l;
    float ssq = 0.f;
#pragma unroll
    for (int d0 = 0; d0 < 2; ++d0)
#pragma unroll
        for (int c = 0; c < 4; ++c) {
            const float a = oT[d0][4 * c] * inv, b = oT[d0][4 * c + 1] * inv, cc = oT[d0][4 * c + 2] * inv, d = oT[d0][4 * c + 3] * inv;
            ssq += (a * a + b * b) + (cc * cc + d * d);
            *(u32x2*)(orow + 32 * d0 + 8 * c + 4 * hi) = (u32x2){cvtpk(a, b), cvtpk(cc, d)};
        }
    ssq = swap32_sum(ssq);
    if (hi == 0) *ossp = ssq;
}

__device__ __forceinline__ void mla_unit(int b, int h, int qb, const bf16_t* QB, const bf16_t* KNC, const bf16_t* VBC, const bf16_t* KRC, bf16_t* OAB, float* OSS, LAS unsigned char* lds, const int wid) {
    const int lane = lane_id(), r32 = lane & 31, hi = lane >> 5;
    const size_t rowbase = (size_t)b * S; const int q0 = qb * 512, tqa = q0 + wid * 64 + r32, tqb = tqa + 32;
    const size_t hb = ((size_t)(b * 8 + h) * S) * 64;
    bf16x8 qf[2][6];
#pragma unroll
    for (int c = 0; c < 2; ++c) { const bf16_t* qrow = QB + (rowbase + tqa + 32 * c) * NQB;
#pragma unroll
      for (int d0 = 0; d0 < 4; ++d0) qf[c][d0] = *(const bf16x8*)(qrow + h * 64 + d0 * 16 + hi * 8);
#pragma unroll
      for (int d0 = 4; d0 < 6; ++d0) qf[c][d0] = *(const bf16x8*)(qrow + 512 + h * 32 + (d0 - 4) * 16 + hi * 8); }
    f32x16 oT[2][2]; float l[2];
    attn_core<0>(qf, 8 * (qb + 1), (q0 + wid * 64 + 63) >> 6, tqa, tqb, KNC + hb + wid * 512 + lane * 8, KRC + rowbase * 32 + (wid & 3) * 512 + lane * 8, VBC + hb + wid * 512 + lane * 8,
                 nullptr, nullptr, 0.f, 0.f, 0.f, 0, 0, lds, wid, lane, oT, l);
    attn_store(oT[0], l[0], OAB + (rowbase + tqa) * DM + 512 + h * 64, OSS + (rowbase + tqa) * 16 + 8 + h, hi);
    attn_store(oT[1], l[1], OAB + (rowbase + tqb) * DM + 512 + h * 64, OSS + (rowbase + tqb) * 16 + 8 + h, hi);
}
__device__ __forceinline__ void dsa_unit(int b, int g, int qb, const bf16_t* PROJ, const bf16_t* KAC, const bf16_t* VAC, const unsigned long long* MASKT, const float* POSF, bf16_t* OAB, float* OSS, LAS unsigned char* lds, const int wid) {
    const int lane = lane_id(), r32 = lane & 31, hi = lane >> 5;
    const size_t rowbase = (size_t)b * S; const int q0 = qb * 128, qja = wid * 16 + (r32 >> 2), qjb = qja + 8, tqa = q0 + qja, tqb = q0 + qjb, head = 4 * g + (r32 & 3);
    const size_t gb = ((size_t)(b * 2 + g) * S) * 64;
    bf16x8 qf[2][6];
#pragma unroll
    for (int c = 0; c < 2; ++c) { const bf16_t* qrow = PROJ + (rowbase + tqa + 8 * c) * NPROJ + C_QA + head * 64;
#pragma unroll
      for (int d0 = 0; d0 < 4; ++d0) qf[c][d0] = *(const bf16x8*)(qrow + d0 * 16 + hi * 8);
      qf[c][4] = qf[c][0]; qf[c][5] = qf[c][0]; }
    const float pta = POSF[rowbase + tqa], ptb = POSF[rowbase + tqb];
    const float nslope = -__builtin_amdgcn_exp2f(-(float)(head + 1)) * LOG2E;
    f32x16 oT[2][2]; float l[2];
    attn_core<1>(qf, 2 * (qb + 1), (q0 + wid * 16 + 15) >> 6, tqa, tqb, KAC + gb + wid * 512 + lane * 8, nullptr, VAC + gb + wid * 512 + lane * 8,
                 MASKT + ((size_t)(b * 64 + 2 * qb) * 64) * 64 + (lane >> 5) * 4096 + (lane & 31) * 2, POSF + rowbase + lane, pta, ptb, nslope, qja, qjb, lds, wid, lane, oT, l);
    attn_store(oT[0], l[0], OAB + (rowbase + tqa) * DM + head * 64, OSS + (rowbase + tqa) * 16 + head, hi);
    attn_store(oT[1], l[1], OAB + (rowbase + tqb) * DM + head * 64, OSS + (rowbase + tqb) * 16 + head, hi);
}

__device__ __forceinline__ int wave_sum_i(int x) {
    x += __builtin_amdgcn_update_dpp(0, x, 0xB1, 0xf, 0xf, true);
    x += __builtin_amdgcn_update_dpp(0, x, 0x4E, 0xf, 0xf, true);
    x += __builtin_amdgcn_update_dpp(0, x, 0x141, 0xf, 0xf, true);
    x += __builtin_amdgcn_update_dpp(0, x, 0x140, 0xf, 0xf, true);
    { auto r = __builtin_amdgcn_permlane16_swap((unsigned)x, (unsigned)x, false, false); x = (int)(r[0] + r[1]); }
    { auto r = __builtin_amdgcn_permlane32_swap((unsigned)x, (unsigned)x, false, false); x = (int)(r[0] + r[1]); }
    return __builtin_amdgcn_readfirstlane(x);
}
__device__ __forceinline__ float wave_max_f(float x) {
    x = fmaxf(x, __uint_as_float(__builtin_amdgcn_update_dpp(0, __float_as_uint(x), 0xB1, 0xf, 0xf, true)));
    x = fmaxf(x, __uint_as_float(__builtin_amdgcn_update_dpp(0, __float_as_uint(x), 0x4E, 0xf, 0xf, true)));
    x = fmaxf(x, __uint_as_float(__builtin_amdgcn_update_dpp(0, __float_as_uint(x), 0x141, 0xf, 0xf, true)));
    x = fmaxf(x, __uint_as_float(__builtin_amdgcn_update_dpp(0, __float_as_uint(x), 0x140, 0xf, 0xf, true)));
    { auto r = __builtin_amdgcn_permlane16_swap(__float_as_uint(x), __float_as_uint(x), false, false); x = fmaxf(__uint_as_float(r[0]), __uint_as_float(r[1])); }
    { auto r = __builtin_amdgcn_permlane32_swap(__float_as_uint(x), __float_as_uint(x), false, false); x = fmaxf(__uint_as_float(r[0]), __uint_as_float(r[1])); }
    return __uint_as_float(__builtin_amdgcn_readfirstlane(__float_as_uint(x)));
}
#define SEL_GE(cnt, xv, thr) asm volatile("v_cmp_ge_f32 vcc, %1, %2\n\tv_addc_co_u32 %0, vcc, 0, %0, vcc" : "+v"(cnt) : "v"(xv), "v"(thr) : "vcc")
#define SEL_GT(cnt, xv, thr) asm volatile("v_cmp_gt_f32 vcc, %1, %2\n\tv_addc_co_u32 %0, vcc, 0, %0, vcc" : "+v"(cnt) : "v"(xv), "v"(thr) : "vcc")
__device__ __forceinline__ void select_row(int t, const LAS float* sc, unsigned long long* mrow, int lane) {
    const int n = t + 1;
    if (n <= KTOP) {
        const int cnt = n - 64 * lane;
        mrow[(size_t)lane * 64] = cnt >= 64 ? ~0ull : (cnt <= 0 ? 0ull : ((1ull << cnt) - 1ull));
        return;
    }
    const int nreg = (n + 63) >> 6;
    float xv[64];
#define SEL_LD16(base) _Pragma("unroll") for (int i = (base); i < (base) + 16; ++i) xv[i] = sc[64 * i + lane];
#define SEL_NO16(base) _Pragma("unroll") for (int i = (base); i < (base) + 16; ++i) xv[i] = -INFINITY;
    SEL_LD16(0)
    if (nreg > 16) { SEL_LD16(16) } else { SEL_NO16(16) }
    if (nreg > 32) { SEL_LD16(32) } else { SEL_NO16(32) }
    if (nreg > 48) { SEL_LD16(48) } else { SEL_NO16(48) }
#undef SEL_LD16
#undef SEL_NO16
    float mx = -INFINITY, mn = INFINITY;
    const int nl = n - lane;
#define SEL_MM16(base) _Pragma("unroll") for (int i = (base); i < (base) + 16; ++i) { const bool ok = 64 * i < nl; const float v = xv[i]; xv[i] = ok ? v : -INFINITY; mx = fmaxf(mx, xv[i]); mn = fminf(mn, ok ? v : INFINITY); }
    SEL_MM16(0) if (nreg > 16) { SEL_MM16(16) } if (nreg > 32) { SEL_MM16(32) } if (nreg > 48) { SEL_MM16(48) }
#undef SEL_MM16
    mx = wave_max_f(mx); mn = -wave_max_f(-mn);
#define SEL_CNT16(base, MAC, V) _Pragma("unroll") for (int i = (base); i < (base) + 16; ++i) MAC(c, xv[i], V);
#define SEL_COUNT(MAC, V) do { c = 0; SEL_CNT16(0, MAC, V) if (nreg > 16) { SEL_CNT16(16, MAC, V) } if (nreg > 32) { SEL_CNT16(32, MAC, V) } if (nreg > 48) { SEL_CNT16(48, MAC, V) } c = wave_sum_i(c); } while (0)
    int c;
    float lo = mn, hi = mx, theta = mx; bool exact = false;
    SEL_COUNT(SEL_GE, mx);
    if (c >= KTOP) { if (c == KTOP) exact = true; else { lo = mx; hi = INFINITY; } }
    else {
#pragma unroll 1
        for (int it = 0; it < 64; ++it) {
            const float mid = __uint_as_float(__builtin_amdgcn_readfirstlane(__float_as_uint(lo + 0.5f * (hi - lo))));
            if (!(mid > lo) || !(mid < hi)) break;
            SEL_COUNT(SEL_GE, mid);
            if (c == KTOP) { exact = true; theta = mid; break; }
            if (c > KTOP) lo = mid; else hi = mid;
        }
    }
    unsigned long long myw = 0ull;
    if (exact) {
#define SEL_OUT16(base) _Pragma("unroll") for (int i = (base); i < (base) + 16; ++i) { const unsigned long long mk = __ballot(xv[i] >= theta); if (lane == i) myw = mk; }
        SEL_OUT16(0) if (nreg > 16) { SEL_OUT16(16) } if (nreg > 32) { SEL_OUT16(32) } if (nreg > 48) { SEL_OUT16(48) }
#undef SEL_OUT16
    } else {
        SEL_COUNT(SEL_GT, lo);
        int need = KTOP - c;
#pragma unroll
        for (int i = 0; i < 64; ++i) {
            if (i < nreg) {
                unsigned long long mk = __ballot(xv[i] > lo); const unsigned long long e = __ballot(xv[i] == lo);
                const int pe = __popcll(e);
                if (pe <= need) { mk |= e; need -= pe; }
                else { const int rank = __popcll(e & ((1ull << lane) - 1ull)); mk |= __ballot(((e >> lane) & 1ull) && rank < need); need = 0; }
                if (lane == i) myw = mk;
            }
        }
    }
#undef SEL_COUNT
#undef SEL_CNT16
    mrow[(size_t)lane * 64] = myw;
}

#define IDX_BAR() asm volatile("s_waitcnt lgkmcnt(0)\n\ts_barrier" ::: "memory")
__device__ __forceinline__ void idx_phase(int b, int sdeal, const bf16_t* PROJ, const bf16_t* IKC, unsigned long long* MASK, LAS unsigned char* lds, const int wid) {
    const int lane = lane_id(), r32 = lane & 31, hi = lane >> 5;
    const size_t rowbase = (size_t)b * S;
    LAS float* SC = (LAS float*)lds;
    const int qi = 2 * ((r32 >> 2) & 1) + (r32 >> 4), hd = (r32 & 3) + 4 * ((r32 >> 3) & 1);
    const bf16_t* qbase = PROJ + (rowbase + qi) * NPROJ + C_IQ + hd * 64 + hi * 8;
    const bf16_t* wbase = PROJ + (rowbase + 2 * hi) * NPROJ + C_IW;
    const bf16_t* kbase = IKC + (rowbase + wid * 32) * 64 + hi * 256 + r32 * 8;
    bf16x8 af[2][4]; u32x4 wv[2][2]; bf16x8 f0[4], f1[4], f2[4], f3[4];
#define IDX_J(u) (16 * (u) + (((u) & 1) ? 15 - sdeal : sdeal))
#define IDX_CNT(t0) ((((t0) + 8 + 31) >> 5) - wid + 7) >> 3
#define IDX_LOAD(dst, i, cnt) do { const int _i = ((i) < (cnt)) ? (i) : ((cnt) - 1); const bf16_t* _p = kbase + (size_t)_i * (256 * 64); \
        _Pragma("unroll") for (int d0 = 0; d0 < 4; ++d0) dst[d0] = *(const bf16x8*)(_p + d0 * 512); } while (0)
#define IDX_PREFETCH(t0) do { if ((t0) + 8 > KTOP) { const int _c = IDX_CNT(t0); \
        _Pragma("unroll") for (int mt = 0; mt < 2; ++mt) { const bf16_t* _q = qbase + (size_t)((t0) + 4 * mt) * NPROJ; \
            _Pragma("unroll") for (int d0 = 0; d0 < 4; ++d0) af[mt][d0] = *(const bf16x8*)(_q + d0 * 16); \
            _Pragma("unroll") for (int e = 0; e < 2; ++e) wv[mt][e] = *(const u32x4*)(wbase + (size_t)((t0) + 4 * mt + e) * NPROJ); } \
        IDX_LOAD(f0, 0, _c); IDX_LOAD(f1, 1, _c); IDX_LOAD(f2, 2, _c); } } while (0)
#define IDX_W(mt, e, h8) ((h8) == 0 ? bf_lo(wv[mt][e].x) : (h8) == 1 ? bf_hi(wv[mt][e].x) : (h8) == 2 ? bf_lo(wv[mt][e].y) : (h8) == 3 ? bf_hi(wv[mt][e].y) : \
                          (h8) == 4 ? bf_lo(wv[mt][e].z) : (h8) == 5 ? bf_hi(wv[mt][e].z) : (h8) == 6 ? bf_lo(wv[mt][e].w) : bf_hi(wv[mt][e].w))
#define IDX_COMP(src, i) do { f32x16 a0 = f32x16{}, a1 = f32x16{}; \
        _Pragma("unroll") for (int d0 = 0; d0 < 4; ++d0) { a0 = __builtin_amdgcn_mfma_f32_32x32x16_bf16(af[0][d0], src[d0], a0, 0, 0, 0); a1 = __builtin_amdgcn_mfma_f32_32x32x16_bf16(af[1][d0], src[d0], a1, 0, 0, 0); } \
        _Pragma("unroll") for (int mt = 0; mt < 2; ++mt) _Pragma("unroll") for (int e = 0; e < 2; ++e) { float s = 0.f; \
            _Pragma("unroll") for (int h8 = 0; h8 < 8; ++h8) s = __builtin_fmaf(w[mt][e][h8], fmaxf(mt == 0 ? a0[8 * e + h8] : a1[8 * e + h8], 0.f), s); \
            SC[(4 * mt + 2 * hi + e) * 4096 + (wid + 8 * (i)) * 32 + r32] = s; } } while (0)
    { const int t0 = 8 * IDX_J(0); IDX_PREFETCH(t0); }
    for (int u = 0; u < 32; ++u) {
        const int t0 = 8 * IDX_J(u);
        if (t0 + 8 > KTOP) {
            float w[2][2][8];
#pragma unroll
            for (int mt = 0; mt < 2; ++mt)
#pragma unroll
                for (int e = 0; e < 2; ++e)
#pragma unroll
                    for (int h8 = 0; h8 < 8; ++h8) w[mt][e][h8] = IDX_W(mt, e, h8);
            const int cnt = IDX_CNT(t0);
            for (int i = 0; i < cnt; i += 4) {
                IDX_LOAD(f3, i + 3, cnt); IDX_COMP(f0, i);
                if (i + 1 < cnt) { IDX_LOAD(f0, i + 4, cnt); IDX_COMP(f1, i + 1); }
                if (i + 2 < cnt) { IDX_LOAD(f1, i + 5, cnt); IDX_COMP(f2, i + 2); }
                if (i + 3 < cnt) { IDX_LOAD(f2, i + 6, cnt); IDX_COMP(f3, i + 3); }
            }
        }
        IDX_BAR();
        if (u + 1 < 32) { const int t1 = 8 * IDX_J(u + 1); IDX_PREFETCH(t1); }
        select_row(t0 + wid, SC + wid * 4096, MASK + ((size_t)(b * 64 + ((t0 + wid) >> 6)) * 64) * 64 + ((t0 + wid) & 63), lane);
        IDX_BAR();
    }
#undef IDX_J
#undef IDX_CNT
#undef IDX_LOAD
#undef IDX_PREFETCH
#undef IDX_W
#undef IDX_COMP
}

__device__ __forceinline__ void grid_bar(unsigned* ctr, unsigned target, int wave) {
    asm volatile("s_waitcnt vmcnt(0) lgkmcnt(0)" ::: "memory");
    __syncthreads();
    if (wave == 0 && lane_id() == 0) {
        __builtin_amdgcn_fence(__ATOMIC_RELEASE, "agent");
        asm volatile("s_waitcnt vmcnt(0)" ::: "memory");
        __hip_atomic_fetch_add(ctr, 1u, __ATOMIC_RELAXED, __HIP_MEMORY_SCOPE_AGENT);
        unsigned spins = 0;
        while (__hip_atomic_load(ctr, __ATOMIC_RELAXED, __HIP_MEMORY_SCOPE_AGENT) < target) { __builtin_amdgcn_s_sleep(2); if (++spins > (1u << 26)) break; }
        __builtin_amdgcn_fence(__ATOMIC_ACQUIRE, "agent");
        asm volatile("s_waitcnt vmcnt(0)" ::: "memory");
    }
    __syncthreads();
}

struct Args { const float* x; const int* pos; const float* w_in; const float* g_q; const float* w_uq; const float* g_kv; const float* w_ukv; const float* g_oa; const float* g_ob;
              const float* w_out; const float* ln_g; const float* ln_b; float* out; unsigned char* ws; int ph_lo, ph_hi; };

__device__ __forceinline__ void src_map(int kind, int n, int& src, float& sc) {
    sc = 1.f;
    if (kind == 0) {
        if (n < 512) { src = n; sc = QA_SCALE; }
        else if (n < 1280) src = n;
        else if (n < 1664) src = n - 1280 + 1352;
        else if (n < 1920) src = n - 1664 + 1736;
        else if (n < 1984) src = n - 1920 + 1280;
        else if (n < 2016) { const int e = n - 1984; src = 1992 + (e >> 1) + 16 * (e & 1); }
        else if (n < 2024) { src = n - 2016 + 1344; sc = IW_SCALE; }
        else if (n < 2048) src = -1;
        else src = n - 2048 + 2024;
    } else if (kind == 1) {
        if (n < 512) { const int h = n >> 6, d = n & 63; src = h * 96 + d; }
        else { const int e = n - 512, h = e >> 5, r = e & 31; src = h * 96 + 64 + (r >> 1) + 16 * (r & 1); }
        sc = QB_SCALE;
    } else if (kind == 2) {
        if (n < 512) { const int h = n >> 6, d = n & 63; src = h * 128 + d; }
        else { const int e = n - 512, h = e >> 6, d = e & 63; src = h * 128 + 64 + d; }
    } else src = n;
}
__device__ __forceinline__ void p0_transpose_item(const float* W, int K, int Nsrc, int Ndst, bf16_t* WT, int kind, const float* ks0, const float* ks1, LAS float* scr, int item, int lane) {
    const int nblk = Ndst / 32, kb = item / nblk, nb = item % nblk, k0 = 64 * kb, n0 = 32 * nb;
    int src; float sc; src_map(kind, n0 + (lane & 31), src, sc);
#pragma unroll 8
    for (int i = 0; i < 32; ++i) { const int kk = 2 * i + (lane >> 5), k = k0 + kk;
        float ksc = 1.f; if (ks0) ksc = (k < 512 || !ks1) ? ks0[k] : ks1[k - 512];
        scr[kk * 33 + (lane & 31)] = src >= 0 ? W[(size_t)k * Nsrc + src] * (sc * ksc) : 0.f; }
    asm volatile("s_waitcnt lgkmcnt(0)" ::: "memory");
    const int c = lane & 7;
#pragma unroll
    for (int jj = 0; jj < 4; ++jj) { const int n = (lane >> 3) + 8 * jj; const LAS float* s = scr + (8 * c) * 33 + n;
        u32x4 o; o.x = cvt_pk_bf16(s[0 * 33], s[1 * 33]); o.y = cvt_pk_bf16(s[2 * 33], s[3 * 33]); o.z = cvt_pk_bf16(s[4 * 33], s[5 * 33]); o.w = cvt_pk_bf16(s[6 * 33], s[7 * 33]);
        *(u32x4*)(WT + (size_t)(n0 + n) * K + k0 + 8 * c) = o; }
    asm volatile("s_waitcnt lgkmcnt(0)" ::: "memory");
}
__device__ __forceinline__ float wave_sum(float v) {
#pragma unroll
    for (int o = 1; o < 64; o <<= 1) v += __shfl_xor(v, o);
    return v;
}

__global__ void __launch_bounds__(512, 2) hybrid_fwd(Args a) {
    extern __shared__ __attribute__((aligned(16))) unsigned char lds_raw[];
    LAS unsigned char* lds = (LAS unsigned char*)lds_raw;
    const int wave = __builtin_amdgcn_readfirstlane(threadIdx.x >> 6);
#define lane lane_id()
#define tid (wave * 64 + lane_id())
    const int G = gridDim.x, bx = blockIdx.x, vcu = (G % 8 == 0) ? (bx % 8) * (G / 8) + bx / 8 : bx;
    unsigned char* ws = a.ws;
    bf16_t* W1T = (bf16_t*)(ws + WS_W1T); bf16_t* WUQT = (bf16_t*)(ws + WS_WUQT); bf16_t* WUKVT = (bf16_t*)(ws + WS_WUKVT); bf16_t* WOT = (bf16_t*)(ws + WS_WOT);
    float* CS = (float*)(ws + WS_CS); float* SSQ = (float*)(ws + WS_SSQ); float* POSF = (float*)(ws + WS_POSF); float* OSS = (float*)(ws + WS_OSS); float* STATS = (float*)(ws + WS_STATS);
    bf16_t* XB = (bf16_t*)(ws + WS_XB); bf16_t* PROJ = (bf16_t*)(ws + WS_PROJ); bf16_t* QB = (bf16_t*)(ws + WS_QB); bf16_t* KVB = (bf16_t*)(ws + WS_KVB);
    bf16_t* IKC = (bf16_t*)(ws + WS_IKC); bf16_t* KRC = (bf16_t*)(ws + WS_KRC); bf16_t* KAC = (bf16_t*)(ws + WS_KAC); bf16_t* VAC = (bf16_t*)(ws + WS_VAC);
    bf16_t* CQC = (bf16_t*)(ws + WS_CQC); bf16_t* CKVC = (bf16_t*)(ws + WS_CKVC); bf16_t* KNC = (bf16_t*)(ws + WS_KNC); bf16_t* VBC = (bf16_t*)(ws + WS_VBC);
    unsigned long long* MASK = (unsigned long long*)(ws + WS_MASK); bf16_t* OAB = (bf16_t*)(ws + WS_OAB); bf16_t* Y = (bf16_t*)(ws + WS_Y);
    const int lo = a.ph_lo, hi_ph = a.ph_hi;
#define IN(k) (lo <= (k) && (k) < hi_ph)
#define SEAM(k) do { if (IN(k) && IN((k) + 1)) { if ((k) == 0) cg::this_grid().sync(); else { ++nbar; grid_bar((unsigned*)ws, nbar * (unsigned)G, wave); } } } while (0)
    unsigned nbar = 0;
#define NOSEAM(k) do { if (IN(k) && IN((k) + 1)) { __syncthreads(); } } while (0)
    const int gw = vcu * 8 + wave, NGW = G * 8;
#define gt ((size_t)vcu * 512 + tid)
    const size_t NGT = (size_t)G * 512;

    if (IN(0)) {
        LAS float* scr = (LAS float*)(lds + wave * 16384);
        constexpr int I1 = (1024 / 64) * (NPROJ / 32), I2 = (384 / 64) * (NQB / 32), I3 = (256 / 64) * (NKVB / 32), I4 = (1024 / 64) * (1024 / 32);
        for (int it = gw; it < I1 + I2 + I3 + I4; it += NGW) {
            int r = it;
            if (r < I1) { p0_transpose_item(a.w_in, 1024, D_IN, NPROJ, W1T, 0, nullptr, nullptr, scr, r, lane); continue; } r -= I1;
            if (r < I2) { p0_transpose_item(a.w_uq, 384, NQB, NQB, WUQT, 1, a.g_q, nullptr, scr, r, lane); continue; } r -= I2;
            if (r < I3) { p0_transpose_item(a.w_ukv, 256, NKVB, NKVB, WUKVT, 2, a.g_kv, nullptr, scr, r, lane); continue; } r -= I3;
            p0_transpose_item(a.w_out, 1024, 1024, 1024, WOT, 3, a.g_oa, a.g_ob, scr, r, lane);
        }
        for (size_t c = gt; c < (size_t)M * 128; c += NGT) {
            const f32x4 v0 = *(const f32x4*)(a.x + c * 8), v1 = *(const f32x4*)(a.x + c * 8 + 4);
            *(u32x4*)(XB + c * 8) = (u32x4){cvt_pk_bf16(v0[0], v0[1]), cvt_pk_bf16(v0[2], v0[3]), cvt_pk_bf16(v1[0], v1[1]), cvt_pk_bf16(v1[2], v1[3])};
        }
        for (size_t i = gt; i < (size_t)M * 16; i += NGT) {
            const size_t t = i >> 4; const int k = (int)(i & 15);
            const float p = (float)a.pos[t];
            const float invf = exp2f(-(float)k * 0.8304820237218406f);
            const float ang = p * invf;
            const double ad = (double)ang;
            const double kk = rint(ad * 0.15915494309189535);
            const double r = fma(-kk, 6.283185307179586, ad) - kk * 2.4492935982947064e-16;
            const double r2 = r * r;
            double sn = -8.2206352466243297e-18; sn = fma(sn, r2, 2.8114572543455206e-15); sn = fma(sn, r2, -7.6471637318198165e-13); sn = fma(sn, r2, 1.6059043836821613e-10);
            sn = fma(sn, r2, -2.5052108385441720e-08); sn = fma(sn, r2, 2.7557319223985893e-06); sn = fma(sn, r2, -1.9841269841269841e-04); sn = fma(sn, r2, 8.3333333333333332e-03);
            sn = fma(sn, r2, -1.6666666666666666e-01); sn = fma(sn * r2, r, r);
            double cn = 4.1103176233121648e-19; cn = fma(cn, r2, -1.5619206968586226e-16); cn = fma(cn, r2, 4.7794773323873853e-14); cn = fma(cn, r2, -1.1470745597729725e-11);
            cn = fma(cn, r2, 2.0876756987868099e-09); cn = fma(cn, r2, -2.7557319223985888e-07); cn = fma(cn, r2, 2.4801587301587302e-05); cn = fma(cn, r2, -1.3888888888888889e-03);
            cn = fma(cn, r2, 4.1666666666666664e-02); cn = fma(cn, r2, -0.5); cn = fma(cn, r2, 1.0);
            CS[t * 32 + k] = (float)cn; CS[t * 32 + 16 + k] = (float)sn;
            if (k == 0) POSF[t] = p;
        }
    }
    SEAM(0);
    if (IN(1)) {
        pg8::Gemm g{XB, W1T, M, NPROJ, 1024, 1024}; pg8::StaticOrder So; So.init(M, NPROJ, G, bx);
        EpiProj E{PROJ, CS, SSQ, IKC, KRC, KAC, VAC, CQC, CKVC};
        pg8::gemm_phase<EpiProj>(lds, g, So, E, wave);
    }
    SEAM(1);
    if (IN(2)) {
        { pg8::Gemm g{CQC, WUQT, M, NQB, 384, 384}; pg8::StaticOrder So; So.init(M, NQB, G, bx);
          EpiUp E{QB, NQB, SSQ, 0, 3, 1.0f / 384.0f, CS, 2, nullptr, nullptr};
          pg8::gemm_phase<EpiUp>(lds, g, So, E, wave); }
        { pg8::Gemm g{CKVC, WUKVT, M, NKVB, 256, 256}; pg8::StaticOrder So; So.init(M, NKVB, G, bx);
          EpiUp E{KVB, NKVB, SSQ, 12, 2, 1.0f / 256.0f, CS, -1, KNC, VBC};
          pg8::gemm_phase<EpiUp>(lds, g, So, E, wave); }
    }
    NOSEAM(2);
    if (IN(3)) {
        idx_phase(vcu >> 4, vcu & 15, PROJ, IKC, MASK, lds, wave);
    }
    SEAM(3);
    if (IN(4)) {
        const int bh = vcu >> 1, s = vcu & 1, b = bh >> 3, h = bh & 7;
        for (int i = 0; i < 2; ++i) { const int qa = 2 * i + s; mla_unit(b, h, 7 - qa, QB, KNC, VBC, KRC, OAB, OSS, lds, wave); mla_unit(b, h, qa, QB, KNC, VBC, KRC, OAB, OSS, lds, wave); }
    }
    NOSEAM(4);
    if (IN(5)) {
        const int bg = vcu >> 3, s = vcu & 7, b = bg >> 1, g = bg & 1;
        for (int i = 0; i < 2; ++i) { const int qa = 8 * i + s; dsa_unit(b, g, 31 - qa, PROJ, KAC, VAC, MASK, POSF, OAB, OSS, lds, wave); dsa_unit(b, g, qa, PROJ, KAC, VAC, MASK, POSF, OAB, OSS, lds, wave); }
    }
    SEAM(5);
    if (IN(6)) {
        for (size_t c = gt; c < (size_t)M * 128; c += NGT) {
            const size_t row = c >> 7; const int col = (int)(c & 127) * 8, grp = col >> 9;
            const f32x4 s0 = *(const f32x4*)(OSS + row * 16 + grp * 8), s1 = *(const f32x4*)(OSS + row * 16 + grp * 8 + 4);
            const float rstd = __builtin_amdgcn_rsqf(((s0[0] + s0[1]) + (s0[2] + s0[3]) + (s1[0] + s1[1]) + (s1[2] + s1[3])) * (1.0f / 512.0f) + 1e-6f);
            const u32x4 o = *(const u32x4*)(OAB + row * DM + col), z = *(const u32x4*)(PROJ + row * NPROJ + C_Z + col);
            u32x4 y;
            y.x = cvt_pk_bf16(bf_lo(o.x) * rstd * bf_lo(z.x), bf_hi(o.x) * rstd * bf_hi(z.x)); y.y = cvt_pk_bf16(bf_lo(o.y) * rstd * bf_lo(z.y), bf_hi(o.y) * rstd * bf_hi(z.y));
            y.z = cvt_pk_bf16(bf_lo(o.z) * rstd * bf_lo(z.z), bf_hi(o.z) * rstd * bf_hi(z.z)); y.w = cvt_pk_bf16(bf_lo(o.w) * rstd * bf_lo(z.w), bf_hi(o.w) * rstd * bf_hi(z.w));
            *(u32x4*)(Y + row * DM + col) = y;
        }
    }
    SEAM(6);
    if (IN(7)) {
        pg8::Gemm g{Y, WOT, M, DM, 1024, 1024}; pg8::StaticOrder So; So.init(M, DM, G, bx);
        EpiOut E{a.x, a.out, STATS};
        pg8::gemm_phase<EpiOut>(lds, g, So, E, wave);
    }
    SEAM(7);
    if (IN(8)) {
        for (int row = gw; row < M; row += NGW) {
            float s = 0.f, q = 0.f;
            if (lane < 16) { const f32x2 t = *(const f32x2*)(STATS + (size_t)row * 32 + 2 * lane); s = t.x; q = t.y; }
            s = wave_sum(s); q = wave_sum(q);
            const float mean = s * (1.0f / DM), var = q * (1.0f / DM) - mean * mean, rstd = 1.0f / sqrtf(fmaxf(var, 0.f) + 1e-5f);
            float* orow = a.out + (size_t)row * DM;
#pragma unroll
            for (int jj = 0; jj < 4; ++jj) { const int col = jj * 256 + lane * 4;
                const f32x4 v = *(const f32x4*)(orow + col), gg = *(const f32x4*)(a.ln_g + col), bb = *(const f32x4*)(a.ln_b + col);
                *(f32x4*)(orow + col) = (v - mean) * rstd * gg + bb; }
        }
    }
#undef IN
#undef lane
#undef tid
#undef gt
#undef SEAM
#undef NOSEAM
}

constexpr int N_PHASES = 9;
#ifndef PROBE_PHASE
#define PROBE_PHASE -1
#endif
extern "C" void kernel_launch(void* const* d_in, const int* in_sizes, int n_in, void* d_out, int out_size, void* d_ws, size_t ws_size, hipStream_t stream) {
    static int grid = 0;
    if (grid == 0) {
        if (n_in != 12 || in_sizes[0] != M * DM || out_size != M * DM || ws_size < WS_END) { fprintf(stderr, "kernel_launch: unexpected shapes (n_in %d, in0 %d, out %d, ws %zu)\n", n_in, n_in > 0 ? in_sizes[0] : -1, out_size, ws_size); grid = -1; return; }
        int dev = 0, cus = 0, per_cu = 0;
        if (hipGetDevice(&dev) != hipSuccess || hipDeviceGetAttribute(&cus, hipDeviceAttributeMultiprocessorCount, dev) != hipSuccess) { grid = -1; return; }
        if (hipFuncSetAttribute((const void*)hybrid_fwd, hipFuncAttributeMaxDynamicSharedMemorySize, LDS_BYTES) != hipSuccess) { fprintf(stderr, "kernel_launch: hipFuncSetAttribute failed\n"); grid = -1; return; }
        if (hipOccupancyMaxActiveBlocksPerMultiprocessor(&per_cu, (const void*)hybrid_fwd, 512, LDS_BYTES) != hipSuccess || per_cu < 1) { fprintf(stderr, "kernel_launch: occupancy query says %d\n", per_cu); per_cu = 1; }
        (void)hipGetLastError();
        grid = cus;
        if (grid != 256) fprintf(stderr, "kernel_launch: %d CUs; this kernel's work deals assume 256\n", grid);
    }
    if (grid < 0) return;
    Args a{};
    a.x = (const float*)d_in[0]; a.pos = (const int*)d_in[1]; a.w_in = (const float*)d_in[2]; a.g_q = (const float*)d_in[3]; a.w_uq = (const float*)d_in[4]; a.g_kv = (const float*)d_in[5];
    a.w_ukv = (const float*)d_in[6]; a.g_oa = (const float*)d_in[7]; a.g_ob = (const float*)d_in[8]; a.w_out = (const float*)d_in[9]; a.ln_g = (const float*)d_in[10]; a.ln_b = (const float*)d_in[11];
    a.out = (float*)d_out; a.ws = (unsigned char*)d_ws;
    (void)hipMemsetAsync(d_ws, 0, 256, stream);
#if MK_N_LAUNCHES == 1
    a.ph_lo = 0; a.ph_hi = N_PHASES;
    void* args[] = {&a};
    hipError_t e = hipLaunchCooperativeKernel((const void*)hybrid_fwd, dim3(grid), dim3(512), args, LDS_BYTES, stream);
    if (e != hipSuccess) fprintf(stderr, "kernel_launch: cooperative launch failed: %s (grid %d)\n", hipGetErrorString(e), grid);
#else
    for (int p = 0; p < N_PHASES; ++p) {
        a.ph_lo = p; a.ph_hi = p + 1;
        for (int rep = 0; rep < ((p == PROBE_PHASE) ? 2 : 1); ++rep) hipLaunchKernelGGL(hybrid_fwd, dim3(grid), dim3(512), LDS_BYTES, stream, a);
    }
#endif
}
```

```cpp
#include <hip/hip_runtime.h>
#include <hip/hip_cooperative_groups.h>
#include <cstdio>
#include <cstdint>
namespace cg = cooperative_groups;

#ifndef MK_N_LAUNCHES
#define MK_N_LAUNCHES 1
#endif

#define LAS __attribute__((address_space(3)))
typedef unsigned short bf16_t;
typedef short bf16x8 __attribute__((ext_vector_type(8)));
typedef short s16x4 __attribute__((ext_vector_type(4)));
typedef float f32x4 __attribute__((ext_vector_type(4)));
typedef float f32x2 __attribute__((ext_vector_type(2)));
typedef float f32x16 __attribute__((ext_vector_type(16)));
typedef unsigned u32x4 __attribute__((ext_vector_type(4)));
typedef unsigned u32x2 __attribute__((ext_vector_type(2)));

constexpr int NB = 16, S = 4096, M = NB * S, DM = 1024;
constexpr int NPROJ = 3072;
constexpr int C_QA = 0, C_KA = 512, C_VA = 640, C_IQ = 768, C_CQ = 1280, C_CKV = 1664, C_IK = 1920, C_KR = 1984, C_IW = 2016, C_Z = 2048;
constexpr int D_IN = 3048;
constexpr int NQB = 768, NKVB = 1024;
constexpr float LOG2E = 1.4426950408889634f;
constexpr float QA_SCALE = 0.125f * LOG2E;
constexpr float QB_SCALE = 0.10206207261596577f * LOG2E;
constexpr float IW_SCALE = 0.04419417382415922f;
constexpr float DN_ALPHA = 1.189207115002721f;
constexpr int KTOP = 256;

constexpr size_t MiB = 1u << 20;
constexpr size_t WS_W1T = 1 * MiB, WS_WUQT = 7 * MiB, WS_WUKVT = 8 * MiB, WS_WOT = 9 * MiB, WS_CS = 11 * MiB, WS_SSQ = 19 * MiB, WS_POSF = 25 * MiB,
                 WS_OSS = 26 * MiB, WS_STATS = 30 * MiB, WS_XB = 64 * MiB, WS_PROJ = 192 * MiB, WS_QB = 576 * MiB, WS_KVB = 672 * MiB, WS_MASK = 800 * MiB,
                 WS_IKC = 832 * MiB, WS_KRC = 840 * MiB, WS_KAC = 848 * MiB, WS_VAC = 864 * MiB, WS_CQC = 880 * MiB, WS_CKVC = 928 * MiB, WS_END = 960 * MiB;
constexpr size_t WS_KNC = WS_KVB, WS_VBC = WS_KVB + 64 * MiB;
constexpr size_t WS_OAB = WS_XB;
constexpr size_t WS_Y = WS_KVB;

constexpr int LDS_BYTES = 132096;

__device__ __forceinline__ unsigned cvt_pk_bf16(float lo, float hi) { unsigned r; asm volatile("v_cvt_pk_bf16_f32 %0, %1, %2" : "=v"(r) : "v"(lo), "v"(hi)); return r; }
__device__ __forceinline__ float bf_lo(unsigned u) { return __uint_as_float(u << 16); }
__device__ __forceinline__ float bf_hi(unsigned u) { return __uint_as_float(u & 0xffff0000u); }
__device__ __forceinline__ int crow(int r, int hi) { return (r & 3) + 8 * (r >> 2) + 4 * hi; }
__device__ __forceinline__ float silu_f(float v) { return v * __builtin_amdgcn_rcpf(1.0f + __builtin_amdgcn_exp2f(-v * LOG2E)); }
__device__ __forceinline__ int lane_id() { return (int)__builtin_amdgcn_mbcnt_hi(~0u, __builtin_amdgcn_mbcnt_lo(~0u, 0u)); }
__device__ __forceinline__ void glds16(const void* g, LAS unsigned char* l) { __builtin_amdgcn_global_load_lds((const unsigned*)g, (LAS unsigned*)l, 16, 0, 0); }

namespace pg8 {
constexpr int BM = 256, BK = 64, HALF = 128, HTB = HALF * BK * 2, STAGE_BYTES = 8 * HTB, NXCD = 8, WGM = 8;
__host__ __device__ __forceinline__ int lds_byte(int r, int c) { const int st = (r >> 4) * 2 + (c >> 5), rr = r & 15, cc = c & 31, ob = rr * 64 + cc * 2; return st * 1024 + (ob ^ (((ob >> 9) & 1) << 5)); }
__host__ __device__ __forceinline__ void stage_rc(int b, int& R, int& C) { const int st = b / 1024, sb = b % 1024, swz = sb ^ (((sb >> 9) & 1) << 5); R = (st >> 1) * 16 + swz / 64; C = (st & 1) * 32 + (swz % 64) / 2; }
__host__ __device__ __forceinline__ int perm32(int rho) { const int n = rho >> 4, i = rho & 15; return 8 * (i >> 2) + 4 * n + (i & 3); }

struct Unit { int pm, pn; };
struct Gemm { const bf16_t* A; const bf16_t* Bt; int M, N, K, lda; };

struct StaticOrder {
    int nM, nN, nwg, G, c;
    __host__ __device__ void init(int M_, int N_, int G_, int c_) { nM = M_ / BM; nN = N_ / BM; nwg = nM * nN; G = G_; c = c_; }
    __host__ __device__ bool next(int i, Unit& u) const {
        const long L = (long)i * G + c; if (L >= nwg) return false;
        int wgid = (int)L; { const int q = nwg / NXCD, r = nwg % NXCD, xcd = wgid % NXCD, off = wgid / NXCD; wgid = (xcd < r ? xcd * (q + 1) : r * (q + 1) + (xcd - r) * q) + off; }
        const int nig = WGM * nN, gid = wgid / nig, fm = gid * WGM, gsz = (nM - fm) < WGM ? (nM - fm) : WGM;
        u.pm = fm + ((wgid % nig) % gsz); u.pn = (wgid % nig) / gsz; return true;
    }
};

template <class Epi>
__device__ __forceinline__ void gemm_phase(LAS unsigned char* lds, const Gemm g, const StaticOrder& S, const Epi& E, const int wid) {
    const int lane = lane_id(), tid = wid * 64 + lane, wr = wid >> 2, wc = wid & 3, fr = lane & 15, fq = lane >> 4;
    const int K = g.K, nt = K / BK, lda = g.lda;
    unsigned voffA[2], voffB[2];
#pragma unroll
    for (int i = 0; i < 2; ++i) { int R, C; stage_rc(tid * 16 + i * 8192, R, C); const int Rb = Epi::PERM ? ((R & ~31) + perm32(R & 31)) : R;
        voffA[i] = (unsigned)(R * lda + C) * 2u; voffB[i] = (unsigned)(Rb * K + C) * 2u; }
    const size_t kstep = (size_t)(BK * 2);
    const size_t hstepA = (size_t)HALF * lda * 2, tstepA = 2 * hstepA;
    const size_t hstepB = (size_t)HALF * K * 2, tstepB = 2 * hstepB;
    const unsigned ldsw = (unsigned)wid * 1024u;
    const int aoff = lds_byte(wr * 64 + fr, fq * 8), boff = lds_byte(wc * 32 + fr, fq * 8);
#define PG8_SA(b, h) (((b) * 2 + (h)) * HTB)
#define PG8_SB(b, h) ((4 + (b) * 2 + (h)) * HTB)
#define PG8_STAGE(bufoff, gbase, voff) do { _Pragma("unroll") for (int _i = 0; _i < 2; ++_i) \
        __builtin_amdgcn_global_load_lds((const unsigned*)((const char*)(gbase) + (voff)[_i]), (LAS unsigned*)(lds + (bufoff) + ldsw + _i * 8192), 16, 0, 0); } while (0)
#define PG8_LDA(dst, b, h) do { _Pragma("unroll") for (int m = 0; m < 4; ++m) _Pragma("unroll") for (int k = 0; k < 2; ++k) dst[m][k] = *(const LAS bf16x8*)(lds + PG8_SA(b, h) + aoff + m * 2048 + k * 1024); } while (0)
#define PG8_LDB(dst, b, h) do { _Pragma("unroll") for (int n = 0; n < 2; ++n) _Pragma("unroll") for (int k = 0; k < 2; ++k) dst[n][k] = *(const LAS bf16x8*)(lds + PG8_SB(b, h) + boff + n * 2048 + k * 1024); } while (0)
#define PG8_MMA(ai, bj, At, Bt) do { __builtin_amdgcn_s_setprio(1); _Pragma("unroll") for (int m = 0; m < 4; ++m) _Pragma("unroll") for (int n = 0; n < 2; ++n) _Pragma("unroll") for (int k = 0; k < 2; ++k) \
        acc[ai][bj][m][n] = __builtin_amdgcn_mfma_f32_16x16x32_bf16(Bt[n][k], At[m][k], acc[ai][bj][m][n], 0, 0, 0); __builtin_amdgcn_s_setprio(0); } while (0)
#define PG8_WAIT_V(n) asm volatile("s_waitcnt vmcnt(" #n ")" ::: "memory")
#define PG8_WAIT_L(n) asm volatile("s_waitcnt lgkmcnt(" #n ")" ::: "memory")
#define PG8_BAR __builtin_amdgcn_s_barrier()
#define PG8_SCHED __builtin_amdgcn_sched_barrier(0)
    Unit cur, nxt; int ui = 0;
    if (!S.next(0, cur)) return;
    f32x4 acc[2][2][4][2];
#pragma unroll
    for (int a = 0; a < 2; ++a)
#pragma unroll
        for (int b = 0; b < 2; ++b)
#pragma unroll
            for (int m = 0; m < 4; ++m)
#pragma unroll
                for (int n = 0; n < 2; ++n) acc[a][b][m][n] = (f32x4){0.f, 0.f, 0.f, 0.f};
    bf16x8 At[4][2], B0[2][2], B1[2][2];
    const char* cA = (const char*)g.A + (size_t)cur.pm * tstepA; const char* cB = (const char*)g.Bt + (size_t)cur.pn * tstepB;
    PG8_STAGE(PG8_SB(0, 0), cB, voffB); PG8_STAGE(PG8_SB(0, 1), cB + hstepB, voffB); PG8_STAGE(PG8_SA(0, 0), cA, voffA); PG8_STAGE(PG8_SA(0, 1), cA + hstepA, voffA);
    if (wr == 1) PG8_BAR;
    PG8_WAIT_V(2); PG8_BAR;
    PG8_STAGE(PG8_SB(1, 0), cB + kstep, voffB); PG8_STAGE(PG8_SA(1, 0), cA + kstep, voffA); PG8_STAGE(PG8_SB(1, 1), cB + hstepB + kstep, voffB);
    PG8_WAIT_V(6); PG8_BAR;
    for (;;) {
        const bool has_next = S.next(ui + 1, nxt);
        const char* nA = has_next ? (const char*)g.A + (size_t)nxt.pm * tstepA : cA; const char* nB = has_next ? (const char*)g.Bt + (size_t)nxt.pn * tstepB : cB;
        for (int t = 0; t < nt; t += 2) {
            const bool last = (t == nt - 2);
            const char* a1 = cA + (size_t)(t + 1) * kstep;
            const char* a2 = last ? nA : cA + (size_t)(t + 2) * kstep; const char* b2 = last ? nB : cB + (size_t)(t + 2) * kstep;
            const char* a3 = a2 + kstep; const char* b3 = b2 + kstep;
            PG8_LDB(B0, 0, 0); PG8_LDB(B1, 0, 1); PG8_SCHED; PG8_LDA(At, 0, 0); PG8_STAGE(PG8_SA(1, 1), a1 + hstepA, voffA);
            PG8_WAIT_V(8); PG8_WAIT_L(0); PG8_BAR; PG8_MMA(0, 0, At, B0); PG8_MMA(0, 1, At, B1); PG8_BAR; PG8_SCHED;
            PG8_LDA(At, 0, 1); PG8_STAGE(PG8_SB(0, 0), b2, voffB); PG8_STAGE(PG8_SB(0, 1), b2 + hstepB, voffB); PG8_STAGE(PG8_SA(0, 0), a2, voffA);
            PG8_WAIT_V(8); PG8_WAIT_L(0); PG8_BAR; PG8_MMA(1, 0, At, B0); PG8_MMA(1, 1, At, B1); PG8_BAR; PG8_SCHED;
            PG8_LDB(B0, 1, 0); PG8_LDB(B1, 1, 1); PG8_SCHED; PG8_LDA(At, 1, 0); PG8_STAGE(PG8_SA(0, 1), a2 + hstepA, voffA);
            PG8_WAIT_V(8); PG8_WAIT_L(0); PG8_BAR; PG8_MMA(0, 0, At, B0); PG8_MMA(0, 1, At, B1); PG8_BAR; PG8_SCHED;
            PG8_LDA(At, 1, 1); PG8_STAGE(PG8_SB(1, 0), b3, voffB); PG8_STAGE(PG8_SB(1, 1), b3 + hstepB, voffB); PG8_STAGE(PG8_SA(1, 0), a3, voffA);
            PG8_WAIT_V(8); PG8_WAIT_L(0); PG8_BAR; PG8_MMA(1, 0, At, B0); PG8_MMA(1, 1, At, B1); PG8_BAR; PG8_SCHED;
        }
        if (wr == 0) PG8_BAR;
        E(acc, cur, wr, wc, fr, fq);
        if (!has_next) break;
#pragma unroll
        for (int a = 0; a < 2; ++a)
#pragma unroll
            for (int b = 0; b < 2; ++b)
#pragma unroll
                for (int m = 0; m < 4; ++m)
#pragma unroll
                    for (int n = 0; n < 2; ++n) acc[a][b][m][n] = (f32x4){0.f, 0.f, 0.f, 0.f};
        cur = nxt; cA = nA; cB = nB; ++ui;
        if (wr == 1) PG8_BAR;
    }
    PG8_WAIT_V(0);
    PG8_BAR;
#undef PG8_SA
#undef PG8_SB
#undef PG8_STAGE
#undef PG8_LDA
#undef PG8_LDB
#undef PG8_MMA
#undef PG8_WAIT_V
#undef PG8_WAIT_L
#undef PG8_BAR
#undef PG8_SCHED
}
}

__device__ __forceinline__ int lane_id_nohoist() { int l; asm volatile("v_mbcnt_lo_u32_b32 %0, -1, 0\n\tv_mbcnt_hi_u32_b32 %0, -1, %0" : "=v"(l)); return l; }

__device__ __forceinline__ void rope8(f32x4& v0, f32x4& v1, const float* csrow, int fq) {
    const f32x4 c = *(const f32x4*)(csrow + 4 * fq), s = *(const f32x4*)(csrow + 16 + 4 * fq);
    const float a0 = v0[0] * c[0] - v0[1] * s[0], b0 = v0[0] * s[0] + v0[1] * c[0];
    const float a1 = v0[2] * c[1] - v0[3] * s[1], b1 = v0[2] * s[1] + v0[3] * c[1];
    const float a2 = v1[0] * c[2] - v1[1] * s[2], b2 = v1[0] * s[2] + v1[1] * c[2];
    const float a3 = v1[2] * c[3] - v1[3] * s[3], b3 = v1[2] * s[3] + v1[3] * c[3];
    v0 = (f32x4){a0, b0, a1, b1}; v1 = (f32x4){a2, b2, a3, b3};
}
__device__ __forceinline__ void store8(bf16_t* p, const f32x4& v0, const f32x4& v1) {
    u32x4 w; w.x = cvt_pk_bf16(v0[0], v0[1]); w.y = cvt_pk_bf16(v0[2], v0[3]); w.z = cvt_pk_bf16(v1[0], v1[1]); w.w = cvt_pk_bf16(v1[2], v1[3]);
    *(u32x4*)p = w;
}

struct EpiProj {
    static constexpr bool PERM = true, MID = false;
    bf16_t* P; const float* cs; float* ssq; bf16_t* IKC; bf16_t* KRC; bf16_t* KAC; bf16_t* VAC; bf16_t* CQC; bf16_t* CKVC;
    __device__ __forceinline__ void operator()(const f32x4 (&acc)[2][2][4][2], const pg8::Unit& u, int wr, int wc, int fr_, int fq_) const {
        const int l_ = lane_id_nohoist(), fr = l_ & 15, fq = l_ >> 4;
        const int row0 = u.pm * 256 + wr * 64 + fr, colt = u.pn * 256 + wc * 32 + 8 * fq, pn = u.pn;
#pragma unroll
        for (int ai = 0; ai < 2; ++ai)
#pragma unroll
            for (int m = 0; m < 4; ++m) {
                const int row = row0 + ai * 128 + m * 16; bf16_t* rowp = P + (size_t)row * NPROJ + colt;
#pragma unroll
                for (int bj = 0; bj < 2; ++bj) {
                    f32x4 v0 = acc[ai][bj][m][0], v1 = acc[ai][bj][m][1];
                    bf16_t* dst = rowp + bj * 128;
                    if (pn >= 8) {
#pragma unroll
                        for (int j = 0; j < 4; ++j) { v0[j] = silu_f(v0[j]); v1[j] = silu_f(v1[j]); }
                    } else if (pn == 2) {
                        const size_t tb = (size_t)((row >> 12) * 2 + (wc >> 1)) * 64 + ((row & 4095) >> 6); const int k = row & 63;
                        dst = (bj == 0) ? KAC + (tb * 8 + 4 * (wc & 1) + fq) * 512 + k * 8 : VAC + (tb * 2 + (wc & 1)) * 2048 + k * 32 + 8 * fq;
                    } else if (pn >= 5) {
                        int slot = -1;
                        if (pn == 5) { slot = bj * 4 + wc; dst = CQC + (size_t)row * 384 + bj * 128 + wc * 32 + 8 * fq; }
                        else if (pn == 6) { if (bj == 0) { slot = 8 + wc; dst = CQC + (size_t)row * 384 + 256 + wc * 32 + 8 * fq; } else { slot = 12 + wc; dst = CKVC + (size_t)row * 256 + wc * 32 + 8 * fq; } }
                        else if (bj == 0) { slot = 16 + wc; dst = CKVC + (size_t)row * 256 + 128 + wc * 32 + 8 * fq; }
                        if (slot >= 0) {
                            float s = (v0[0] * v0[0] + v0[1] * v0[1]) + (v0[2] * v0[2] + v0[3] * v0[3]) + (v1[0] * v1[0] + v1[1] * v1[1]) + (v1[2] * v1[2] + v1[3] * v1[3]);
                            s += __shfl_xor(s, 16); s += __shfl_xor(s, 32);
                            if (fq == 0) ssq[(size_t)row * 20 + slot] = s;
                        } else if (wc < 2) dst = IKC + ((size_t)(row >> 5) * 8 + 4 * wc + fq) * 256 + (row & 31) * 8;
                        else if (wc == 2) { rope8(v0, v1, cs + (size_t)row * 32, fq); dst = KRC + ((size_t)(row >> 6) * 4 + fq) * 512 + (row & 63) * 8; }
                    }
                    store8(dst, v0, v1);
                }
                asm volatile("" ::: "memory");
            }
    }
};
struct EpiUp {
    static constexpr bool PERM = true, MID = false;
    bf16_t* O; int ldc; const float* ssq; int slot0, nslot4; float invK; const float* cs; int rope_pn; bf16_t* HK; bf16_t* HV;
    __device__ __forceinline__ void operator()(const f32x4 (&acc)[2][2][4][2], const pg8::Unit& u, int wr, int wc, int fr_, int fq_) const {
        const int l_ = lane_id_nohoist(), fr = l_ & 15, fq = l_ >> 4;
        const int row0 = u.pm * 256 + wr * 64 + fr, colt = u.pn * 256 + wc * 32 + 8 * fq;
#pragma unroll
        for (int ai = 0; ai < 2; ++ai) {
            float rstd[4];
            { f32x4 tq[4][3];
#pragma unroll
              for (int m = 0; m < 4; ++m)
#pragma unroll
                  for (int q = 0; q < 3; ++q) tq[m][q] = (q < nslot4) ? *(const f32x4*)(ssq + (size_t)(row0 + ai * 128 + m * 16) * 20 + slot0 + 4 * q) : (f32x4){0.f, 0.f, 0.f, 0.f};
#pragma unroll
              for (int m = 0; m < 4; ++m) { const f32x4 t = tq[m][0] + tq[m][1] + tq[m][2]; rstd[m] = __builtin_amdgcn_rsqf(((t[0] + t[1]) + (t[2] + t[3])) * invK + 1e-6f); } }
#pragma unroll
            for (int m = 0; m < 4; ++m) {
                const int row = row0 + ai * 128 + m * 16; bf16_t* rowp = O + (size_t)row * ldc + colt;
#pragma unroll
                for (int bj = 0; bj < 2; ++bj) {
                    f32x4 v0 = acc[ai][bj][m][0] * rstd[m], v1 = acc[ai][bj][m][1] * rstd[m];
                    if (u.pn == rope_pn) rope8(v0, v1, cs + (size_t)row * 32, fq);
                    bf16_t* dst = rowp + bj * 128;
                    if (HK) { const int h = 4 * (u.pn & 1) + 2 * bj + (wc >> 1);
                        const size_t tb = (size_t)((row >> 12) * 8 + h) * 64 + ((row & 4095) >> 6); const int k = row & 63;
                        dst = (u.pn < 2) ? HK + (tb * 8 + 4 * (wc & 1) + fq) * 512 + k * 8 : HV + (tb * 2 + (wc & 1)) * 2048 + k * 32 + 8 * fq; }
                    store8(dst, v0, v1);
                }
                asm volatile("" ::: "memory");
            }
        }
    }
};
struct EpiOut {
    static constexpr bool PERM = false, MID = false;
    const float* x; float* out; float* stats; const float* rs;
    __device__ __forceinline__ void operator()(const f32x4 (&acc)[2][2][4][2], const pg8::Unit& u, int wr, int wc, int fr_, int fq_) const {
        const int l_ = lane_id_nohoist(), fr = l_ & 15, fq = l_ >> 4;
        const int row0 = u.pm * 256 + wr * 64 + fr, col0 = u.pn * 256 + wc * 32 + 4 * fq;
#pragma unroll
        for (int ai = 0; ai < 2; ++ai)
#pragma unroll
            for (int m = 0; m < 4; ++m) {
                const int row = row0 + ai * 128 + m * 16; const size_t off = (size_t)row * DM + col0;
                const float rb = rs[(size_t)row * 2 + 1];
                float s = 0.f, q = 0.f;
#pragma unroll
                for (int bj = 0; bj < 2; ++bj)
#pragma unroll
                    for (int n = 0; n < 2; ++n) {
                        const f32x4 xv = *(const f32x4*)(x + off + bj * 128 + n * 16);
                        const f32x4 v = xv * DN_ALPHA + acc[ai][bj][m][n] * rb;
                        s += (v[0] + v[1]) + (v[2] + v[3]); q += (v[0] * v[0] + v[1] * v[1]) + (v[2] * v[2] + v[3] * v[3]);
                        *(f32x4*)(out + off + bj * 128 + n * 16) = v;
                    }
                s += __shfl_xor(s, 16); s += __shfl_xor(s, 32); q += __shfl_xor(q, 16); q += __shfl_xor(q, 32);
                if (fq == 0) *(f32x2*)(stats + (size_t)row * 32 + (u.pn * 4 + wc) * 2) = (f32x2){s, q};
            }
    }
};

constexpr int AT_KB = 12288, AT_VOFF = 3 * AT_KB, AT_VB = 8192, AT_POS = 8192, AT_MSK = 8448;
__device__ __forceinline__ s16x4 vtr(const LAS unsigned char* p) {
    typedef short v4i16_t __attribute__((ext_vector_type(4)));
    return __builtin_bit_cast(s16x4, __builtin_amdgcn_ds_read_tr16_b64_v4i16((LAS v4i16_t*)p));
}
typedef __bf16 bf16x2_t __attribute__((ext_vector_type(2)));
__device__ __forceinline__ unsigned cvtpk(float lo, float hi) { f32x2 v = {lo, hi}; bf16x2_t bb = __builtin_convertvector(v, bf16x2_t); return __builtin_bit_cast(unsigned, bb); }
__device__ __forceinline__ float swap32_max(float x) { auto r = __builtin_amdgcn_permlane32_swap(__float_as_uint(x), __float_as_uint(x), false, false); return fmaxf(__uint_as_float(r[0]), __uint_as_float(r[1])); }
__device__ __forceinline__ float swap32_sum(float x) { auto r = __builtin_amdgcn_permlane32_swap(__float_as_uint(x), __float_as_uint(x), false, false); return __uint_as_float(r[0]) + __uint_as_float(r[1]); }
__device__ __forceinline__ void dma16(const void* gbase, unsigned voff, unsigned lds_dst) { unsigned keep;
    asm volatile("s_mov_b32 %0, m0\n\ts_mov_b32 m0, %3\n\ts_nop 0\n\tglobal_load_lds_dwordx4 %1, %2\n\ts_mov_b32 m0, %0" : "=&s"(keep) : "v"(voff), "s"(gbase), "s"(lds_dst) : "memory"); }
__device__ __forceinline__ void dma4(const void* gbase, unsigned voff, unsigned lds_dst) { unsigned keep;
    asm volatile("s_mov_b32 %0, m0\n\ts_mov_b32 m0, %3\n\ts_nop 0\n\tglobal_load_lds_dword %1, %2\n\ts_mov_b32 m0, %0" : "=&s"(keep) : "v"(voff), "s"(gbase), "s"(lds_dst) : "memory"); }
#define AT_SYNC() asm volatile("s_waitcnt vmcnt(0) lgkmcnt(0)\n\ts_barrier" ::: "memory")

constexpr int AT_BUF = AT_KB + AT_VB;
constexpr float AT_THR = 8.0f;
constexpr int AT_MSK2 = AT_MSK + 1024;
template <int MODE>
__device__ __forceinline__ void attn_core(const bf16x8 (&qf)[2][6], const int NT, const int tlast, const int tqa, const int tqb, const bf16_t* ksrc, const bf16_t* rsrc, const bf16_t* vsrc,
                                          const unsigned long long* msrc, const float* psrc, const float pta, const float ptb, const float nslope, const int qja, const int qjb,
                                          LAS unsigned char* lds, const int wid, const int lane, f32x16 (&oT)[2][2], float (&l_out)[2]) {
    constexpr int NKS = (MODE == 0) ? 6 : 4;
    const int r32 = lane & 31, hi = lane >> 5;
    const int vboff = ((lane >> 4) & 1) * 32 + (lane & 3) * 8 + (4 * hi + ((lane & 15) >> 2)) * 64;
    const unsigned lds0 = (unsigned)(uintptr_t)lds;
#define AT_DMA(t, bsel) do { const unsigned _b = lds0 + (bsel) * AT_BUF; const unsigned _l = (unsigned)lane_id_nohoist(); \
        dma16(ksrc + (size_t)(t) * 4096, _l * 16u, (unsigned)__builtin_amdgcn_readfirstlane(_b + wid * 1024)); \
        if (MODE == 0) { if (wid >= 4) dma16(rsrc + (size_t)(t) * 2048, _l * 16u, (unsigned)__builtin_amdgcn_readfirstlane(_b + (8 + (wid & 3)) * 1024)); } \
        else { if (wid == 0) dma4(psrc + (size_t)(t) * 64, _l * 4u, (unsigned)__builtin_amdgcn_readfirstlane(_b + AT_POS)); \
               if (wid == 1) dma16(msrc + (size_t)(t) * 64, (_l & 31u) * 16u + (_l >> 5) * 32768u, (unsigned)__builtin_amdgcn_readfirstlane(_b + AT_MSK)); } \
        dma16(vsrc + (size_t)(t) * 4096, _l * 16u, (unsigned)__builtin_amdgcn_readfirstlane(_b + AT_KB + wid * 1024)); } while (0)
#define AT_SOFTMAX(p0, p1, o, mref, l, first) do { \
        float a = fmaxf(fmaxf(p0[0], p1[0]), p0[1]), bq = fmaxf(fmaxf(p1[1], p0[2]), p1[2]); \
        _Pragma("unroll") for (int r = 3; r < 15; r += 2) { a = fmaxf(fmaxf(a, p0[r]), p1[r]); bq = fmaxf(fmaxf(bq, p0[r + 1]), p1[r + 1]); } \
        const float mx = swap32_max(fmaxf(fmaxf(a, bq), fmaxf(p0[15], p1[15]))) - mref; \
        const bool mv = first ? (mx > -INFINITY) : (mx > AT_THR); \
        if (__any(mv)) { const float dl = (mx > -INFINITY && (first || mx > 0.f)) ? mx : 0.f; mref += dl; const float f = first ? 0.f : __builtin_amdgcn_exp2f(-dl); \
            _Pragma("unroll") for (int r = 0; r < 16; ++r) { o[0][r] *= f; o[1][r] *= f; } \
            l *= f; if (mx > -INFINITY) first = false; } \
        float sacc = 0.f; \
        _Pragma("unroll") for (int r = 0; r < 16; ++r) { p0[r] = __builtin_amdgcn_exp2f(p0[r] - mref); p1[r] = __builtin_amdgcn_exp2f(p1[r] - mref); sacc += p0[r] + p1[r]; } \
        l += sacc; } while (0)
#define AT_PACK(pw, p0, p1) _Pragma("unroll") for (int s4 = 0; s4 < 4; ++s4) { const f32x16& p = (s4 < 2) ? p0 : p1; const int o = 8 * (s4 & 1); \
            pw[s4] = (u32x4){cvtpk(p[o], p[o + 1]), cvtpk(p[o + 2], p[o + 3]), cvtpk(p[o + 4], p[o + 5]), cvtpk(p[o + 6], p[o + 7])}; }
    float mrefa = 0.f, mrefb = 0.f, la = 0.f, lb = 0.f; bool firsta = true, firstb = true;
    oT[0][0] = f32x16{}; oT[0][1] = f32x16{}; oT[1][0] = f32x16{}; oT[1][1] = f32x16{};
    AT_DMA(0, 0);
    AT_SYNC();
    for (int t = 0; t < NT; ++t) {
        const int cur = t & 1;
        if (t + 1 < NT) AT_DMA(t + 1, cur ^ 1);
        if (t <= tlast) {
        const LAS unsigned char* buf = lds + cur * AT_BUF;
        f32x16 pa0 = f32x16{}, pa1 = f32x16{}, pb0 = f32x16{}, pb1 = f32x16{};
        { const LAS unsigned char* kb = buf + hi * 1024 + r32 * 16;
#pragma unroll
          for (int d0 = 0; d0 < NKS; ++d0) { const bf16x8 a0 = *(const LAS bf16x8*)(kb + d0 * 2048), a1 = *(const LAS bf16x8*)(kb + d0 * 2048 + 512);
              pa0 = __builtin_amdgcn_mfma_f32_32x32x16_bf16(a0, qf[0][d0], pa0, 0, 0, 0); pa1 = __builtin_amdgcn_mfma_f32_32x32x16_bf16(a1, qf[0][d0], pa1, 0, 0, 0);
              pb0 = __builtin_amdgcn_mfma_f32_32x32x16_bf16(a0, qf[1][d0], pb0, 0, 0, 0); pb1 = __builtin_amdgcn_mfma_f32_32x32x16_bf16(a1, qf[1][d0], pb1, 0, 0, 0); } }
        if (MODE == 0) {
            if (t * 64 + 63 > tqa - r32) { const int kb0 = t * 64 + 4 * hi;
#pragma unroll
                for (int r = 0; r < 16; ++r) { const int ks = kb0 + (r & 3) + 8 * (r >> 2);
                    if (ks > tqa) pa0[r] = -INFINITY; if (ks + 32 > tqa) pa1[r] = -INFINITY; if (ks > tqb) pb0[r] = -INFINITY; if (ks + 32 > tqb) pb1[r] = -INFINITY; } }
        } else {
            const u32x2 mwa = *(const LAS u32x2*)(buf + AT_MSK + qja * 8), mwb = *(const LAS u32x2*)(buf + AT_MSK + qjb * 8);
            const unsigned wa0 = ~(mwa.x >> (4 * hi)), wa1 = ~(mwa.y >> (4 * hi)), wb0 = ~(mwb.x >> (4 * hi)), wb1 = ~(mwb.y >> (4 * hi));
#pragma unroll
            for (int c = 0; c < 4; ++c) { const f32x4 k0 = *(const LAS f32x4*)(buf + AT_POS + (4 * hi + 8 * c) * 4), k1 = *(const LAS f32x4*)(buf + AT_POS + (32 + 4 * hi + 8 * c) * 4);
#pragma unroll
                for (int j = 0; j < 4; ++j) { const int r = 4 * c + j;
                    pa0[r] = __builtin_fmaf(nslope, __builtin_fabsf(pta - k0[j]), pa0[r]) + __uint_as_float((unsigned)__builtin_amdgcn_sbfe((int)wa0, 8 * c + j, 1) & 0xff800000u);
                    pa1[r] = __builtin_fmaf(nslope, __builtin_fabsf(pta - k1[j]), pa1[r]) + __uint_as_float((unsigned)__builtin_amdgcn_sbfe((int)wa1, 8 * c + j, 1) & 0xff800000u);
                    pb0[r] = __builtin_fmaf(nslope, __builtin_fabsf(ptb - k0[j]), pb0[r]) + __uint_as_float((unsigned)__builtin_amdgcn_sbfe((int)wb0, 8 * c + j, 1) & 0xff800000u);
                    pb1[r] = __builtin_fmaf(nslope, __builtin_fabsf(ptb - k1[j]), pb1[r]) + __uint_as_float((unsigned)__builtin_amdgcn_sbfe((int)wb1, 8 * c + j, 1) & 0xff800000u); } }
        }
        AT_SOFTMAX(pa0, pa1, oT[0], mrefa, la, firsta);
        AT_SOFTMAX(pb0, pb1, oT[1], mrefb, lb, firstb);
        u32x4 pwa[4], pwb[4];
        AT_PACK(pwa, pa0, pa1)
        AT_PACK(pwb, pb0, pb1)
        { const LAS unsigned char* vbase = buf + AT_KB + vboff;
#pragma unroll
          for (int d0 = 0; d0 < 2; ++d0)
#pragma unroll
              for (int s4 = 0; s4 < 4; ++s4) {
                  const s16x4 vlo = vtr(vbase + d0 * 4096 + s4 * 1024), vhi = vtr(vbase + d0 * 4096 + s4 * 1024 + 512);
                  const bf16x8 vf = (bf16x8){vlo[0], vlo[1], vlo[2], vlo[3], vhi[0], vhi[1], vhi[2], vhi[3]};
                  oT[0][d0] = __builtin_amdgcn_mfma_f32_32x32x16_bf16(vf, __builtin_bit_cast(bf16x8, pwa[s4]), oT[0][d0], 0, 0, 0);
                  oT[1][d0] = __builtin_amdgcn_mfma_f32_32x32x16_bf16(vf, __builtin_bit_cast(bf16x8, pwb[s4]), oT[1][d0], 0, 0, 0);
              } }
        }
        AT_SYNC();
    }
    l_out[0] = la; l_out[1] = lb;
#undef AT_DMA
#undef AT_SOFTMAX
#undef AT_PACK
}
template <int MODE>
__device__ __forceinline__ void attn_store(const f32x16 (&oT)[2], float l, bf16_t* OAB, float* OSS, const bf16_t* PROJ, size_t tbase, int hh) {
    const int ln = lane_id_nohoist(), r32 = ln & 31, hi = ln >> 5;
    const size_t grow = tbase + ((MODE == 0) ? r32 : (r32 >> 2));
    const int head = (MODE == 0) ? hh : 4 * hh + (r32 & 3), ch = ((MODE == 0) ? 512 : 0) + head * 64, ohead = ((MODE == 0) ? 8 : 0) + head;
    bf16_t* orow = OAB + grow * DM + ch; const bf16_t* szrow = PROJ + grow * NPROJ + C_Z + ch;
    l = swap32_sum(l);
    const float inv = 1.0f / l;
    float ssq = 0.f;
#pragma unroll
    for (int d0 = 0; d0 < 2; ++d0)
#pragma unroll
        for (int c = 0; c < 4; ++c) {
            const u32x2 z = *(const u32x2*)(szrow + 32 * d0 + 8 * c + 4 * hi);
            const float a = oT[d0][4 * c] * inv, b = oT[d0][4 * c + 1] * inv, cc = oT[d0][4 * c + 2] * inv, d = oT[d0][4 * c + 3] * inv;
            ssq += (a * a + b * b) + (cc * cc + d * d);
            *(u32x2*)(orow + 32 * d0 + 8 * c + 4 * hi) = (u32x2){cvtpk(a * bf_lo(z.x), b * bf_hi(z.x)), cvtpk(cc * bf_lo(z.y), d * bf_hi(z.y))};
        }
    ssq = swap32_sum(ssq);
    if (hi == 0) OSS[grow * 16 + ohead] = ssq;
}

__device__ __forceinline__ void mla_unit(int b, int h, int qb, const bf16_t* QB, const bf16_t* PROJ, const bf16_t* KNC, const bf16_t* VBC, const bf16_t* KRC, bf16_t* OAB, float* OSS, LAS unsigned char* lds, const int wid) {
    const int lane = lane_id(), r32 = lane & 31, hi = lane >> 5;
    const size_t rowbase = (size_t)b * S; const int q0 = qb * 512, tqa = q0 + wid * 64 + r32, tqb = tqa + 32;
    const size_t hb = ((size_t)(b * 8 + h) * S) * 64;
    bf16x8 qf[2][6];
#pragma unroll
    for (int c = 0; c < 2; ++c) { const bf16_t* qrow = QB + (rowbase + tqa + 32 * c) * NQB;
#pragma unroll
      for (int d0 = 0; d0 < 4; ++d0) qf[c][d0] = *(const bf16x8*)(qrow + h * 64 + d0 * 16 + hi * 8);
#pragma unroll
      for (int d0 = 4; d0 < 6; ++d0) qf[c][d0] = *(const bf16x8*)(qrow + 512 + h * 32 + (d0 - 4) * 16 + hi * 8); }
    f32x16 oT[2][2]; float l[2];
    attn_core<0>(qf, 8 * (qb + 1), (q0 + wid * 64 + 63) >> 6, tqa, tqb, KNC + hb + wid * 512, KRC + rowbase * 32 + (wid & 3) * 512, VBC + hb + wid * 512,
                 nullptr, nullptr, 0.f, 0.f, 0.f, 0, 0, lds, wid, lane, oT, l);
    attn_store<0>(oT[0], l[0], OAB, OSS, PROJ, rowbase + q0 + wid * 64, h);
    attn_store<0>(oT[1], l[1], OAB, OSS, PROJ, rowbase + q0 + wid * 64 + 32, h);
}
__device__ __forceinline__ void dsa_unit(int b, int g, int qb, const bf16_t* PROJ, const bf16_t* KAC, const bf16_t* VAC, const unsigned long long* MASKT, const float* POSF, bf16_t* OAB, float* OSS, LAS unsigned char* lds, const int wid) {
    const int lane = lane_id(), r32 = lane & 31, hi = lane >> 5;
    const size_t rowbase = (size_t)b * S; const int q0 = qb * 128, qja = wid * 16 + (r32 >> 2), qjb = qja + 8, tqa = q0 + qja, tqb = q0 + qjb, head = 4 * g + (r32 & 3);
    const size_t gb = ((size_t)(b * 2 + g) * S) * 64;
    bf16x8 qf[2][6];
#pragma unroll
    for (int c = 0; c < 2; ++c) { const bf16_t* qrow = PROJ + (rowbase + tqa + 8 * c) * NPROJ + C_QA + head * 64;
#pragma unroll
      for (int d0 = 0; d0 < 4; ++d0) qf[c][d0] = *(const bf16x8*)(qrow + d0 * 16 + hi * 8);
      qf[c][4] = qf[c][0]; qf[c][5] = qf[c][0]; }
    const float pta = POSF[rowbase + tqa], ptb = POSF[rowbase + tqb];
    const float nslope = -__builtin_amdgcn_exp2f(-(float)(head + 1)) * LOG2E;
    f32x16 oT[2][2]; float l[2];
    attn_core<1>(qf, 2 * (qb + 1), (q0 + wid * 16 + 15) >> 6, tqa, tqb, KAC + gb + wid * 512, nullptr, VAC + gb + wid * 512,
                 MASKT + ((size_t)(b * 64 + 2 * qb) * 64) * 64, POSF + rowbase, pta, ptb, nslope, qja, qjb, lds, wid, lane, oT, l);
    attn_store<1>(oT[0], l[0], OAB, OSS, PROJ, rowbase + q0 + wid * 16, g);
    attn_store<1>(oT[1], l[1], OAB, OSS, PROJ, rowbase + q0 + wid * 16 + 8, g);
}

__device__ __forceinline__ int wave_sum_i(int x) {
    x += __builtin_amdgcn_update_dpp(0, x, 0xB1, 0xf, 0xf, true);
    x += __builtin_amdgcn_update_dpp(0, x, 0x4E, 0xf, 0xf, true);
    x += __builtin_amdgcn_update_dpp(0, x, 0x141, 0xf, 0xf, true);
    x += __builtin_amdgcn_update_dpp(0, x, 0x140, 0xf, 0xf, true);
    { auto r = __builtin_amdgcn_permlane16_swap((unsigned)x, (unsigned)x, false, false); x = (int)(r[0] + r[1]); }
    { auto r = __builtin_amdgcn_permlane32_swap((unsigned)x, (unsigned)x, false, false); x = (int)(r[0] + r[1]); }
    return __builtin_amdgcn_readfirstlane(x);
}
__device__ __forceinline__ float wave_max_f(float x) {
    x = fmaxf(x, __uint_as_float(__builtin_amdgcn_update_dpp(0, __float_as_uint(x), 0xB1, 0xf, 0xf, true)));
    x = fmaxf(x, __uint_as_float(__builtin_amdgcn_update_dpp(0, __float_as_uint(x), 0x4E, 0xf, 0xf, true)));
    x = fmaxf(x, __uint_as_float(__builtin_amdgcn_update_dpp(0, __float_as_uint(x), 0x141, 0xf, 0xf, true)));
    x = fmaxf(x, __uint_as_float(__builtin_amdgcn_update_dpp(0, __float_as_uint(x), 0x140, 0xf, 0xf, true)));
    { auto r = __builtin_amdgcn_permlane16_swap(__float_as_uint(x), __float_as_uint(x), false, false); x = fmaxf(__uint_as_float(r[0]), __uint_as_float(r[1])); }
    { auto r = __builtin_amdgcn_permlane32_swap(__float_as_uint(x), __float_as_uint(x), false, false); x = fmaxf(__uint_as_float(r[0]), __uint_as_float(r[1])); }
    return __uint_as_float(__builtin_amdgcn_readfirstlane(__float_as_uint(x)));
}
#define SEL_GE(cnt, xv, thr) asm volatile("v_cmp_ge_f32 vcc, %1, %2\n\tv_addc_co_u32 %0, vcc, 0, %0, vcc" : "+v"(cnt) : "v"(xv), "v"(thr) : "vcc")
#define SEL_GT(cnt, xv, thr) asm volatile("v_cmp_gt_f32 vcc, %1, %2\n\tv_addc_co_u32 %0, vcc, 0, %0, vcc" : "+v"(cnt) : "v"(xv), "v"(thr) : "vcc")
__device__ __forceinline__ void select_row(int t, const LAS float* sc, unsigned long long* mrow, int lane) {
    const int n = t + 1;
    if (n <= KTOP) {
        const int cnt = n - 64 * lane;
        mrow[(size_t)lane * 64] = cnt >= 64 ? ~0ull : (cnt <= 0 ? 0ull : ((1ull << cnt) - 1ull));
        return;
    }
    const int nreg = (n + 63) >> 6;
    float xv[64];
#define SEL_LD16(base) _Pragma("unroll") for (int i = (base); i < (base) + 16; ++i) xv[i] = sc[64 * i + lane];
#define SEL_NO16(base) _Pragma("unroll") for (int i = (base); i < (base) + 16; ++i) xv[i] = -INFINITY;
    SEL_LD16(0)
    if (nreg > 16) { SEL_LD16(16) } else { SEL_NO16(16) }
    if (nreg > 32) { SEL_LD16(32) } else { SEL_NO16(32) }
    if (nreg > 48) { SEL_LD16(48) } else { SEL_NO16(48) }
#undef SEL_LD16
#undef SEL_NO16
    float mx = -INFINITY, mn = INFINITY;
    const int nl = n - lane;
#define SEL_MM16(base) _Pragma("unroll") for (int i = (base); i < (base) + 16; ++i) { const bool ok = 64 * i < nl; const float v = xv[i]; xv[i] = ok ? v : -INFINITY; mx = fmaxf(mx, xv[i]); mn = fminf(mn, ok ? v : INFINITY); }
    SEL_MM16(0) if (nreg > 16) { SEL_MM16(16) } if (nreg > 32) { SEL_MM16(32) } if (nreg > 48) { SEL_MM16(48) }
#undef SEL_MM16
    mx = wave_max_f(mx); mn = -wave_max_f(-mn);
#define SEL_CNT16(base, MAC, V) _Pragma("unroll") for (int i = (base); i < (base) + 16; ++i) MAC(c, xv[i], V);
#define SEL_COUNT(MAC, V) do { c = 0; SEL_CNT16(0, MAC, V) if (nreg > 16) { SEL_CNT16(16, MAC, V) } if (nreg > 32) { SEL_CNT16(32, MAC, V) } if (nreg > 48) { SEL_CNT16(48, MAC, V) } c = wave_sum_i(c); } while (0)
    int c;
    float lo = mn, hi = mx, theta = mx; bool exact = false;
    SEL_COUNT(SEL_GE, mx);
    if (c >= KTOP) { if (c == KTOP) exact = true; else { lo = mx; hi = INFINITY; } }
    else {
#pragma unroll 1
        for (int it = 0; it < 64; ++it) {
            const float mid = __uint_as_float(__builtin_amdgcn_readfirstlane(__float_as_uint(lo + 0.5f * (hi - lo))));
            if (!(mid > lo) || !(mid < hi)) break;
            SEL_COUNT(SEL_GE, mid);
            if (c == KTOP) { exact = true; theta = mid; break; }
            if (c > KTOP) lo = mid; else hi = mid;
        }
    }
    unsigned long long myw = 0ull;
    if (exact) {
#define SEL_OUT16(base) _Pragma("unroll") for (int i = (base); i < (base) + 16; ++i) { const unsigned long long mk = __ballot(xv[i] >= theta); if (lane == i) myw = mk; }
        SEL_OUT16(0) if (nreg > 16) { SEL_OUT16(16) } if (nreg > 32) { SEL_OUT16(32) } if (nreg > 48) { SEL_OUT16(48) }
#undef SEL_OUT16
    } else {
        SEL_COUNT(SEL_GT, lo);
        int need = KTOP - c;
#pragma unroll
        for (int i = 0; i < 64; ++i) {
            if (i < nreg) {
                unsigned long long mk = __ballot(xv[i] > lo); const unsigned long long e = __ballot(xv[i] == lo);
                const int pe = __popcll(e);
                if (pe <= need) { mk |= e; need -= pe; }
                else { const int rank = __popcll(e & ((1ull << lane) - 1ull)); mk |= __ballot(((e >> lane) & 1ull) && rank < need); need = 0; }
                if (lane == i) myw = mk;
            }
        }
    }
#undef SEL_COUNT
#undef SEL_CNT16
    mrow[(size_t)lane * 64] = myw;
}

#define IDX_BAR() asm volatile("s_waitcnt lgkmcnt(0)\n\ts_barrier" ::: "memory")
__device__ __forceinline__ void idx_phase(int b, int sdeal, const bf16_t* PROJ, const bf16_t* IKC, unsigned long long* MASK, LAS unsigned char* lds, const int wid) {
    const int lane = lane_id(), r32 = lane & 31, hi = lane >> 5;
    const size_t rowbase = (size_t)b * S;
    LAS float* SC = (LAS float*)lds;
    const int qi = 2 * ((r32 >> 2) & 1) + (r32 >> 4), hd = (r32 & 3) + 4 * ((r32 >> 3) & 1);
    const bf16_t* qbase = PROJ + (rowbase + qi) * NPROJ + C_IQ + hd * 64 + hi * 8;
    const bf16_t* wbase = PROJ + (rowbase + 2 * hi) * NPROJ + C_IW;
    const bf16_t* kbase = IKC + (rowbase + wid * 32) * 64 + hi * 256 + r32 * 8;
    bf16x8 af[2][4]; u32x4 wv[2][2]; bf16x8 f0[4], f1[4], f2[4], f3[4];
#define IDX_J(u) (16 * (u) + (((u) & 1) ? 15 - sdeal : sdeal))
#define IDX_CNT(t0) ((((t0) + 8 + 31) >> 5) - wid + 7) >> 3
#define IDX_LOAD(dst, i, cnt) do { const int _i = ((i) < (cnt)) ? (i) : ((cnt) - 1); const bf16_t* _p = kbase + (size_t)_i * (256 * 64); \
        _Pragma("unroll") for (int d0 = 0; d0 < 4; ++d0) dst[d0] = *(const bf16x8*)(_p + d0 * 512); } while (0)
#define IDX_PREFETCH(t0) do { if ((t0) + 8 > KTOP) { const int _c = IDX_CNT(t0); \
        _Pragma("unroll") for (int mt = 0; mt < 2; ++mt) { const bf16_t* _q = qbase + (size_t)((t0) + 4 * mt) * NPROJ; \
            _Pragma("unroll") for (int d0 = 0; d0 < 4; ++d0) af[mt][d0] = *(const bf16x8*)(_q + d0 * 16); \
            _Pragma("unroll") for (int e = 0; e < 2; ++e) wv[mt][e] = *(const u32x4*)(wbase + (size_t)((t0) + 4 * mt + e) * NPROJ); } \
        IDX_LOAD(f0, 0, _c); IDX_LOAD(f1, 1, _c); IDX_LOAD(f2, 2, _c); } } while (0)
#define IDX_W(mt, e, h8) ((h8) == 0 ? bf_lo(wv[mt][e].x) : (h8) == 1 ? bf_hi(wv[mt][e].x) : (h8) == 2 ? bf_lo(wv[mt][e].y) : (h8) == 3 ? bf_hi(wv[mt][e].y) : \
                          (h8) == 4 ? bf_lo(wv[mt][e].z) : (h8) == 5 ? bf_hi(wv[mt][e].z) : (h8) == 6 ? bf_lo(wv[mt][e].w) : bf_hi(wv[mt][e].w))
#define IDX_COMP(src, i) do { f32x16 a0 = f32x16{}, a1 = f32x16{}; \
        _Pragma("unroll") for (int d0 = 0; d0 < 4; ++d0) { a0 = __builtin_amdgcn_mfma_f32_32x32x16_bf16(af[0][d0], src[d0], a0, 0, 0, 0); a1 = __builtin_amdgcn_mfma_f32_32x32x16_bf16(af[1][d0], src[d0], a1, 0, 0, 0); } \
        _Pragma("unroll") for (int mt = 0; mt < 2; ++mt) _Pragma("unroll") for (int e = 0; e < 2; ++e) { float s = 0.f; \
            _Pragma("unroll") for (int h8 = 0; h8 < 8; ++h8) s = __builtin_fmaf(w[mt][e][h8], fmaxf(mt == 0 ? a0[8 * e + h8] : a1[8 * e + h8], 0.f), s); \
            SC[(4 * mt + 2 * hi + e) * 4096 + (wid + 8 * (i)) * 32 + r32] = s; } } while (0)
    { const int t0 = 8 * IDX_J(0); IDX_PREFETCH(t0); }
    for (int u = 0; u < 32; ++u) {
        const int t0 = 8 * IDX_J(u);
        if (t0 + 8 > KTOP) {
            float w[2][2][8];
#pragma unroll
            for (int mt = 0; mt < 2; ++mt)
#pragma unroll
                for (int e = 0; e < 2; ++e)
#pragma unroll
                    for (int h8 = 0; h8 < 8; ++h8) w[mt][e][h8] = IDX_W(mt, e, h8);
            const int cnt = IDX_CNT(t0);
            for (int i = 0; i < cnt; i += 4) {
                IDX_LOAD(f3, i + 3, cnt); IDX_COMP(f0, i);
                if (i + 1 < cnt) { IDX_LOAD(f0, i + 4, cnt); IDX_COMP(f1, i + 1); }
                if (i + 2 < cnt) { IDX_LOAD(f1, i + 5, cnt); IDX_COMP(f2, i + 2); }
                if (i + 3 < cnt) { IDX_LOAD(f2, i + 6, cnt); IDX_COMP(f3, i + 3); }
            }
        }
        IDX_BAR();
        if (u + 1 < 32) { const int t1 = 8 * IDX_J(u + 1); IDX_PREFETCH(t1); }
        select_row(t0 + wid, SC + wid * 4096, MASK + ((size_t)(b * 64 + ((t0 + wid) >> 6)) * 64) * 64 + ((t0 + wid) & 63), lane);
        IDX_BAR();
    }
#undef IDX_J
#undef IDX_CNT
#undef IDX_LOAD
#undef IDX_PREFETCH
#undef IDX_W
#undef IDX_COMP
}

__device__ __forceinline__ void grid_bar(unsigned* ctr, unsigned target, int wave) {
    asm volatile("s_waitcnt vmcnt(0) lgkmcnt(0)" ::: "memory");
    __syncthreads();
    if (wave == 0 && lane_id() == 0) {
        __builtin_amdgcn_fence(__ATOMIC_RELEASE, "agent");
        asm volatile("s_waitcnt vmcnt(0)" ::: "memory");
        __hip_atomic_fetch_add(ctr, 1u, __ATOMIC_RELAXED, __HIP_MEMORY_SCOPE_AGENT);
        unsigned spins = 0;
        while (__hip_atomic_load(ctr, __ATOMIC_RELAXED, __HIP_MEMORY_SCOPE_AGENT) < target) { __builtin_amdgcn_s_sleep(2); if (++spins > (1u << 26)) break; }
        __builtin_amdgcn_fence(__ATOMIC_ACQUIRE, "agent");
        asm volatile("s_waitcnt vmcnt(0)" ::: "memory");
    }
    __syncthreads();
}

struct Args { const float* x; const int* pos; const float* w_in; const float* g_q; const float* w_uq; const float* g_kv; const float* w_ukv; const float* g_oa; const float* g_ob;
              const float* w_out; const float* ln_g; const float* ln_b; float* out; unsigned char* ws; int ph_lo, ph_hi; };

__device__ __forceinline__ void src_map(int kind, int n, int& src, float& sc) {
    sc = 1.f;
    if (kind == 0) {
        if (n < 512) { src = n; sc = QA_SCALE; }
        else if (n < 1280) src = n;
        else if (n < 1664) src = n - 1280 + 1352;
        else if (n < 1920) src = n - 1664 + 1736;
        else if (n < 1984) src = n - 1920 + 1280;
        else if (n < 2016) { const int e = n - 1984; src = 1992 + (e >> 1) + 16 * (e & 1); }
        else if (n < 2024) { src = n - 2016 + 1344; sc = IW_SCALE; }
        else if (n < 2048) src = -1;
        else src = n - 2048 + 2024;
    } else if (kind == 1) {
        if (n < 512) { const int h = n >> 6, d = n & 63; src = h * 96 + d; }
        else { const int e = n - 512, h = e >> 5, r = e & 31; src = h * 96 + 64 + (r >> 1) + 16 * (r & 1); }
        sc = QB_SCALE;
    } else if (kind == 2) {
        if (n < 512) { const int h = n >> 6, d = n & 63; src = h * 128 + d; }
        else { const int e = n - 512, h = e >> 6, d = e & 63; src = h * 128 + 64 + d; }
    } else src = n;
}
__device__ __forceinline__ void p0_transpose_item(const float* W, int K, int Nsrc, int Ndst, bf16_t* WT, int kind, const float* ks0, const float* ks1, LAS float* scr, int item, int lane) {
    const int nblk = Ndst / 32, kb = item / nblk, nb = item % nblk, k0 = 64 * kb, n0 = 32 * nb;
    int src; float sc; src_map(kind, n0 + (lane & 31), src, sc);
#pragma unroll 8
    for (int i = 0; i < 32; ++i) { const int kk = 2 * i + (lane >> 5), k = k0 + kk;
        float ksc = 1.f; if (ks0) ksc = (k < 512 || !ks1) ? ks0[k] : ks1[k - 512];
        scr[kk * 33 + (lane & 31)] = src >= 0 ? W[(size_t)k * Nsrc + src] * (sc * ksc) : 0.f; }
    asm volatile("s_waitcnt lgkmcnt(0)" ::: "memory");
    const int c = lane & 7;
#pragma unroll
    for (int jj = 0; jj < 4; ++jj) { const int n = (lane >> 3) + 8 * jj; const LAS float* s = scr + (8 * c) * 33 + n;
        u32x4 o; o.x = cvt_pk_bf16(s[0 * 33], s[1 * 33]); o.y = cvt_pk_bf16(s[2 * 33], s[3 * 33]); o.z = cvt_pk_bf16(s[4 * 33], s[5 * 33]); o.w = cvt_pk_bf16(s[6 * 33], s[7 * 33]);
        *(u32x4*)(WT + (size_t)(n0 + n) * K + k0 + 8 * c) = o; }
    asm volatile("s_waitcnt lgkmcnt(0)" ::: "memory");
}
__device__ __forceinline__ float wave_sum(float v) {
#pragma unroll
    for (int o = 1; o < 64; o <<= 1) v += __shfl_xor(v, o);
    return v;
}

__global__ void __launch_bounds__(512, 2) hybrid_fwd(Args a) {
    extern __shared__ __attribute__((aligned(16))) unsigned char lds_raw[];
    LAS unsigned char* lds = (LAS unsigned char*)lds_raw;
    const int wave = __builtin_amdgcn_readfirstlane(threadIdx.x >> 6);
#define lane lane_id()
#define tid (wave * 64 + lane_id())
    const int G = gridDim.x, bx = blockIdx.x, vcu = (G % 8 == 0) ? (bx % 8) * (G / 8) + bx / 8 : bx;
    unsigned char* ws = a.ws;
    bf16_t* W1T = (bf16_t*)(ws + WS_W1T); bf16_t* WUQT = (bf16_t*)(ws + WS_WUQT); bf16_t* WUKVT = (bf16_t*)(ws + WS_WUKVT); bf16_t* WOT = (bf16_t*)(ws + WS_WOT);
    float* CS = (float*)(ws + WS_CS); float* SSQ = (float*)(ws + WS_SSQ); float* POSF = (float*)(ws + WS_POSF); float* OSS = (float*)(ws + WS_OSS); float* STATS = (float*)(ws + WS_STATS);
    bf16_t* XB = (bf16_t*)(ws + WS_XB); bf16_t* PROJ = (bf16_t*)(ws + WS_PROJ); bf16_t* QB = (bf16_t*)(ws + WS_QB); bf16_t* KVB = (bf16_t*)(ws + WS_KVB);
    bf16_t* IKC = (bf16_t*)(ws + WS_IKC); bf16_t* KRC = (bf16_t*)(ws + WS_KRC); bf16_t* KAC = (bf16_t*)(ws + WS_KAC); bf16_t* VAC = (bf16_t*)(ws + WS_VAC);
    bf16_t* CQC = (bf16_t*)(ws + WS_CQC); bf16_t* CKVC = (bf16_t*)(ws + WS_CKVC); bf16_t* KNC = (bf16_t*)(ws + WS_KNC); bf16_t* VBC = (bf16_t*)(ws + WS_VBC);
    unsigned long long* MASK = (unsigned long long*)(ws + WS_MASK); bf16_t* OAB = (bf16_t*)(ws + WS_OAB); bf16_t* Y = (bf16_t*)(ws + WS_Y);
    const int lo = a.ph_lo, hi_ph = a.ph_hi;
#define IN(k) (lo <= (k) && (k) < hi_ph)
#define SEAM(k) do { if (IN(k) && IN((k) + 1)) { if ((k) == 0) cg::this_grid().sync(); else { ++nbar; grid_bar((unsigned*)ws, nbar * (unsigned)G, wave); } } } while (0)
    unsigned nbar = 0;
#define NOSEAM(k) do { if (IN(k) && IN((k) + 1)) { __syncthreads(); } } while (0)
    const int gw = vcu * 8 + wave, NGW = G * 8;
#define gt ((size_t)vcu * 512 + tid)
    const size_t NGT = (size_t)G * 512;

    if (IN(0)) {
        LAS float* scr = (LAS float*)(lds + wave * 16384);
        constexpr int I1 = (1024 / 64) * (NPROJ / 32), I2 = (384 / 64) * (NQB / 32), I3 = (256 / 64) * (NKVB / 32), I4 = (1024 / 64) * (1024 / 32);
        for (int it = gw; it < I1 + I2 + I3 + I4; it += NGW) {
            int r = it;
            if (r < I1) { p0_transpose_item(a.w_in, 1024, D_IN, NPROJ, W1T, 0, nullptr, nullptr, scr, r, lane); continue; } r -= I1;
            if (r < I2) { p0_transpose_item(a.w_uq, 384, NQB, NQB, WUQT, 1, a.g_q, nullptr, scr, r, lane); continue; } r -= I2;
            if (r < I3) { p0_transpose_item(a.w_ukv, 256, NKVB, NKVB, WUKVT, 2, a.g_kv, nullptr, scr, r, lane); continue; } r -= I3;
            p0_transpose_item(a.w_out, 1024, 1024, 1024, WOT, 3, a.g_oa, a.g_ob, scr, r, lane);
        }
        for (size_t c = gt; c < (size_t)M * 128; c += 4 * NGT) {
            f32x4 v[4][2];
#pragma unroll
            for (int k = 0; k < 4; ++k) { v[k][0] = __builtin_nontemporal_load((const f32x4*)(a.x + (c + k * NGT) * 8)); v[k][1] = __builtin_nontemporal_load((const f32x4*)(a.x + (c + k * NGT) * 8 + 4)); }
#pragma unroll
            for (int k = 0; k < 4; ++k)
                *(u32x4*)(XB + (c + k * NGT) * 8) = (u32x4){cvt_pk_bf16(v[k][0][0], v[k][0][1]), cvt_pk_bf16(v[k][0][2], v[k][0][3]), cvt_pk_bf16(v[k][1][0], v[k][1][1]), cvt_pk_bf16(v[k][1][2], v[k][1][3])};
        }
        for (size_t i = gt; i < (size_t)M * 16; i += NGT) {
            const size_t t = i >> 4; const int k = (int)(i & 15);
            const float p = (float)a.pos[t];
            const float invf = exp2f(-(float)k * 0.8304820237218406f);
            const float ang = p * invf;
            const double ad = (double)ang;
            const double kk = rint(ad * 0.15915494309189535);
            const double r = fma(-kk, 6.283185307179586, ad) - kk * 2.4492935982947064e-16;
            const double r2 = r * r;
            double sn = -8.2206352466243297e-18; sn = fma(sn, r2, 2.8114572543455206e-15); sn = fma(sn, r2, -7.6471637318198165e-13); sn = fma(sn, r2, 1.6059043836821613e-10);
            sn = fma(sn, r2, -2.5052108385441720e-08); sn = fma(sn, r2, 2.7557319223985893e-06); sn = fma(sn, r2, -1.9841269841269841e-04); sn = fma(sn, r2, 8.3333333333333332e-03);
            sn = fma(sn, r2, -1.6666666666666666e-01); sn = fma(sn * r2, r, r);
            double cn = 4.1103176233121648e-19; cn = fma(cn, r2, -1.5619206968586226e-16); cn = fma(cn, r2, 4.7794773323873853e-14); cn = fma(cn, r2, -1.1470745597729725e-11);
            cn = fma(cn, r2, 2.0876756987868099e-09); cn = fma(cn, r2, -2.7557319223985888e-07); cn = fma(cn, r2, 2.4801587301587302e-05); cn = fma(cn, r2, -1.3888888888888889e-03);
            cn = fma(cn, r2, 4.1666666666666664e-02); cn = fma(cn, r2, -0.5); cn = fma(cn, r2, 1.0);
            CS[t * 32 + k] = (float)cn; CS[t * 32 + 16 + k] = (float)sn;
            if (k == 0) POSF[t] = p;
        }
    }
    SEAM(0);
    if (IN(1)) {
        pg8::Gemm g{XB, W1T, M, NPROJ, 1024, 1024}; pg8::StaticOrder So; So.init(M, NPROJ, G, bx);
        EpiProj E{PROJ, CS, SSQ, IKC, KRC, KAC, VAC, CQC, CKVC};
        pg8::gemm_phase<EpiProj>(lds, g, So, E, wave);
    }
    SEAM(1);
    if (IN(2)) {
        { pg8::Gemm g{CQC, WUQT, M, NQB, 384, 384}; pg8::StaticOrder So; So.init(M, NQB, G, bx);
          EpiUp E{QB, NQB, SSQ, 0, 3, 1.0f / 384.0f, CS, 2, nullptr, nullptr};
          pg8::gemm_phase<EpiUp>(lds, g, So, E, wave); }
        { pg8::Gemm g{CKVC, WUKVT, M, NKVB, 256, 256}; pg8::StaticOrder So; So.init(M, NKVB, G, bx);
          EpiUp E{KVB, NKVB, SSQ, 12, 2, 1.0f / 256.0f, CS, -1, KNC, VBC};
          pg8::gemm_phase<EpiUp>(lds, g, So, E, wave); }
    }
    NOSEAM(2);
    if (IN(3)) {
        idx_phase(vcu >> 4, vcu & 15, PROJ, IKC, MASK, lds, wave);
    }
    SEAM(3);
    if (IN(4)) {
        const int bh = vcu >> 1, s = vcu & 1, b = bh >> 3, h = bh & 7;
        for (int i = 0; i < 2; ++i) { const int qa = 2 * i + s; mla_unit(b, h, 7 - qa, QB, PROJ, KNC, VBC, KRC, OAB, OSS, lds, wave); mla_unit(b, h, qa, QB, PROJ, KNC, VBC, KRC, OAB, OSS, lds, wave); }
    }
    NOSEAM(4);
    if (IN(5)) {
        const int bg = vcu >> 3, s = vcu & 7, b = bg >> 1, g = bg & 1;
        for (int i = 0; i < 2; ++i) { const int qa = 8 * i + s; dsa_unit(b, g, 31 - qa, PROJ, KAC, VAC, MASK, POSF, OAB, OSS, lds, wave); dsa_unit(b, g, qa, PROJ, KAC, VAC, MASK, POSF, OAB, OSS, lds, wave); }
    }
    SEAM(5);
    if (IN(6)) {
        float* RS = (float*)(ws + WS_SSQ);
        for (int row0 = gw * 4; row0 < M; row0 += NGW * 4) {
            u32x4 o[4]; float rat[4];
#pragma unroll
            for (int k = 0; k < 4; ++k) { const size_t row = (size_t)(row0 + k);
                o[k] = *(const u32x4*)(OAB + row * DM + lane * 8);
                const f32x4 a0 = *(const f32x4*)(OSS + row * 16), a1 = *(const f32x4*)(OSS + row * 16 + 4), b0 = *(const f32x4*)(OSS + row * 16 + 8), b1 = *(const f32x4*)(OSS + row * 16 + 12);
                const float ra = __builtin_amdgcn_rsqf(((a0[0] + a0[1]) + (a0[2] + a0[3]) + (a1[0] + a1[1]) + (a1[2] + a1[3])) * (1.0f / 512.0f) + 1e-6f);
                const float rb = __builtin_amdgcn_rsqf(((b0[0] + b0[1]) + (b0[2] + b0[3]) + (b1[0] + b1[1]) + (b1[2] + b1[3])) * (1.0f / 512.0f) + 1e-6f);
                rat[k] = ra / rb;
                if (lane == 0) *(f32x2*)(RS + row * 2) = (f32x2){rat[k], rb}; }
#pragma unroll
            for (int k = 0; k < 4; ++k) { const float r = rat[k]; u32x4 y;
                y.x = cvt_pk_bf16(bf_lo(o[k].x) * r, bf_hi(o[k].x) * r); y.y = cvt_pk_bf16(bf_lo(o[k].y) * r, bf_hi(o[k].y) * r);
                y.z = cvt_pk_bf16(bf_lo(o[k].z) * r, bf_hi(o[k].z) * r); y.w = cvt_pk_bf16(bf_lo(o[k].w) * r, bf_hi(o[k].w) * r);
                *(u32x4*)(OAB + (size_t)(row0 + k) * DM + lane * 8) = y; }
        }
    }
    SEAM(6);
    if (IN(7)) {
        pg8::Gemm g{OAB, WOT, M, DM, 1024, 1024}; pg8::StaticOrder So; So.init(M, DM, G, bx);
        EpiOut E{a.x, a.out, STATS, (const float*)(ws + WS_SSQ)};
        pg8::gemm_phase<EpiOut>(lds, g, So, E, wave);
    }
    SEAM(7);
    if (IN(8)) {
        for (int row = gw; row < M; row += NGW) {
            float s = 0.f, q = 0.f;
            if (lane < 16) { const f32x2 t = *(const f32x2*)(STATS + (size_t)row * 32 + 2 * lane); s = t.x; q = t.y; }
            s = wave_sum(s); q = wave_sum(q);
            const float mean = s * (1.0f / DM), var = q * (1.0f / DM) - mean * mean, rstd = 1.0f / sqrtf(fmaxf(var, 0.f) + 1e-5f);
            float* orow = a.out + (size_t)row * DM;
#pragma unroll
            for (int jj = 0; jj < 4; ++jj) { const int col = jj * 256 + lane * 4;
                const f32x4 v = *(const f32x4*)(orow + col), gg = *(const f32x4*)(a.ln_g + col), bb = *(const f32x4*)(a.ln_b + col);
                *(f32x4*)(orow + col) = (v - mean) * rstd * gg + bb; }
        }
    }
#undef IN
#undef lane
#undef tid
#undef gt
#undef SEAM
#undef NOSEAM
}

constexpr int N_PHASES = 9;
#ifndef PROBE_PHASE
#define PROBE_PHASE -1
#endif
extern "C" void kernel_launch(void* const* d_in, const int* in_sizes, int n_in, void* d_out, int out_size, void* d_ws, size_t ws_size, hipStream_t stream) {
    static int grid = 0;
    if (grid == 0) {
        if (n_in != 12 || in_sizes[0] != M * DM || out_size != M * DM || ws_size < WS_END) { fprintf(stderr, "kernel_launch: unexpected shapes (n_in %d, in0 %d, out %d, ws %zu)\n", n_in, n_in > 0 ? in_sizes[0] : -1, out_size, ws_size); grid = -1; return; }
        int dev = 0, cus = 0, per_cu = 0;
        if (hipGetDevice(&dev) != hipSuccess || hipDeviceGetAttribute(&cus, hipDeviceAttributeMultiprocessorCount, dev) != hipSuccess) { grid = -1; return; }
        if (hipFuncSetAttribute((const void*)hybrid_fwd, hipFuncAttributeMaxDynamicSharedMemorySize, LDS_BYTES) != hipSuccess) { fprintf(stderr, "kernel_launch: hipFuncSetAttribute failed\n"); grid = -1; return; }
        if (hipOccupancyMaxActiveBlocksPerMultiprocessor(&per_cu, (const void*)hybrid_fwd, 512, LDS_BYTES) != hipSuccess || per_cu < 1) { fprintf(stderr, "kernel_launch: occupancy query says %d\n", per_cu); per_cu = 1; }
        (void)hipGetLastError();
        grid = cus;
        if (grid != 256) fprintf(stderr, "kernel_launch: %d CUs; this kernel's work deals assume 256\n", grid);
    }
    if (grid < 0) return;
    Args a{};
    a.x = (const float*)d_in[0]; a.pos = (const int*)d_in[1]; a.w_in = (const float*)d_in[2]; a.g_q = (const float*)d_in[3]; a.w_uq = (const float*)d_in[4]; a.g_kv = (const float*)d_in[5];
    a.w_ukv = (const float*)d_in[6]; a.g_oa = (const float*)d_in[7]; a.g_ob = (const float*)d_in[8]; a.w_out = (const float*)d_in[9]; a.ln_g = (const float*)d_in[10]; a.ln_b = (const float*)d_in[11];
    a.out = (float*)d_out; a.ws = (unsigned char*)d_ws;
    (void)hipMemsetAsync(d_ws, 0, 256, stream);
#if MK_N_LAUNCHES == 1
    a.ph_lo = 0; a.ph_hi = N_PHASES;
    void* args[] = {&a};
    hipError_t e = hipLaunchCooperativeKernel((const void*)hybrid_fwd, dim3(grid), dim3(512), args, LDS_BYTES, stream);
    if (e != hipSuccess) fprintf(stderr, "kernel_launch: cooperative launch failed: %s (grid %d)\n", hipGetErrorString(e), grid);
#else
    for (int p = 0; p < N_PHASES; ++p) {
        a.ph_lo = p; a.ph_hi = p + 1;
        for (int rep = 0; rep < ((p == PROBE_PHASE) ? 2 : 1); ++rep) hipLaunchKernelGGL(hybrid_fwd, dim3(grid), dim3(512), LDS_BYTES, stream, a);
    }
#endif
}
```

```cpp
#include <hip/hip_runtime.h>
#include <hip/hip_cooperative_groups.h>
#include <cstdio>
#include <cstdint>
namespace cg = cooperative_groups;

#ifndef MK_N_LAUNCHES
#define MK_N_LAUNCHES 1
#endif

#define LAS __attribute__((address_space(3)))
typedef unsigned short bf16_t;
typedef short bf16x8 __attribute__((ext_vector_type(8)));
typedef short s16x4 __attribute__((ext_vector_type(4)));
typedef float f32x4 __attribute__((ext_vector_type(4)));
typedef float f32x2 __attribute__((ext_vector_type(2)));
typedef float f32x16 __attribute__((ext_vector_type(16)));
typedef unsigned u32x4 __attribute__((ext_vector_type(4)));
typedef unsigned u32x2 __attribute__((ext_vector_type(2)));

constexpr int NB = 16, S = 4096, M = NB * S, DM = 1024;
constexpr int NPROJ = 3072;
constexpr int C_QA = 0, C_KA = 512, C_VA = 640, C_IQ = 768, C_CQ = 1280, C_CKV = 1664, C_IK = 1920, C_KR = 1984, C_IW = 2016, C_Z = 2048;
constexpr int D_IN = 3048;
constexpr int NQB = 768, NKVB = 1024;
constexpr float LOG2E = 1.4426950408889634f;
constexpr float QA_SCALE = 0.125f * LOG2E;
constexpr float QB_SCALE = 0.10206207261596577f * LOG2E;
constexpr float IW_SCALE = 0.04419417382415922f;
constexpr float DN_ALPHA = 1.189207115002721f;
constexpr int KTOP = 256;

constexpr size_t MiB = 1u << 20;
constexpr size_t WS_W1T = 1 * MiB, WS_WUQT = 7 * MiB, WS_WUKVT = 8 * MiB, WS_WOT = 9 * MiB, WS_CS = 11 * MiB, WS_SSQ = 19 * MiB, WS_POSF = 25 * MiB,
                 WS_OSS = 26 * MiB, WS_STATS = 30 * MiB, WS_XB = 64 * MiB, WS_PROJ = 192 * MiB, WS_QB = 576 * MiB, WS_KVB = 672 * MiB, WS_MASK = 800 * MiB,
                 WS_IKC = 832 * MiB, WS_KRC = 840 * MiB, WS_KAC = 848 * MiB, WS_VAC = 864 * MiB, WS_CQC = 880 * MiB, WS_CKVC = 928 * MiB, WS_END = 960 * MiB;
constexpr size_t WS_KNC = WS_KVB, WS_VBC = WS_KVB + 64 * MiB;
constexpr size_t WS_PCNT = 4096;
constexpr size_t WS_OAB = WS_XB;
constexpr size_t WS_Y = WS_KVB;

constexpr int LDS_BYTES = 148480;

__device__ __forceinline__ unsigned cvt_pk_bf16(float lo, float hi) { unsigned r; asm volatile("v_cvt_pk_bf16_f32 %0, %1, %2" : "=v"(r) : "v"(lo), "v"(hi)); return r; }
__device__ __forceinline__ float bf_lo(unsigned u) { return __uint_as_float(u << 16); }
__device__ __forceinline__ float bf_hi(unsigned u) { return __uint_as_float(u & 0xffff0000u); }
__device__ __forceinline__ int crow(int r, int hi) { return (r & 3) + 8 * (r >> 2) + 4 * hi; }
__device__ __forceinline__ float silu_f(float v) { return v * __builtin_amdgcn_rcpf(1.0f + __builtin_amdgcn_exp2f(-v * LOG2E)); }
__device__ __forceinline__ size_t proj_off(size_t row, int col) { return ((row >> 4) * (size_t)(3072 / 8) + (size_t)(col >> 3)) * 128 + (row & 15) * 8 + (col & 7); }
__device__ __forceinline__ size_t vb_off(size_t row, int col) { return ((row >> 4) * (size_t)(1024 / 8) + (size_t)(col >> 3)) * 128 + (row & 15) * 8 + (col & 7); }
__device__ __forceinline__ float relu_f(float x) { const int b = __float_as_int(x); return __int_as_float(b > 0 ? b : 0); }
__device__ __forceinline__ int lane_id() { return (int)__builtin_amdgcn_mbcnt_hi(~0u, __builtin_amdgcn_mbcnt_lo(~0u, 0u)); }
__device__ __forceinline__ void glds16(const void* g, LAS unsigned char* l) { __builtin_amdgcn_global_load_lds((const unsigned*)g, (LAS unsigned*)l, 16, 0, 0); }

namespace pg8 {
constexpr int BM = 256, BK = 64, HALF = 128, HTB = HALF * BK * 2, STAGE_BYTES = 8 * HTB, NXCD = 8, WGM = 8;
__host__ __device__ __forceinline__ int lds_byte(int r, int c) { const int st = (r >> 4) * 2 + (c >> 5), rr = r & 15, cc = c & 31, ob = rr * 64 + cc * 2; return st * 1024 + (ob ^ (((ob >> 9) & 1) << 5)); }
__host__ __device__ __forceinline__ void stage_rc(int b, int& R, int& C) { const int st = b / 1024, sb = b % 1024, swz = sb ^ (((sb >> 9) & 1) << 5); R = (st >> 1) * 16 + swz / 64; C = (st & 1) * 32 + (swz % 64) / 2; }
__host__ __device__ __forceinline__ int perm32(int rho) { const int n = rho >> 4, i = rho & 15; return 8 * (i >> 2) + 4 * n + (i & 3); }

struct Unit { int pm, pn; };
struct Gemm { const bf16_t* A; const bf16_t* Bt; int M, N, K, lda; };

struct StaticOrder {
    int nM, nN, nwg, G, c;
    __host__ __device__ void init(int M_, int N_, int G_, int c_) { nM = M_ / BM; nN = N_ / BM; nwg = nM * nN; G = G_; c = c_; }
    __host__ __device__ bool next(int i, Unit& u) const {
        const long L = (long)i * G + c; if (L >= nwg) return false;
        int wgid = (int)L; { const int q = nwg / NXCD, r = nwg % NXCD, xcd = wgid % NXCD; int off = wgid / NXCD;
            if (nN == 12 && G % NXCD == 0) { const int per = G / NXCD, st = off / per, j = off % per; off = st * per + (j + 8 * (st / 3)) % per; }
            wgid = (xcd < r ? xcd * (q + 1) : r * (q + 1) + (xcd - r) * q) + off; }
        const int nig = WGM * nN, gid = wgid / nig, fm = gid * WGM, gsz = (nM - fm) < WGM ? (nM - fm) : WGM;
        u.pm = fm + ((wgid % nig) % gsz); u.pn = (wgid % nig) / gsz; return true;
    }
};

template <class Epi>
__device__ __forceinline__ void gemm_phase(LAS unsigned char* lds, const Gemm g, const StaticOrder& S, const Epi& E, const int wid) {
    const int lane = lane_id(), tid = wid * 64 + lane, wr = wid >> 2, wc = wid & 3, fr = lane & 15, fq = lane >> 4;
    const int K = g.K, nt = K / BK, lda = g.lda;
    unsigned voffA[2], voffB[2];
#pragma unroll
    for (int i = 0; i < 2; ++i) { int R, C; stage_rc(tid * 16 + i * 8192, R, C); const int Rb = Epi::PERM ? ((R & ~31) + perm32(R & 31)) : R;
        voffA[i] = (unsigned)(R * lda + C) * 2u; voffB[i] = (unsigned)(Rb * K + C) * 2u; }
    const size_t kstep = (size_t)(BK * 2);
    const size_t hstepA = (size_t)HALF * lda * 2, tstepA = 2 * hstepA;
    const size_t hstepB = (size_t)HALF * K * 2, tstepB = 2 * hstepB;
    const unsigned ldsw = (unsigned)wid * 1024u;
    const int aoff = lds_byte(wr * 64 + fr, fq * 8), boff = lds_byte(wc * 32 + fr, fq * 8);
#define PG8_SA(b, h) (((b) * 2 + (h)) * HTB)
#define PG8_SB(b, h) ((4 + (b) * 2 + (h)) * HTB)
#define PG8_STAGE(bufoff, gbase, voff) do { _Pragma("unroll") for (int _i = 0; _i < 2; ++_i) \
        __builtin_amdgcn_global_load_lds((const unsigned*)((const char*)(gbase) + (voff)[_i]), (LAS unsigned*)(lds + (bufoff) + ldsw + _i * 8192), 16, 0, 0); } while (0)
#define PG8_LDA(dst, b, h) do { _Pragma("unroll") for (int m = 0; m < 4; ++m) _Pragma("unroll") for (int k = 0; k < 2; ++k) dst[m][k] = *(const LAS bf16x8*)(lds + PG8_SA(b, h) + aoff + m * 2048 + k * 1024); } while (0)
#define PG8_LDB(dst, b, h) do { _Pragma("unroll") for (int n = 0; n < 2; ++n) _Pragma("unroll") for (int k = 0; k < 2; ++k) dst[n][k] = *(const LAS bf16x8*)(lds + PG8_SB(b, h) + boff + n * 2048 + k * 1024); } while (0)
#define PG8_MMA(ai, bj, At, Bt) do { __builtin_amdgcn_s_setprio(1); _Pragma("unroll") for (int m = 0; m < 4; ++m) _Pragma("unroll") for (int n = 0; n < 2; ++n) _Pragma("unroll") for (int k = 0; k < 2; ++k) \
        acc[ai][bj][m][n] = __builtin_amdgcn_mfma_f32_16x16x32_bf16(Bt[n][k], At[m][k], acc[ai][bj][m][n], 0, 0, 0); __builtin_amdgcn_s_setprio(0); } while (0)
#define PG8_WAIT_V(n) asm volatile("s_waitcnt vmcnt(" #n ")" ::: "memory")
#define PG8_WAIT_L(n) asm volatile("s_waitcnt lgkmcnt(" #n ")" ::: "memory")
#define PG8_BAR __builtin_amdgcn_s_barrier()
#define PG8_SCHED __builtin_amdgcn_sched_barrier(0)
    Unit cur, nxt; int ui = 0;
    if (!S.next(0, cur)) return;
    f32x4 acc[2][2][4][2];
#pragma unroll
    for (int a = 0; a < 2; ++a)
#pragma unroll
        for (int b = 0; b < 2; ++b)
#pragma unroll
            for (int m = 0; m < 4; ++m)
#pragma unroll
                for (int n = 0; n < 2; ++n) acc[a][b][m][n] = (f32x4){0.f, 0.f, 0.f, 0.f};
    bf16x8 At[4][2], B0[2][2], B1[2][2];
    const char* cA = (const char*)g.A + (size_t)cur.pm * tstepA; const char* cB = (const char*)g.Bt + (size_t)cur.pn * tstepB;
    PG8_STAGE(PG8_SB(0, 0), cB, voffB); PG8_STAGE(PG8_SB(0, 1), cB + hstepB, voffB); PG8_STAGE(PG8_SA(0, 0), cA, voffA); PG8_STAGE(PG8_SA(0, 1), cA + hstepA, voffA);
    if (wr == 1) PG8_BAR;
    PG8_WAIT_V(2); PG8_BAR;
    PG8_STAGE(PG8_SB(1, 0), cB + kstep, voffB); PG8_STAGE(PG8_SA(1, 0), cA + kstep, voffA); PG8_STAGE(PG8_SB(1, 1), cB + hstepB + kstep, voffB);
    PG8_WAIT_V(6); PG8_BAR;
    for (;;) {
        const bool has_next = S.next(ui + 1, nxt);
        const char* nA = has_next ? (const char*)g.A + (size_t)nxt.pm * tstepA : cA; const char* nB = has_next ? (const char*)g.Bt + (size_t)nxt.pn * tstepB : cB;
        for (int t = 0; t < nt; t += 2) {
            if constexpr (Epi::MID) {
                if (t == nt / 2) {
                    float midf[2][4]; E.mid_load(midf, cur, wr);
#pragma unroll
                    for (int a = 0; a < 2; ++a)
#pragma unroll
                        for (int b = 0; b < 2; ++b)
#pragma unroll
                            for (int m = 0; m < 4; ++m)
#pragma unroll
                                for (int n = 0; n < 2; ++n) acc[a][b][m][n] *= midf[a][m];
                }
            }
            const bool last = (t == nt - 2);
            const char* a1 = cA + (size_t)(t + 1) * kstep;
            const char* a2 = last ? nA : cA + (size_t)(t + 2) * kstep; const char* b2 = last ? nB : cB + (size_t)(t + 2) * kstep;
            const char* a3 = a2 + kstep; const char* b3 = b2 + kstep;
            PG8_LDB(B0, 0, 0); PG8_LDB(B1, 0, 1); PG8_SCHED; PG8_LDA(At, 0, 0); PG8_STAGE(PG8_SA(1, 1), a1 + hstepA, voffA);
            PG8_WAIT_V(8); PG8_WAIT_L(0); PG8_BAR; PG8_MMA(0, 0, At, B0); PG8_MMA(0, 1, At, B1); PG8_BAR; PG8_SCHED;
            PG8_LDA(At, 0, 1); PG8_STAGE(PG8_SB(0, 0), b2, voffB); PG8_STAGE(PG8_SB(0, 1), b2 + hstepB, voffB); PG8_STAGE(PG8_SA(0, 0), a2, voffA);
            PG8_WAIT_V(8); PG8_WAIT_L(0); PG8_BAR; PG8_MMA(1, 0, At, B0); PG8_MMA(1, 1, At, B1); PG8_BAR; PG8_SCHED;
            PG8_LDB(B0, 1, 0); PG8_LDB(B1, 1, 1); PG8_SCHED; PG8_LDA(At, 1, 0); PG8_STAGE(PG8_SA(0, 1), a2 + hstepA, voffA);
            PG8_WAIT_V(8); PG8_WAIT_L(0); PG8_BAR; PG8_MMA(0, 0, At, B0); PG8_MMA(0, 1, At, B1); PG8_BAR; PG8_SCHED;
            PG8_LDA(At, 1, 1); PG8_STAGE(PG8_SB(1, 0), b3, voffB); PG8_STAGE(PG8_SB(1, 1), b3 + hstepB, voffB); PG8_STAGE(PG8_SA(1, 0), a3, voffA);
            PG8_WAIT_V(8); PG8_WAIT_L(0); PG8_BAR; PG8_MMA(1, 0, At, B0); PG8_MMA(1, 1, At, B1); PG8_BAR; PG8_SCHED;
        }
        if (wr == 0) PG8_BAR;
        if constexpr (Epi::FUSED) E.fused(acc, cur, wr, wc, lds + 131072, wid); else E(acc, cur, wr, wc, fr, fq);
        if (!has_next) break;
#pragma unroll
        for (int a = 0; a < 2; ++a)
#pragma unroll
            for (int b = 0; b < 2; ++b)
#pragma unroll
                for (int m = 0; m < 4; ++m)
#pragma unroll
                    for (int n = 0; n < 2; ++n) acc[a][b][m][n] = (f32x4){0.f, 0.f, 0.f, 0.f};
        cur = nxt; cA = nA; cB = nB; ++ui;
        if (wr == 1) PG8_BAR;
    }
    PG8_WAIT_V(0);
    PG8_BAR;
#undef PG8_SA
#undef PG8_SB
#undef PG8_STAGE
#undef PG8_LDA
#undef PG8_LDB
#undef PG8_MMA
#undef PG8_WAIT_V
#undef PG8_WAIT_L
#undef PG8_BAR
#undef PG8_SCHED
}
}

__device__ __forceinline__ int lane_id_nohoist() { int l; asm volatile("v_mbcnt_lo_u32_b32 %0, -1, 0\n\tv_mbcnt_hi_u32_b32 %0, -1, %0" : "=v"(l)); return l; }

__device__ __forceinline__ void rope8(f32x4& v0, f32x4& v1, const float* csrow, int fq) {
    const f32x4 c = *(const f32x4*)(csrow + 4 * fq), s = *(const f32x4*)(csrow + 16 + 4 * fq);
    const float a0 = v0[0] * c[0] - v0[1] * s[0], b0 = v0[0] * s[0] + v0[1] * c[0];
    const float a1 = v0[2] * c[1] - v0[3] * s[1], b1 = v0[2] * s[1] + v0[3] * c[1];
    const float a2 = v1[0] * c[2] - v1[1] * s[2], b2 = v1[0] * s[2] + v1[1] * c[2];
    const float a3 = v1[2] * c[3] - v1[3] * s[3], b3 = v1[2] * s[3] + v1[3] * c[3];
    v0 = (f32x4){a0, b0, a1, b1}; v1 = (f32x4){a2, b2, a3, b3};
}
__device__ __forceinline__ void rope8r(f32x4& v0, f32x4& v1, const f32x4& c, const f32x4& s) {
    const float a0 = v0[0] * c[0] - v0[1] * s[0], b0 = v0[0] * s[0] + v0[1] * c[0];
    const float a1 = v0[2] * c[1] - v0[3] * s[1], b1 = v0[2] * s[1] + v0[3] * c[1];
    const float a2 = v1[0] * c[2] - v1[1] * s[2], b2 = v1[0] * s[2] + v1[1] * c[2];
    const float a3 = v1[2] * c[3] - v1[3] * s[3], b3 = v1[2] * s[3] + v1[3] * c[3];
    v0 = (f32x4){a0, b0, a1, b1}; v1 = (f32x4){a2, b2, a3, b3};
}
__device__ __forceinline__ void store8(bf16_t* p, const f32x4& v0, const f32x4& v1) {
    u32x4 w; w.x = cvt_pk_bf16(v0[0], v0[1]); w.y = cvt_pk_bf16(v0[2], v0[3]); w.z = cvt_pk_bf16(v1[0], v1[1]); w.w = cvt_pk_bf16(v1[2], v1[3]);
    *(u32x4*)p = w;
}

struct EpiProj {
    static constexpr bool PERM = true, MID = false, FUSED = false;
    bf16_t* P; const float* cs; float* ssq; bf16_t* IKC; bf16_t* KRC; bf16_t* KAC; bf16_t* VAC; bf16_t* CQC; bf16_t* CKVC;
    __device__ __forceinline__ void operator()(const f32x4 (&acc)[2][2][4][2], const pg8::Unit& u, int wr, int wc, int fr_, int fq_) const {
        const int l_ = lane_id_nohoist(), fr = l_ & 15, fq = l_ >> 4;
        const int row0 = u.pm * 256 + wr * 64 + fr, colt = u.pn * 256 + wc * 32 + 8 * fq, pn = u.pn;
#pragma unroll
        for (int ai = 0; ai < 2; ++ai) {
            f32x4 rc[4], rs[4];
            if (pn == 7 && wc == 2) {
#pragma unroll
                for (int m = 0; m < 4; ++m) { const float* cp = cs + (size_t)(row0 + ai * 128 + m * 16) * 32 + 4 * fq; rc[m] = *(const f32x4*)cp; rs[m] = *(const f32x4*)(cp + 16); }
            }
#pragma unroll
            for (int m = 0; m < 4; ++m) {
                const int row = row0 + ai * 128 + m * 16;
#pragma unroll
                for (int bj = 0; bj < 2; ++bj) {
                    f32x4 v0 = acc[ai][bj][m][0], v1 = acc[ai][bj][m][1];
                    bf16_t* dst = P + proj_off((size_t)row, colt + bj * 128);
                    if (pn >= 8) {
#pragma unroll
                        for (int j = 0; j < 4; ++j) { v0[j] = silu_f(v0[j]); v1[j] = silu_f(v1[j]); }
                    } else if (pn == 2) {
                        const size_t tb = (size_t)((row >> 12) * 2 + (wc >> 1)) * 64 + ((row & 4095) >> 6); const int k = row & 63;
                        dst = (bj == 0) ? KAC + (tb * 8 + 4 * (wc & 1) + fq) * 512 + k * 8 : VAC + (tb * 2 + (wc & 1)) * 2048 + k * 32 + 8 * fq;
                    } else if (pn >= 5) {
                        int slot = -1;
                        if (pn == 5) { slot = bj * 4 + wc; dst = CQC + (size_t)row * 384 + bj * 128 + wc * 32 + 8 * fq; }
                        else if (pn == 6) { if (bj == 0) { slot = 8 + wc; dst = CQC + (size_t)row * 384 + 256 + wc * 32 + 8 * fq; } else { slot = 12 + wc; dst = CKVC + (size_t)row * 256 + wc * 32 + 8 * fq; } }
                        else if (bj == 0) { slot = 16 + wc; dst = CKVC + (size_t)row * 256 + 128 + wc * 32 + 8 * fq; }
                        if (slot >= 0) {
                            float s = (v0[0] * v0[0] + v0[1] * v0[1]) + (v0[2] * v0[2] + v0[3] * v0[3]) + (v1[0] * v1[0] + v1[1] * v1[1]) + (v1[2] * v1[2] + v1[3] * v1[3]);
                            s += __shfl_xor(s, 16); s += __shfl_xor(s, 32);
                            if (fq == 0) ssq[(size_t)row * 20 + slot] = s;
                        } else if (wc < 2) dst = IKC + ((size_t)(row >> 5) * 8 + 4 * wc + fq) * 256 + (row & 31) * 8;
                        else if (wc == 2) { rope8r(v0, v1, rc[m], rs[m]); dst = KRC + ((size_t)(row >> 6) * 4 + fq) * 512 + (row & 63) * 8; }
                    }
                    store8(dst, v0, v1);
                }
                asm volatile("" ::: "memory");
            }
        }
    }
};
struct EpiUp {
    static constexpr bool PERM = true, MID = false, FUSED = false;
    bf16_t* O; int ldc; const float* ssq; int slot0, nslot4; float invK; const float* cs; int rope_pn; bf16_t* HK; bf16_t* HV;
    __device__ __forceinline__ void operator()(const f32x4 (&acc)[2][2][4][2], const pg8::Unit& u, int wr, int wc, int fr_, int fq_) const {
        const int l_ = lane_id_nohoist(), fr = l_ & 15, fq = l_ >> 4;
        const int row0 = u.pm * 256 + wr * 64 + fr, colt = u.pn * 256 + wc * 32 + 8 * fq;
#pragma unroll
        for (int ai = 0; ai < 2; ++ai) {
            float rstd[4];
            { f32x4 tq[4][3];
#pragma unroll
              for (int m = 0; m < 4; ++m)
#pragma unroll
                  for (int q = 0; q < 3; ++q) tq[m][q] = (q < nslot4) ? *(const f32x4*)(ssq + (size_t)(row0 + ai * 128 + m * 16) * 20 + slot0 + 4 * q) : (f32x4){0.f, 0.f, 0.f, 0.f};
#pragma unroll
              for (int m = 0; m < 4; ++m) { const f32x4 t = tq[m][0] + tq[m][1] + tq[m][2]; rstd[m] = __builtin_amdgcn_rsqf(((t[0] + t[1]) + (t[2] + t[3])) * invK + 1e-6f); } }
            f32x4 rc[4], rs[4];
            if (u.pn == rope_pn) {
#pragma unroll
                for (int m = 0; m < 4; ++m) { const float* cp = cs + (size_t)(row0 + ai * 128 + m * 16) * 32 + 4 * fq; rc[m] = *(const f32x4*)cp; rs[m] = *(const f32x4*)(cp + 16); }
            }
#pragma unroll
            for (int m = 0; m < 4; ++m) {
                const int row = row0 + ai * 128 + m * 16; bf16_t* rowp = O + (size_t)row * ldc + colt;
#pragma unroll
                for (int bj = 0; bj < 2; ++bj) {
                    f32x4 v0 = acc[ai][bj][m][0] * rstd[m], v1 = acc[ai][bj][m][1] * rstd[m];
                    if (u.pn == rope_pn) rope8r(v0, v1, rc[m], rs[m]);
                    bf16_t* dst = rowp + bj * 128;
                    if (HK) { const int h = 4 * (u.pn & 1) + 2 * bj + (wc >> 1);
                        const size_t tb = (size_t)((row >> 12) * 8 + h) * 64 + ((row & 4095) >> 6); const int k = row & 63;
                        dst = (u.pn < 2) ? HK + (tb * 8 + 4 * (wc & 1) + fq) * 512 + k * 8 : HV + (tb * 2 + (wc & 1)) * 2048 + k * 32 + 8 * fq; }
                    store8(dst, v0, v1);
                }
                asm volatile("" ::: "memory");
            }
        }
    }
};
struct EpiOut {
    static constexpr bool PERM = true, MID = true, FUSED = true;
    const float* x; float* out; unsigned long long* xbuf; unsigned* cnt; const float* oss; const float* ln_g; const float* ln_b;
    __device__ __forceinline__ float rstd_of(const float* p) const { const f32x4 s0 = *(const f32x4*)p, s1 = *(const f32x4*)(p + 4);
        return __builtin_amdgcn_rsqf((((s0[0] + s0[1]) + (s0[2] + s0[3])) + ((s1[0] + s1[1]) + (s1[2] + s1[3]))) * (1.0f / 512.0f) + 1e-6f); }
    __device__ __forceinline__ void mid_load(float (&f)[2][4], const pg8::Unit& u, int wr) const {
        const int fr = lane_id_nohoist() & 15;
#pragma unroll
        for (int ai = 0; ai < 2; ++ai)
#pragma unroll
            for (int m = 0; m < 4; ++m) { const float* p = oss + (size_t)(u.pm * 256 + wr * 64 + fr + ai * 128 + m * 16) * 16; f[ai][m] = rstd_of(p) / rstd_of(p + 8); }
    }
    __device__ __forceinline__ void fused(f32x4 (&acc)[2][2][4][2], const pg8::Unit& u, int wr, int wc, LAS unsigned char* tl, int wid) const {
        LAS f32x2* P = (LAS f32x2*)tl;
        LAS f32x2* SX = (LAS f32x2*)(tl + 8192);
        { const int l_ = lane_id_nohoist(), fr = l_ & 15, fq = l_ >> 4;
          const int row0 = u.pm * 256 + wr * 64 + fr, col0 = u.pn * 256 + wc * 32 + 8 * fq;
#pragma unroll
          for (int ai = 0; ai < 2; ++ai)
#pragma unroll
            for (int m = 0; m < 4; ++m) {
                const int row = row0 + ai * 128 + m * 16; const size_t off = (size_t)row * DM + col0;
                const float rb = rstd_of(oss + (size_t)row * 16 + 8);
                float sm = 0.f, q = 0.f;
#pragma unroll
                for (int bj = 0; bj < 2; ++bj) {
                    const f32x4 x0 = *(const f32x4*)(x + off + bj * 128), x1 = *(const f32x4*)(x + off + bj * 128 + 4);
                    const f32x4 v0 = x0 * DN_ALPHA + acc[ai][bj][m][0] * rb, v1 = x1 * DN_ALPHA + acc[ai][bj][m][1] * rb;
                    sm += ((v0[0] + v0[1]) + (v0[2] + v0[3])) + ((v1[0] + v1[1]) + (v1[2] + v1[3]));
                    q += ((v0[0] * v0[0] + v0[1] * v0[1]) + (v0[2] * v0[2] + v0[3] * v0[3])) + ((v1[0] * v1[0] + v1[1] * v1[1]) + (v1[2] * v1[2] + v1[3] * v1[3]));
                    acc[ai][bj][m][0] = v0; acc[ai][bj][m][1] = v1;
                }
                sm += __shfl_xor(sm, 16); sm += __shfl_xor(sm, 32); q += __shfl_xor(q, 16); q += __shfl_xor(q, 32);
                if (fq == 0) P[(ai * 128 + wr * 64 + m * 16 + fr) * 4 + wc] = (f32x2){sm, q};
                asm volatile("" ::: "memory");
            } }
        asm volatile("s_waitcnt lgkmcnt(0)" ::: "memory"); __builtin_amdgcn_s_barrier(); asm volatile("" ::: "memory");
        const int ln = lane_id_nohoist(), rl = wid * 32 + (ln & 31);
        if (ln < 32) {
            const f32x2 a = P[rl * 4 + 0], b = P[rl * 4 + 1], c = P[rl * 4 + 2], d = P[rl * 4 + 3];
            const float st = (a.x + b.x) + (c.x + d.x), qt = (a.y + b.y) + (c.y + d.y);
            __hip_atomic_store(xbuf + ((size_t)(u.pm * 256 + rl) * 4 + u.pn), ((unsigned long long)__float_as_uint(qt) << 32) | __float_as_uint(st), __ATOMIC_RELAXED, __HIP_MEMORY_SCOPE_AGENT);
        }
        asm volatile("s_waitcnt vmcnt(0)" ::: "memory");
        if (ln == 0) __hip_atomic_fetch_add(cnt + 64 * u.pm, 1u, __ATOMIC_RELAXED, __HIP_MEMORY_SCOPE_AGENT);
        if (wid == 0) {
            unsigned spins = 0;
            while ((unsigned)__builtin_amdgcn_readfirstlane((int)__hip_atomic_load(cnt + 64 * u.pm, __ATOMIC_RELAXED, __HIP_MEMORY_SCOPE_AGENT)) < 32u) { __builtin_amdgcn_s_sleep(1); if (++spins > (1u << 24)) break; }
            __builtin_amdgcn_fence(__ATOMIC_ACQUIRE, "agent");
        }
        asm volatile("s_waitcnt vmcnt(0) lgkmcnt(0)" ::: "memory"); __builtin_amdgcn_s_barrier(); asm volatile("" ::: "memory");
        if (ln < 32) {
            const unsigned long long* slot = xbuf + (size_t)(u.pm * 256 + rl) * 4; float st = 0.f, qt = 0.f;
#pragma unroll
            for (int t = 0; t < 4; ++t) { const unsigned long long w = __hip_atomic_load(slot + t, __ATOMIC_RELAXED, __HIP_MEMORY_SCOPE_AGENT); st += __uint_as_float((unsigned)w); qt += __uint_as_float((unsigned)(w >> 32)); }
            const float mean = st * (1.0f / DM), var = qt * (1.0f / DM) - mean * mean;
            SX[rl] = (f32x2){mean, 1.0f / sqrtf(fmaxf(var, 0.f) + 1e-5f)};
        }
        asm volatile("s_waitcnt lgkmcnt(0)" ::: "memory"); __builtin_amdgcn_s_barrier(); asm volatile("" ::: "memory");
        { const int l_ = lane_id_nohoist(), fr = l_ & 15, fq = l_ >> 4;
          const int col0 = u.pn * 256 + wc * 32 + 8 * fq;
#pragma unroll
          for (int bj = 0; bj < 2; ++bj) {
              const int col = col0 + bj * 128;
              const f32x4 g0 = *(const f32x4*)(ln_g + col), g1 = *(const f32x4*)(ln_g + col + 4), b0 = *(const f32x4*)(ln_b + col), b1 = *(const f32x4*)(ln_b + col + 4);
#pragma unroll
              for (int ai = 0; ai < 2; ++ai)
#pragma unroll
                  for (int m = 0; m < 4; ++m) { const int r = ai * 128 + wr * 64 + m * 16 + fr; const f32x2 sr = SX[r];
                      float* op = out + (size_t)(u.pm * 256 + r) * DM + col;
                      *(f32x4*)op = (acc[ai][bj][m][0] - sr.x) * sr.y * g0 + b0; *(f32x4*)(op + 4) = (acc[ai][bj][m][1] - sr.x) * sr.y * g1 + b1; }
              asm volatile("" ::: "memory");
          } }
    }
    __device__ __forceinline__ void operator()(const f32x4 (&acc)[2][2][4][2], const pg8::Unit& u, int wr, int wc, int fr_, int fq_) const {}
};

constexpr int AT_KB = 12288, AT_VOFF = 3 * AT_KB, AT_VB = 8192, AT_POS = 8192, AT_MSK = 8448;
__device__ __forceinline__ s16x4 vtr(const LAS unsigned char* p) {
    typedef short v4i16_t __attribute__((ext_vector_type(4)));
    return __builtin_bit_cast(s16x4, __builtin_amdgcn_ds_read_tr16_b64_v4i16((LAS v4i16_t*)p));
}
typedef __bf16 bf16x2_t __attribute__((ext_vector_type(2)));
__device__ __forceinline__ unsigned cvtpk(float lo, float hi) { f32x2 v = {lo, hi}; bf16x2_t bb = __builtin_convertvector(v, bf16x2_t); return __builtin_bit_cast(unsigned, bb); }
__device__ __forceinline__ float swap32_max(float x) { auto r = __builtin_amdgcn_permlane32_swap(__float_as_uint(x), __float_as_uint(x), false, false); return fmaxf(__uint_as_float(r[0]), __uint_as_float(r[1])); }
__device__ __forceinline__ float swap32_sum(float x) { auto r = __builtin_amdgcn_permlane32_swap(__float_as_uint(x), __float_as_uint(x), false, false); return __uint_as_float(r[0]) + __uint_as_float(r[1]); }
__device__ __forceinline__ void dma16(const void* gbase, unsigned voff, unsigned lds_dst) { unsigned keep;
    asm volatile("s_mov_b32 %0, m0\n\ts_mov_b32 m0, %3\n\ts_nop 0\n\tglobal_load_lds_dwordx4 %1, %2\n\ts_mov_b32 m0, %0" : "=&s"(keep) : "v"(voff), "s"(gbase), "s"(lds_dst) : "memory"); }
__device__ __forceinline__ void dma4(const void* gbase, unsigned voff, unsigned lds_dst) { unsigned keep;
    asm volatile("s_mov_b32 %0, m0\n\ts_mov_b32 m0, %3\n\ts_nop 0\n\tglobal_load_lds_dword %1, %2\n\ts_mov_b32 m0, %0" : "=&s"(keep) : "v"(voff), "s"(gbase), "s"(lds_dst) : "memory"); }
#define AT_SYNC() asm volatile("s_waitcnt vmcnt(0) lgkmcnt(0)\n\ts_barrier" ::: "memory")

constexpr int AT_BUF = AT_KB + AT_VB;
constexpr float AT_THR = 8.0f;
constexpr int AT_MSK2 = AT_MSK + 1024;
template <int MODE>
__device__ __forceinline__ void attn_prime(const bf16_t* ksrc, const bf16_t* rsrc, const bf16_t* vsrc, const unsigned long long* msrc, const float* psrc, LAS unsigned char* lds, const int wid) {
    const unsigned _b = (unsigned)(uintptr_t)lds; const unsigned _l = (unsigned)lane_id_nohoist();
    dma16(ksrc, _l * 16u, (unsigned)__builtin_amdgcn_readfirstlane(_b + wid * 1024));
    if (MODE == 0) { if (wid >= 4) dma16(rsrc, _l * 16u, (unsigned)__builtin_amdgcn_readfirstlane(_b + (8 + (wid & 3)) * 1024)); }
    else { if (wid == 0) dma4(psrc, _l * 4u, (unsigned)__builtin_amdgcn_readfirstlane(_b + AT_POS));
           if (wid == 1) dma16(msrc, (_l & 31u) * 16u + (_l >> 5) * 32768u, (unsigned)__builtin_amdgcn_readfirstlane(_b + AT_MSK)); }
    dma16(vsrc, _l * 16u, (unsigned)__builtin_amdgcn_readfirstlane(_b + AT_KB + wid * 1024));
}
template <int MODE>
__device__ __forceinline__ void attn_core(const bf16x8 (&qf)[2][6], const int NT, const int tlast, const int tqbase, const int tlastb, const int tqbaseb, const bf16_t* ksrc, const bf16_t* rsrc, const bf16_t* vsrc,
                                          const unsigned long long* msrc, const float* psrc, const float pta, const float nsa, const float nsb, const int qjbase,
                                          LAS unsigned char* lds, const int wid, const int lane, f32x16 (&oT)[2][2], float (&l_out)[2]) {
    constexpr int NKS = (MODE == 0) ? 6 : 4;
    const int r32 = lane & 31, hi = lane >> 5;
    const int vboff = ((lane >> 4) & 1) * 32 + (lane & 3) * 8 + (4 * hi + ((lane & 15) >> 2)) * 64;
    const unsigned lds0 = (unsigned)(uintptr_t)lds;
#define AT_DMA(t, bsel) do { const unsigned _b = lds0 + (bsel) * AT_BUF; const unsigned _l = (unsigned)lane_id_nohoist(); \
        dma16(ksrc + (size_t)(t) * 4096, _l * 16u, (unsigned)__builtin_amdgcn_readfirstlane(_b + wid * 1024)); \
        if (MODE == 0) { if (wid >= 4) dma16(rsrc + (size_t)(t) * 2048, _l * 16u, (unsigned)__builtin_amdgcn_readfirstlane(_b + (8 + (wid & 3)) * 1024)); } \
        else { if (wid == 0) dma4(psrc + (size_t)(t) * 64, _l * 4u, (unsigned)__builtin_amdgcn_readfirstlane(_b + AT_POS)); \
               if (wid == 1) dma16(msrc + (size_t)(t) * 64, (_l & 31u) * 16u + (_l >> 5) * 32768u, (unsigned)__builtin_amdgcn_readfirstlane(_b + AT_MSK)); } \
        dma16(vsrc + (size_t)(t) * 4096, _l * 16u, (unsigned)__builtin_amdgcn_readfirstlane(_b + AT_KB + wid * 1024)); } while (0)
#define AT_SOFTMAX(p0, p1, o, mref, l, first) do { \
        float a = fmaxf(fmaxf(p0[0], p1[0]), p0[1]), bq = fmaxf(fmaxf(p1[1], p0[2]), p1[2]); \
        _Pragma("unroll") for (int r = 3; r < 15; r += 2) { a = fmaxf(fmaxf(a, p0[r]), p1[r]); bq = fmaxf(fmaxf(bq, p0[r + 1]), p1[r + 1]); } \
        const float mx = swap32_max(fmaxf(fmaxf(a, bq), fmaxf(p0[15], p1[15]))) - mref; \
        const bool mv = first ? (mx > -INFINITY) : (mx > AT_THR); \
        if (__any(mv)) { const float dl = (mx > -INFINITY && (first || mx > 0.f)) ? mx : 0.f; mref += dl; const float f = first ? 0.f : __builtin_amdgcn_exp2f(-dl); \
            _Pragma("unroll") for (int r = 0; r < 16; ++r) { o[0][r] *= f; o[1][r] *= f; } \
            l *= f; if (mx > -INFINITY) first = false; } \
        float sacc = 0.f; \
        _Pragma("unroll") for (int r = 0; r < 16; ++r) { p0[r] = __builtin_amdgcn_exp2f(p0[r] - mref); p1[r] = __builtin_amdgcn_exp2f(p1[r] - mref); sacc += p0[r] + p1[r]; } \
        l += sacc; } while (0)
#define AT_PACK(pw, p0, p1) _Pragma("unroll") for (int s4 = 0; s4 < 4; ++s4) { const f32x16& p = (s4 < 2) ? p0 : p1; const int o = 8 * (s4 & 1); \
            pw[s4] = (u32x4){cvtpk(p[o], p[o + 1]), cvtpk(p[o + 2], p[o + 3]), cvtpk(p[o + 4], p[o + 5]), cvtpk(p[o + 6], p[o + 7])}; }
    float mrefa = 0.f, mrefb = 0.f, la = 0.f, lb = 0.f; bool firsta = true, firstb = true;
    oT[0][0] = f32x16{}; oT[0][1] = f32x16{}; oT[1][0] = f32x16{}; oT[1][1] = f32x16{};
    AT_SYNC();
    for (int t = 0; t < NT; ++t) {
        const int cur = t & 1;
        if (t + 1 < NT) AT_DMA(t + 1, cur ^ 1);
        if (MODE == 0 && t > tlast && t <= tlastb) {
            const LAS unsigned char* buf = lds + cur * AT_BUF;
            f32x16 pb0 = f32x16{}, pb1 = f32x16{};
            { const LAS unsigned char* kb = buf + hi * 1024 + r32 * 16;
              __builtin_amdgcn_s_setprio(1);
#pragma unroll
              for (int d0 = 0; d0 < NKS; ++d0) { const bf16x8 a0 = *(const LAS bf16x8*)(kb + d0 * 2048), a1 = *(const LAS bf16x8*)(kb + d0 * 2048 + 512);
                  pb0 = __builtin_amdgcn_mfma_f32_32x32x16_bf16(a0, qf[1][d0], pb0, 0, 0, 0); pb1 = __builtin_amdgcn_mfma_f32_32x32x16_bf16(a1, qf[1][d0], pb1, 0, 0, 0); }
              __builtin_amdgcn_s_setprio(0); }
            if (t * 64 + 63 > tqbaseb) { const int kb0 = t * 64 + 4 * hi, tqb = tqbaseb + (lane_id_nohoist() & 31);
#pragma unroll
                for (int r = 0; r < 16; ++r) { const int ks = kb0 + (r & 3) + 8 * (r >> 2); if (ks > tqb) pb0[r] = -INFINITY; if (ks + 32 > tqb) pb1[r] = -INFINITY; } }
            AT_SOFTMAX(pb0, pb1, oT[1], mrefb, lb, firstb);
            u32x4 pwb[4];
            AT_PACK(pwb, pb0, pb1)
            { const LAS unsigned char* vbase = buf + AT_KB + vboff;
              __builtin_amdgcn_s_setprio(1);
#pragma unroll
              for (int d0 = 0; d0 < 2; ++d0)
#pragma unroll
                  for (int s4 = 0; s4 < 4; ++s4) {
                      const s16x4 vlo = vtr(vbase + d0 * 4096 + s4 * 1024), vhi = vtr(vbase + d0 * 4096 + s4 * 1024 + 512);
                      const bf16x8 vf = (bf16x8){vlo[0], vlo[1], vlo[2], vlo[3], vhi[0], vhi[1], vhi[2], vhi[3]};
                      oT[1][d0] = __builtin_amdgcn_mfma_f32_32x32x16_bf16(vf, __builtin_bit_cast(bf16x8, pwb[s4]), oT[1][d0], 0, 0, 0);
                  }
              __builtin_amdgcn_s_setprio(0); }
        } else
        if (t <= tlast) {
        const LAS unsigned char* buf = lds + cur * AT_BUF;
        f32x16 pa0 = f32x16{}, pa1 = f32x16{}, pb0 = f32x16{}, pb1 = f32x16{};
        if (MODE == 1) {
            const u32x2 mwa = *(const LAS u32x2*)(buf + AT_MSK + (qjbase + (lane_id_nohoist() & 31)) * 8);
            const unsigned wa0 = ~(mwa.x >> (4 * hi)), wa1 = ~(mwa.y >> (4 * hi));
#pragma unroll
            for (int r = 0; r < 16; ++r) { const int bit = 8 * (r >> 2) + (r & 3);
                pa0[r] = __uint_as_float((unsigned)__builtin_amdgcn_sbfe((int)wa0, bit, 1) & 0xff800000u); pa1[r] = __uint_as_float((unsigned)__builtin_amdgcn_sbfe((int)wa1, bit, 1) & 0xff800000u); }
        }
        { const LAS unsigned char* kb = buf + hi * 1024 + r32 * 16;
          __builtin_amdgcn_s_setprio(1);
#pragma unroll
          for (int d0 = 0; d0 < NKS; ++d0) { const bf16x8 a0 = *(const LAS bf16x8*)(kb + d0 * 2048), a1 = *(const LAS bf16x8*)(kb + d0 * 2048 + 512);
              if (MODE == 1 && d0 == 0) {
                  pb0 = __builtin_amdgcn_mfma_f32_32x32x16_bf16(a0, qf[1][d0], pa0, 0, 0, 0); pb1 = __builtin_amdgcn_mfma_f32_32x32x16_bf16(a1, qf[1][d0], pa1, 0, 0, 0);
                  pa0 = __builtin_amdgcn_mfma_f32_32x32x16_bf16(a0, qf[0][d0], pa0, 0, 0, 0); pa1 = __builtin_amdgcn_mfma_f32_32x32x16_bf16(a1, qf[0][d0], pa1, 0, 0, 0);
              } else {
              pa0 = __builtin_amdgcn_mfma_f32_32x32x16_bf16(a0, qf[0][d0], pa0, 0, 0, 0); pa1 = __builtin_amdgcn_mfma_f32_32x32x16_bf16(a1, qf[0][d0], pa1, 0, 0, 0);
              pb0 = __builtin_amdgcn_mfma_f32_32x32x16_bf16(a0, qf[1][d0], pb0, 0, 0, 0); pb1 = __builtin_amdgcn_mfma_f32_32x32x16_bf16(a1, qf[1][d0], pb1, 0, 0, 0); } }
          __builtin_amdgcn_s_setprio(0); }
        if (MODE == 0) {
            if (t * 64 + 63 > tqbase) { const int kb0 = t * 64 + 4 * hi, tqa = tqbase + (lane_id_nohoist() & 31), tqb = tqbaseb + (lane_id_nohoist() & 31);
#pragma unroll
                for (int r = 0; r < 16; ++r) { const int ks = kb0 + (r & 3) + 8 * (r >> 2);
                    if (ks > tqa) pa0[r] = -INFINITY; if (ks + 32 > tqa) pa1[r] = -INFINITY; if (ks > tqb) pb0[r] = -INFINITY; if (ks + 32 > tqb) pb1[r] = -INFINITY; } }
        } else {
#pragma unroll
            for (int c = 0; c < 4; ++c) { const f32x4 k0 = *(const LAS f32x4*)(buf + AT_POS + (4 * hi + 8 * c) * 4), k1 = *(const LAS f32x4*)(buf + AT_POS + (32 + 4 * hi + 8 * c) * 4);
#pragma unroll
                for (int j = 0; j < 4; ++j) { const int r = 4 * c + j;
                    const float d0_ = __builtin_fabsf(pta - k0[j]), d1_ = __builtin_fabsf(pta - k1[j]);
                    pa0[r] = __builtin_fmaf(nsa, d0_, pa0[r]); pa1[r] = __builtin_fmaf(nsa, d1_, pa1[r]);
                    pb0[r] = __builtin_fmaf(nsb, d0_, pb0[r]); pb1[r] = __builtin_fmaf(nsb, d1_, pb1[r]); }
                if (c == 1) __builtin_amdgcn_sched_barrier(0); }
        }
        AT_SOFTMAX(pa0, pa1, oT[0], mrefa, la, firsta);
        AT_SOFTMAX(pb0, pb1, oT[1], mrefb, lb, firstb);
        u32x4 pwa[4], pwb[4];
        AT_PACK(pwa, pa0, pa1)
        AT_PACK(pwb, pb0, pb1)
        { const LAS unsigned char* vbase = buf + AT_KB + vboff;
          __builtin_amdgcn_s_setprio(1);
#pragma unroll
          for (int d0 = 0; d0 < 2; ++d0)
#pragma unroll
              for (int s4 = 0; s4 < 4; ++s4) {
                  const s16x4 vlo = vtr(vbase + d0 * 4096 + s4 * 1024), vhi = vtr(vbase + d0 * 4096 + s4 * 1024 + 512);
                  const bf16x8 vf = (bf16x8){vlo[0], vlo[1], vlo[2], vlo[3], vhi[0], vhi[1], vhi[2], vhi[3]};
                  oT[0][d0] = __builtin_amdgcn_mfma_f32_32x32x16_bf16(vf, __builtin_bit_cast(bf16x8, pwa[s4]), oT[0][d0], 0, 0, 0);
                  oT[1][d0] = __builtin_amdgcn_mfma_f32_32x32x16_bf16(vf, __builtin_bit_cast(bf16x8, pwb[s4]), oT[1][d0], 0, 0, 0);
              }
          __builtin_amdgcn_s_setprio(0); }
        }
        AT_SYNC();
    }
    l_out[0] = la; l_out[1] = lb;
#undef AT_DMA
#undef AT_SOFTMAX
#undef AT_PACK
}
__device__ __forceinline__ void attn_store(const f32x16 (&oT)[2], float l, bf16_t* OAB, float* OSS, const bf16_t* PROJ, size_t tbase, int ch, int ohead) {
    const int ln = lane_id_nohoist(), r32 = ln & 31, hi = ln >> 5;
    const size_t grow = tbase + r32;
    bf16_t* orow = OAB + grow * DM + ch; const bf16_t* szrow = PROJ + proj_off(grow, C_Z + ch) + 4 * hi;
    l = swap32_sum(l);
    const float inv = 1.0f / l;
    float ssq = 0.f;
    u32x2 zz[8];
#pragma unroll
    for (int k = 0; k < 8; ++k) zz[k] = *(const u32x2*)(szrow + k * 128);
#pragma unroll
    for (int d0 = 0; d0 < 2; ++d0)
#pragma unroll
        for (int c = 0; c < 4; ++c) {
            const u32x2 z = zz[4 * d0 + c];
            const float a = oT[d0][4 * c] * inv, b = oT[d0][4 * c + 1] * inv, cc = oT[d0][4 * c + 2] * inv, d = oT[d0][4 * c + 3] * inv;
            ssq += (a * a + b * b) + (cc * cc + d * d);
            *(u32x2*)(orow + 32 * d0 + 8 * c + 4 * hi) = (u32x2){cvtpk(a * bf_lo(z.x), b * bf_hi(z.x)), cvtpk(cc * bf_lo(z.y), d * bf_hi(z.y))};
        }
    ssq = swap32_sum(ssq);
    if (hi == 0) OSS[grow * 16 + ohead] = ssq;
}

__device__ __forceinline__ void mla_prime(int b, int h, int qb, const bf16_t* QB, const bf16_t* KNC, const bf16_t* VBC, const bf16_t* KRC, LAS unsigned char* lds, const int wid, bf16x8 (&qf)[2][6]) {
    const int lane = lane_id(), r32 = lane & 31, hi = lane >> 5;
    const size_t rowbase = (size_t)b * S; const int q0 = qb * 512, ra0 = q0 + 32 * wid, rb0 = q0 + 32 * (15 - wid);
    const size_t hb = ((size_t)(b * 8 + h) * S) * 64;
#pragma unroll
    for (int c = 0; c < 2; ++c) { const bf16_t* qrow = QB + (rowbase + (c ? rb0 : ra0) + r32) * NQB;
#pragma unroll
      for (int d0 = 0; d0 < 4; ++d0) qf[c][d0] = *(const bf16x8*)(qrow + h * 64 + d0 * 16 + hi * 8);
#pragma unroll
      for (int d0 = 4; d0 < 6; ++d0) qf[c][d0] = *(const bf16x8*)(qrow + 512 + h * 32 + (d0 - 4) * 16 + hi * 8); }
    attn_prime<0>(KNC + hb + wid * 512, KRC + rowbase * 32 + (wid & 3) * 512, VBC + hb + wid * 512, nullptr, nullptr, lds, wid);
}
__device__ __forceinline__ void mla_unit(int b, int h, int qb, int qb_next, bf16x8 (&qf)[2][6], const bf16_t* QB, const bf16_t* PROJ, const bf16_t* KNC, const bf16_t* VBC, const bf16_t* KRC, bf16_t* OAB, float* OSS, LAS unsigned char* lds, const int wid) {
    const int lane = lane_id();
    const size_t rowbase = (size_t)b * S; const int q0 = qb * 512, ra0 = q0 + 32 * wid, rb0 = q0 + 32 * (15 - wid);
    const size_t hb = ((size_t)(b * 8 + h) * S) * 64;
    f32x16 oT[2][2]; float l[2];
    attn_core<0>(qf, 8 * (qb + 1), (ra0 + 31) >> 6, ra0, (rb0 + 31) >> 6, rb0, KNC + hb + wid * 512, KRC + rowbase * 32 + (wid & 3) * 512, VBC + hb + wid * 512,
                 nullptr, nullptr, 0.f, 0.f, 0.f, 0, lds, wid, lane, oT, l);
    if (qb_next >= 0) mla_prime(b, h, qb_next, QB, KNC, VBC, KRC, lds, wid, qf);
    attn_store(oT[0], l[0], OAB, OSS, PROJ, rowbase + ra0, 512 + h * 64, 8 + h);
    attn_store(oT[1], l[1], OAB, OSS, PROJ, rowbase + rb0, 512 + h * 64, 8 + h);
}
__device__ __forceinline__ void dsa_prime(int b, int g, int qb, const bf16_t* PROJ, const bf16_t* KAC, const bf16_t* VAC, const unsigned long long* MASKT, const float* POSF, LAS unsigned char* lds, const int wid,
                                          bf16x8 (&qf)[2][6], float& pta) {
    const int lane = lane_id(), r32 = lane & 31, hi = lane >> 5;
    const size_t rowbase = (size_t)b * S; const int q0 = qb * 128, qblk = wid >> 1, head0 = 4 * g + 2 * (wid & 1), tqa = q0 + 32 * qblk + r32;
    const size_t gb = ((size_t)(b * 2 + g) * S) * 64;
#pragma unroll
    for (int c = 0; c < 2; ++c) { const bf16_t* qrow = PROJ + proj_off(rowbase + tqa, C_QA + (head0 + c) * 64 + hi * 8);
#pragma unroll
      for (int d0 = 0; d0 < 4; ++d0) qf[c][d0] = *(const bf16x8*)(qrow + d0 * 256);
      qf[c][4] = qf[c][0]; qf[c][5] = qf[c][0]; }
    pta = POSF[rowbase + tqa];
    attn_prime<1>(KAC + gb + wid * 512, nullptr, VAC + gb + wid * 512, MASKT + ((size_t)(b * 64 + 2 * qb) * 64) * 64, POSF + rowbase, lds, wid);
}
__device__ __forceinline__ void dsa_unit(int b, int g, int qb, int qb_next, bf16x8 (&qf)[2][6], float& pta_io, const bf16_t* PROJ, const bf16_t* KAC, const bf16_t* VAC, const unsigned long long* MASKT, const float* POSF,
                                         bf16_t* OAB, float* OSS, LAS unsigned char* lds, const int wid) {
    const int lane = lane_id();
    const size_t rowbase = (size_t)b * S; const int q0 = qb * 128, qblk = wid >> 1, head0 = 4 * g + 2 * (wid & 1);
    const size_t gb = ((size_t)(b * 2 + g) * S) * 64;
    const float pta = pta_io;
    const float nsa = -__builtin_amdgcn_exp2f(-(float)(head0 + 1)) * LOG2E, nsb = 0.5f * nsa;
    f32x16 oT[2][2]; float l[2];
    attn_core<1>(qf, 2 * (qb + 1), (q0 + 32 * qblk + 31) >> 6, q0 + 32 * qblk, (q0 + 32 * qblk + 31) >> 6, q0 + 32 * qblk, KAC + gb + wid * 512, nullptr, VAC + gb + wid * 512,
                 MASKT + ((size_t)(b * 64 + 2 * qb) * 64) * 64, POSF + rowbase, pta, nsa, nsb, 32 * qblk, lds, wid, lane, oT, l);
    if (qb_next >= 0) dsa_prime(b, g, qb_next, PROJ, KAC, VAC, MASKT, POSF, lds, wid, qf, pta_io);
    attn_store(oT[0], l[0], OAB, OSS, PROJ, rowbase + q0 + 32 * qblk, head0 * 64, head0);
    attn_store(oT[1], l[1], OAB, OSS, PROJ, rowbase + q0 + 32 * qblk, (head0 + 1) * 64, head0 + 1);
}

__device__ __forceinline__ int wave_sum_i(int x) {
    x += __builtin_amdgcn_update_dpp(0, x, 0xB1, 0xf, 0xf, true);
    x += __builtin_amdgcn_update_dpp(0, x, 0x4E, 0xf, 0xf, true);
    x += __builtin_amdgcn_update_dpp(0, x, 0x141, 0xf, 0xf, true);
    x += __builtin_amdgcn_update_dpp(0, x, 0x140, 0xf, 0xf, true);
    { auto r = __builtin_amdgcn_permlane16_swap((unsigned)x, (unsigned)x, false, false); x = (int)(r[0] + r[1]); }
    { auto r = __builtin_amdgcn_permlane32_swap((unsigned)x, (unsigned)x, false, false); x = (int)(r[0] + r[1]); }
    return __builtin_amdgcn_readfirstlane(x);
}
__device__ __forceinline__ float wave_max_f(float x) {
    x = fmaxf(x, __uint_as_float(__builtin_amdgcn_update_dpp(0, __float_as_uint(x), 0xB1, 0xf, 0xf, true)));
    x = fmaxf(x, __uint_as_float(__builtin_amdgcn_update_dpp(0, __float_as_uint(x), 0x4E, 0xf, 0xf, true)));
    x = fmaxf(x, __uint_as_float(__builtin_amdgcn_update_dpp(0, __float_as_uint(x), 0x141, 0xf, 0xf, true)));
    x = fmaxf(x, __uint_as_float(__builtin_amdgcn_update_dpp(0, __float_as_uint(x), 0x140, 0xf, 0xf, true)));
    { auto r = __builtin_amdgcn_permlane16_swap(__float_as_uint(x), __float_as_uint(x), false, false); x = fmaxf(__uint_as_float(r[0]), __uint_as_float(r[1])); }
    { auto r = __builtin_amdgcn_permlane32_swap(__float_as_uint(x), __float_as_uint(x), false, false); x = fmaxf(__uint_as_float(r[0]), __uint_as_float(r[1])); }
    return __uint_as_float(__builtin_amdgcn_readfirstlane(__float_as_uint(x)));
}
typedef short s16x2_t __attribute__((ext_vector_type(2)));
#define SEL_P4(k0, k1, k2, k3) \
    "v_pk_sub_u16 %2, %" #k0 ", %14 clamp\n\tv_pk_sub_u16 %3, %" #k1 ", %14 clamp\n\tv_pk_sub_u16 %4, %" #k2 ", %14 clamp\n\tv_pk_sub_u16 %5, %" #k3 ", %14 clamp\n\t" \
    "v_pk_min_u16 %2, %2, %15\n\tv_pk_min_u16 %3, %3, %15\n\tv_pk_min_u16 %4, %4, %15\n\tv_pk_min_u16 %5, %5, %15\n\t" \
    "v_pk_add_u16 %0, %0, %2\n\tv_pk_add_u16 %1, %1, %3\n\tv_pk_add_u16 %0, %0, %4\n\tv_pk_add_u16 %1, %1, %5\n\t"
#define SEL_P8_ASM(a0, a1, K, base, t1, one2) do { unsigned q0_, q1_, q2_, q3_; asm volatile( \
    SEL_P4(6, 7, 8, 9) SEL_P4(10, 11, 12, 13) \
    : "+v"(a0), "+v"(a1), "=&v"(q0_), "=&v"(q1_), "=&v"(q2_), "=&v"(q3_) \
    : "v"(K[(base) + 0]), "v"(K[(base) + 1]), "v"(K[(base) + 2]), "v"(K[(base) + 3]), "v"(K[(base) + 4]), "v"(K[(base) + 5]), "v"(K[(base) + 6]), "v"(K[(base) + 7]), "s"(t1), "s"(one2)); } while (0)
__device__ __forceinline__ int wave_sum_pk(unsigned x) {
    x += (unsigned)__builtin_amdgcn_update_dpp(0, (int)x, 0xB1, 0xf, 0xf, true);
    x += (unsigned)__builtin_amdgcn_update_dpp(0, (int)x, 0x4E, 0xf, 0xf, true);
    x += (unsigned)__builtin_amdgcn_update_dpp(0, (int)x, 0x141, 0xf, 0xf, true);
    x += (unsigned)__builtin_amdgcn_update_dpp(0, (int)x, 0x140, 0xf, 0xf, true);
    x += (unsigned)__builtin_amdgcn_update_dpp(0, (int)x, 0x142, 0xa, 0xf, false);
    x += (unsigned)__builtin_amdgcn_update_dpp(0, (int)x, 0x143, 0xc, 0xf, false);
    const unsigned r = (unsigned)__builtin_amdgcn_readlane((int)x, 63);
    return (int)((r & 0xffffu) + (r >> 16));
}
__device__ __forceinline__ unsigned pk_min_u16(unsigned a, unsigned b) { unsigned d; asm("v_pk_min_u16 %0, %1, %2" : "=v"(d) : "v"(a), "v"(b)); return d; }
__device__ __forceinline__ unsigned wave_min_u(unsigned x) {
    { const unsigned y = (unsigned)__builtin_amdgcn_update_dpp(0, (int)x, 0xB1, 0xf, 0xf, true); x = x < y ? x : y; }
    { const unsigned y = (unsigned)__builtin_amdgcn_update_dpp(0, (int)x, 0x4E, 0xf, 0xf, true); x = x < y ? x : y; }
    { const unsigned y = (unsigned)__builtin_amdgcn_update_dpp(0, (int)x, 0x141, 0xf, 0xf, true); x = x < y ? x : y; }
    { const unsigned y = (unsigned)__builtin_amdgcn_update_dpp(0, (int)x, 0x140, 0xf, 0xf, true); x = x < y ? x : y; }
    { auto r = __builtin_amdgcn_permlane16_swap(x, x, false, false); x = r[0] < r[1] ? r[0] : r[1]; }
    { auto r = __builtin_amdgcn_permlane32_swap(x, x, false, false); x = r[0] < r[1] ? r[0] : r[1]; }
    return (unsigned)__builtin_amdgcn_readfirstlane((int)x);
}
__device__ __forceinline__ unsigned long long select_row(int t, const LAS unsigned* sc, int lane) {
    const int n = t + 1;
    if (n <= KTOP) {
        const int cnt = n - 64 * lane;
        return cnt >= 64 ? ~0ull : (cnt <= 0 ? 0ull : ((1ull << cnt) - 1ull));
    }
    const int nw = (n + 127) >> 7;
    unsigned kv[32];
#define SEL_LD8(base) _Pragma("unroll") for (int j = (base); j < (base) + 8; ++j) { const unsigned h_ = sc[64 * j + lane]; \
        const unsigned m_ = __builtin_bit_cast(unsigned, __builtin_bit_cast(s16x2_t, h_) >> 15) | 0x80008000u; kv[j] = h_ ^ m_; }
#define SEL_Z8(base) _Pragma("unroll") for (int j = (base); j < (base) + 8; ++j) kv[j] = 0u;
    SEL_LD8(0)
    if (nw > 8) { SEL_LD8(8) } else { SEL_Z8(8) }
    if (nw > 16) { SEL_LD8(16) } else { SEL_Z8(16) }
    if (nw > 24) { SEL_LD8(24) } else { SEL_Z8(24) }
#undef SEL_LD8
#undef SEL_Z8
    const int nl = n - lane;
#define SEL_MK8(base) _Pragma("unroll") for (int j = (base); j < (base) + 8; ++j) { const unsigned ml_ = (128 * j < nl) ? 0xffffu : 0u, mh_ = (128 * j + 64 < nl) ? 0xffff0000u : 0u; kv[j] &= (ml_ | mh_); }
    if (nw > 8) { if (nw > 16) { if (nw > 24) { SEL_MK8(24) } else { SEL_MK8(16) } } else { SEL_MK8(8) } } else { SEL_MK8(0) }
#undef SEL_MK8
    const unsigned one2 = 0x00010001u;
#define SEL_COUNT(T) do { unsigned a0_ = 0, a1_ = 0; const unsigned t1_ = (unsigned)((T) - 1) * 0x10001u; SEL_P8_ASM(a0_, a1_, kv, 0, t1_, one2); \
        if (nw > 8) { SEL_P8_ASM(a0_, a1_, kv, 8, t1_, one2); } if (nw > 16) { SEL_P8_ASM(a0_, a1_, kv, 16, t1_, one2); } if (nw > 24) { SEL_P8_ASM(a0_, a1_, kv, 24, t1_, one2); } \
        c = wave_sum_pk(a0_ + a1_); } while (0)
    int c, lo = 0x0400, hi = 0xFC00, chi = 0, theta = 0; bool exact = false;
#pragma unroll 1
    while (hi - lo > 1) {
        const int mid = (lo + hi) >> 1;
        SEL_COUNT(mid);
        if (c == KTOP) { exact = true; theta = mid; break; }
        if (c > KTOP) lo = mid; else { hi = mid; chi = c; }
    }
#undef SEL_COUNT
    unsigned long long myw = 0ull;
    {   const unsigned th = exact ? (unsigned)theta : (unsigned)lo + 1u, thh = th << 16;
#define SEL_OUT8(base) _Pragma("unroll") for (int j = (base); j < (base) + 8; ++j) { const unsigned long long m0_ = __ballot((kv[j] & 0xffffu) >= th); if (lane == 2 * j) myw = m0_; \
            const unsigned long long m1_ = __ballot(kv[j] >= thh); if (lane == 2 * j + 1) myw = m1_; }
        SEL_OUT8(0) if (nw > 8) { SEL_OUT8(8) } if (nw > 16) { SEL_OUT8(16) } if (nw > 24) { SEL_OUT8(24) }
#undef SEL_OUT8
    }
    if (!exact) {
        const unsigned tt = (unsigned)lo * 0x10001u, one2v = 0x00010001u;
        unsigned bml = 0u, bmh = 0u;
#define SEL_EQ8(base) _Pragma("unroll") for (int j = (base); j < (base) + 8; ++j) { const unsigned e_ = pk_min_u16(kv[j] ^ tt, one2v) ^ one2v;        \
            const unsigned t2_ = (e_ >> 15) | (e_ & 1u); if (j < 16) bml |= t2_ << (2 * (j & 15)); else bmh |= t2_ << (2 * (j & 15)); }
        SEL_EQ8(0) if (nw > 8) { SEL_EQ8(8) } if (nw > 16) { SEL_EQ8(16) } if (nw > 24) { SEL_EQ8(24) }
#undef SEL_EQ8
        const int need = KTOP - chi;
#pragma unroll 1
        for (int r = 0; r < need; ++r) {
            const unsigned cl = (unsigned)__builtin_ctz(bml | 0x80000000u), ch = 32u + (unsigned)__builtin_ctz(bmh | 0x80000000u);
            const unsigned cand = bml ? cl : (bmh ? ch : 0xffffu);
            const unsigned m = wave_min_u(cand * 64u + (unsigned)lane);
            const unsigned cs = m >> 6, ls = m & 63u;
            if ((unsigned)lane == ls) { if (cs < 32u) bml &= ~(1u << cs); else bmh &= ~(1u << (cs - 32u)); }
            if ((unsigned)lane == cs) myw |= 1ull << ls;
        }
    }
    return myw;
}

#define IDX_BAR() asm volatile("s_waitcnt lgkmcnt(0)\n\ts_barrier" ::: "memory")
#define IDX_BARV() asm volatile("s_waitcnt vmcnt(0) lgkmcnt(0)\n\ts_barrier" ::: "memory")
constexpr int IDX_QST = 131072;
__device__ __forceinline__ float fma_mix_lo(unsigned w2, float r, float s) { asm("v_fma_mix_f32 %0, %1, %2, %0 op_sel:[0,0,0] op_sel_hi:[1,0,0]" : "+v"(s) : "v"(w2), "v"(r)); return s; }
__device__ __forceinline__ float fma_mix_hi(unsigned w2, float r, float s) { asm("v_fma_mix_f32 %0, %1, %2, %0 op_sel:[1,0,0] op_sel_hi:[1,0,0]" : "+v"(s) : "v"(w2), "v"(r)); return s; }
__device__ __forceinline__ unsigned bf2_to_h2(unsigned u) { return __builtin_bit_cast(unsigned, __builtin_amdgcn_cvt_pkrtz(bf_lo(u), bf_hi(u))); }
__device__ __forceinline__ void idx_phase(int b, int sdeal, const bf16_t* PROJ, const bf16_t* IKC, unsigned long long* MASK, LAS unsigned char* lds, const int wid) {
    const int lane = lane_id(), r32 = lane & 31, hi = lane >> 5;
    const size_t rowbase = (size_t)b * S;
    LAS _Float16* SC = (LAS _Float16*)lds;
    const int qi = 2 * ((r32 >> 2) & 1) + (r32 >> 4), hd = (r32 & 3) + 4 * ((r32 >> 3) & 1);
    const int qcol = C_IQ + hd * 64 + hi * 8;
    const bf16_t* kbase = IKC + (rowbase + wid * 32) * 64 + hi * 256 + r32 * 8;
    const int scl = ((wid >> 2) * 64 + (wid & 1) * 32 + r32) * 2 + ((wid >> 1) & 1);
    bf16x8 af[4][4]; u32x4 wv[4][2]; bf16x8 f0[4], f1[4], f2[4];
#define IDX_J(u) (16 * (u) + (((u) & 1) ? 15 - sdeal : sdeal))
#define IDX_CNT(t0) ((((t0) + 16 + 31) >> 5) - wid + 7) >> 3
#define IDX_LOAD(dst, i, cnt) do { const int _i = ((i) < (cnt)) ? (i) : ((cnt) - 1); const bf16_t* _p = kbase + (size_t)_i * (256 * 64); \
        _Pragma("unroll") for (int d0 = 0; d0 < 4; ++d0) dst[d0] = *(const bf16x8*)(_p + d0 * 512); } while (0)
#define IDX_PREFETCH(t0) do { if ((t0) + 16 > KTOP) { const int _c = IDX_CNT(t0); const unsigned _l = (unsigned)lane_id_nohoist(); \
        _Pragma("unroll") for (int pp = 0; pp < 2; ++pp) { const int pi_ = 2 * wid + pp, mt_ = pi_ >> 2, d0_ = pi_ & 3; \
            const int r32_ = _l & 31, hi_ = _l >> 5, qi_ = 2 * ((r32_ >> 2) & 1) + (r32_ >> 4), hd_ = (r32_ & 3) + 4 * ((r32_ >> 3) & 1); \
            dma16(PROJ, (unsigned)((proj_off(rowbase + (t0) + 4 * mt_ + qi_, C_IQ + hd_ * 64 + hi_ * 8) + (size_t)d0_ * 256) * 2), (unsigned)__builtin_amdgcn_readfirstlane((int)(qst0 + pi_ * 1024))); } \
        if (wid == 7) dma4(PROJ, (unsigned)(proj_off(rowbase + (t0) + (_l >> 2), C_IW) * 2 + (_l & 3u) * 4u), (unsigned)__builtin_amdgcn_readfirstlane((int)(qst0 + 16384))); \
        IDX_LOAD(f0, 0, _c); IDX_LOAD(f1, 1, _c); } } while (0)
#define IDX_FETCHQ() do { \
        _Pragma("unroll") for (int mt = 0; mt < 4; ++mt) { \
            _Pragma("unroll") for (int d0 = 0; d0 < 4; ++d0) af[mt][d0] = *(const LAS bf16x8*)(lds + IDX_QST + (mt * 4 + d0) * 1024 + lane * 16); \
            _Pragma("unroll") for (int e = 0; e < 2; ++e) wv[mt][e] = *(const LAS u32x4*)(lds + IDX_QST + 16384 + (4 * mt + 2 * hi + e) * 16); } } while (0)
#define IDX_S8(acc, e, mt) do { float s = 0.f; \
        s = fma_mix_lo(wh[mt][e][0], relu_f(acc[8 * (e) + 0]), s); s = fma_mix_hi(wh[mt][e][0], relu_f(acc[8 * (e) + 1]), s); \
        s = fma_mix_lo(wh[mt][e][1], relu_f(acc[8 * (e) + 2]), s); s = fma_mix_hi(wh[mt][e][1], relu_f(acc[8 * (e) + 3]), s); \
        s = fma_mix_lo(wh[mt][e][2], relu_f(acc[8 * (e) + 4]), s); s = fma_mix_hi(wh[mt][e][2], relu_f(acc[8 * (e) + 5]), s); \
        s = fma_mix_lo(wh[mt][e][3], relu_f(acc[8 * (e) + 6]), s); s = fma_mix_hi(wh[mt][e][3], relu_f(acc[8 * (e) + 7]), s); \
        SC[(4 * (mt) + 2 * hi + (e)) * 4096 + 256 * (i_) + scl] = (_Float16)s; } while (0)
#define IDX_COMP(src, i) do { const int i_ = (i); _Pragma("unroll") for (int mp = 0; mp < 2; ++mp) { f32x16 a0 = f32x16{}, a1 = f32x16{}; \
        _Pragma("unroll") for (int d0 = 0; d0 < 4; ++d0) { a0 = __builtin_amdgcn_mfma_f32_32x32x16_bf16(af[2 * mp][d0], src[d0], a0, 0, 0, 0); a1 = __builtin_amdgcn_mfma_f32_32x32x16_bf16(af[2 * mp + 1][d0], src[d0], a1, 0, 0, 0); } \
        IDX_S8(a0, 0, 2 * mp); IDX_S8(a0, 1, 2 * mp); IDX_S8(a1, 0, 2 * mp + 1); IDX_S8(a1, 1, 2 * mp + 1); } } while (0)
    const unsigned qst0 = (unsigned)(uintptr_t)lds + IDX_QST;
    { const int t0 = 16 * IDX_J(0); IDX_PREFETCH(t0); }
    IDX_BARV();
    for (int u = 0; u < 16; ++u) {
        const int t0 = 16 * IDX_J(u);
        if (t0 + 16 > KTOP) {
            IDX_FETCHQ();
            unsigned wh[4][2][4];
#pragma unroll
            for (int mt = 0; mt < 4; ++mt)
#pragma unroll
                for (int e = 0; e < 2; ++e) { wh[mt][e][0] = bf2_to_h2(wv[mt][e].x); wh[mt][e][1] = bf2_to_h2(wv[mt][e].y); wh[mt][e][2] = bf2_to_h2(wv[mt][e].z); wh[mt][e][3] = bf2_to_h2(wv[mt][e].w); }
            const int cnt = IDX_CNT(t0);
            for (int i = 0; i < cnt; i += 3) {
                IDX_LOAD(f2, i + 2, cnt); IDX_COMP(f0, i);
                if (i + 1 < cnt) { IDX_LOAD(f0, i + 3, cnt); IDX_COMP(f1, i + 1); }
                if (i + 2 < cnt) { IDX_LOAD(f1, i + 4, cnt); IDX_COMP(f2, i + 2); }
            }
        }
        IDX_BAR();
        if (u + 1 < 16) { const int t1 = 16 * IDX_J(u + 1); IDX_PREFETCH(t1); }
        unsigned long long mw0 = 0ull, mw1 = 0ull;
#pragma unroll 1
        for (int rr = 0; rr < 2; ++rr) { const int q = 8 * rr + wid;
            const unsigned long long w_ = select_row(t0 + q, (const LAS unsigned*)(SC + q * 4096), lane); if (rr == 0) mw0 = w_; else mw1 = w_; }
        { const int ta = t0 + wid, tb = t0 + 8 + wid;
          MASK[((size_t)(b * 64 + (ta >> 6)) * 64) * 64 + (ta & 63) + (size_t)lane * 64] = mw0;
          MASK[((size_t)(b * 64 + (tb >> 6)) * 64) * 64 + (tb & 63) + (size_t)lane * 64] = mw1; }
        IDX_BARV();
    }
#undef IDX_J
#undef IDX_CNT
#undef IDX_LOAD
#undef IDX_PREFETCH
#undef IDX_FETCHQ
#undef IDX_S8
#undef IDX_COMP
}

__device__ __forceinline__ void grid_bar(unsigned* ctr, unsigned target, int wave) {
    asm volatile("s_waitcnt vmcnt(0) lgkmcnt(0)" ::: "memory");
    __syncthreads();
    if (wave == 0 && lane_id() == 0) {
        __builtin_amdgcn_fence(__ATOMIC_RELEASE, "agent");
        asm volatile("s_waitcnt vmcnt(0)" ::: "memory");
        __hip_atomic_fetch_add(ctr, 1u, __ATOMIC_RELAXED, __HIP_MEMORY_SCOPE_AGENT);
        unsigned spins = 0;
        while (__hip_atomic_load(ctr, __ATOMIC_RELAXED, __HIP_MEMORY_SCOPE_AGENT) < target) { __builtin_amdgcn_s_sleep(2); if (++spins > (1u << 26)) break; }
        __builtin_amdgcn_fence(__ATOMIC_ACQUIRE, "agent");
        asm volatile("s_waitcnt vmcnt(0)" ::: "memory");
    }
    __syncthreads();
}

struct Args { const float* x; const int* pos; const float* w_in; const float* g_q; const float* w_uq; const float* g_kv; const float* w_ukv; const float* g_oa; const float* g_ob;
              const float* w_out; const float* ln_g; const float* ln_b; float* out; unsigned char* ws; int ph_lo, ph_hi; };

__device__ __forceinline__ void src_map(int kind, int n, int& src, float& sc) {
    sc = 1.f;
    if (kind == 0) {
        if (n < 512) { src = n; sc = QA_SCALE; }
        else if (n < 1280) src = n;
        else if (n < 1664) src = n - 1280 + 1352;
        else if (n < 1920) src = n - 1664 + 1736;
        else if (n < 1984) src = n - 1920 + 1280;
        else if (n < 2016) { const int e = n - 1984; src = 1992 + (e >> 1) + 16 * (e & 1); }
        else if (n < 2024) { src = n - 2016 + 1344; sc = IW_SCALE; }
        else if (n < 2048) src = -1;
        else src = n - 2048 + 2024;
    } else if (kind == 1) {
        if (n < 512) { const int h = n >> 6, d = n & 63; src = h * 96 + d; }
        else { const int e = n - 512, h = e >> 5, r = e & 31; src = h * 96 + 64 + (r >> 1) + 16 * (r & 1); }
        sc = QB_SCALE;
    } else if (kind == 2) {
        if (n < 512) { const int h = n >> 6, d = n & 63; src = h * 128 + d; }
        else { const int e = n - 512, h = e >> 6, d = e & 63; src = h * 128 + 64 + d; }
    } else src = n;
}
__device__ __forceinline__ void p0_transpose_item(const float* W, int K, int Nsrc, int Ndst, bf16_t* WT, int kind, const float* ks0, const float* ks1, LAS float* scr, int item, int lane) {
    const int nblk = Ndst / 32, kb = item / nblk, nb = item % nblk, k0 = 64 * kb, n0 = 32 * nb;
    int src; float sc; src_map(kind, n0 + (lane & 31), src, sc);
    const int srcc = src >= 0 ? src : 0; const float scm = src >= 0 ? sc : 0.f;
    const float* ksb = ks0 ? ((k0 < 512 || !ks1) ? ks0 + k0 : ks1 + (k0 - 512)) : nullptr;
    float wv_[32], kv_[32];
    const float* wp_ = W + (size_t)(k0 + (lane >> 5)) * Nsrc + srcc;
#pragma unroll
    for (int i = 0; i < 32; ++i) wv_[i] = wp_[(size_t)(2 * i) * Nsrc];
    if (ksb) {
#pragma unroll
        for (int i = 0; i < 32; ++i) kv_[i] = ksb[2 * i + (lane >> 5)];
    } else {
#pragma unroll
        for (int i = 0; i < 32; ++i) kv_[i] = 1.f;
    }
#pragma unroll
    for (int i = 0; i < 32; ++i) scr[(2 * i + (lane >> 5)) * 33 + (lane & 31)] = wv_[i] * (scm * kv_[i]);
    asm volatile("s_waitcnt lgkmcnt(0)" ::: "memory");
    const int c = lane & 7;
#pragma unroll
    for (int jj = 0; jj < 4; ++jj) { const int n = (lane >> 3) + 8 * jj; const LAS float* s = scr + (8 * c) * 33 + n;
        u32x4 o; o.x = cvt_pk_bf16(s[0 * 33], s[1 * 33]); o.y = cvt_pk_bf16(s[2 * 33], s[3 * 33]); o.z = cvt_pk_bf16(s[4 * 33], s[5 * 33]); o.w = cvt_pk_bf16(s[6 * 33], s[7 * 33]);
        *(u32x4*)(WT + (size_t)(n0 + n) * K + k0 + 8 * c) = o; }
    asm volatile("s_waitcnt lgkmcnt(0)" ::: "memory");
}
__device__ __forceinline__ float wave_sum(float v) {
#pragma unroll
    for (int o = 1; o < 64; o <<= 1) v += __shfl_xor(v, o);
    return v;
}

__global__ void __launch_bounds__(512, 2) hybrid_fwd(Args a) {
    extern __shared__ __attribute__((aligned(16))) unsigned char lds_raw[];
    LAS unsigned char* lds = (LAS unsigned char*)lds_raw;
    const int wave = __builtin_amdgcn_readfirstlane(threadIdx.x >> 6);
#define lane lane_id()
#define tid (wave * 64 + lane_id())
    const int G = gridDim.x, bx = blockIdx.x, vcu = (G % 8 == 0) ? (bx % 8) * (G / 8) + bx / 8 : bx;
    unsigned char* ws = a.ws;
    bf16_t* W1T = (bf16_t*)(ws + WS_W1T); bf16_t* WUQT = (bf16_t*)(ws + WS_WUQT); bf16_t* WUKVT = (bf16_t*)(ws + WS_WUKVT); bf16_t* WOT = (bf16_t*)(ws + WS_WOT);
    float* CS = (float*)(ws + WS_CS); float* SSQ = (float*)(ws + WS_SSQ); float* POSF = (float*)(ws + WS_POSF); float* OSS = (float*)(ws + WS_OSS); float* STATS = (float*)(ws + WS_STATS);
    bf16_t* XB = (bf16_t*)(ws + WS_XB); bf16_t* PROJ = (bf16_t*)(ws + WS_PROJ); bf16_t* QB = (bf16_t*)(ws + WS_QB); bf16_t* KVB = (bf16_t*)(ws + WS_KVB);
    bf16_t* IKC = (bf16_t*)(ws + WS_IKC); bf16_t* KRC = (bf16_t*)(ws + WS_KRC); bf16_t* KAC = (bf16_t*)(ws + WS_KAC); bf16_t* VAC = (bf16_t*)(ws + WS_VAC);
    bf16_t* CQC = (bf16_t*)(ws + WS_CQC); bf16_t* CKVC = (bf16_t*)(ws + WS_CKVC); bf16_t* KNC = (bf16_t*)(ws + WS_KNC); bf16_t* VBC = (bf16_t*)(ws + WS_VBC);
    unsigned long long* MASK = (unsigned long long*)(ws + WS_MASK); bf16_t* OAB = (bf16_t*)(ws + WS_OAB); bf16_t* Y = (bf16_t*)(ws + WS_Y);
    const int lo = a.ph_lo, hi_ph = a.ph_hi;
#define IN(k) (lo <= (k) && (k) < hi_ph)
#define SEAM(k) do { if (IN(k) && IN((k) + 1)) { if ((k) == 0) cg::this_grid().sync(); else { ++nbar; grid_bar((unsigned*)ws, nbar * (unsigned)G, wave); } } } while (0)
    unsigned nbar = 0;
#define NOSEAM(k) do { if (IN(k) && IN((k) + 1)) { __syncthreads(); } } while (0)
    const int gw = vcu * 8 + wave, NGW = G * 8;
#define gt ((size_t)vcu * 512 + tid)
    const size_t NGT = (size_t)G * 512;

    if (IN(0)) {
        LAS float* scr = (LAS float*)(lds + wave * 16384);
        constexpr int I1 = (1024 / 64) * (NPROJ / 32), I2 = (384 / 64) * (NQB / 32), I3 = (256 / 64) * (NKVB / 32), I4 = (1024 / 64) * (1024 / 32);
        for (int it = gw; it < I1 + I2 + I3 + I4; it += NGW) {
            int r = it;
            if (r < I1) { p0_transpose_item(a.w_in, 1024, D_IN, NPROJ, W1T, 0, nullptr, nullptr, scr, r, lane); continue; } r -= I1;
            if (r < I2) { p0_transpose_item(a.w_uq, 384, NQB, NQB, WUQT, 1, a.g_q, nullptr, scr, r, lane); continue; } r -= I2;
            if (r < I3) { p0_transpose_item(a.w_ukv, 256, NKVB, NKVB, WUKVT, 2, a.g_kv, nullptr, scr, r, lane); continue; } r -= I3;
            p0_transpose_item(a.w_out, 1024, 1024, 1024, WOT, 3, a.g_oa, a.g_ob, scr, r, lane);
        }
        for (size_t c = gt; c < (size_t)M * 256; c += 8 * NGT) {
            f32x4 v[8];
#pragma unroll
            for (int k = 0; k < 8; ++k) v[k] = __builtin_nontemporal_load((const f32x4*)(a.x + (c + k * NGT) * 4));
#pragma unroll
            for (int k = 0; k < 8; ++k) *(u32x2*)(XB + (c + k * NGT) * 4) = (u32x2){cvt_pk_bf16(v[k][0], v[k][1]), cvt_pk_bf16(v[k][2], v[k][3])};
        }
        int pq[8];
#pragma unroll
        for (int j = 0; j < 8; ++j) { const size_t i_ = gt + (size_t)j * NGT; pq[j] = (i_ < (size_t)M * 16) ? a.pos[i_ >> 4] : 0; }
#pragma unroll
        for (int j = 0; j < 8; ++j) { const size_t i = gt + (size_t)j * NGT; if (i >= (size_t)M * 16) continue;
            const size_t t = i >> 4; const int k = (int)(i & 15);
            const float p = (float)pq[j];
            const float invf = exp2f(-(float)k * 0.8304820237218406f);
            const float ang = p * invf;
            const double ad = (double)ang;
            const double kk = rint(ad * 0.15915494309189535);
            const double r = fma(-kk, 6.283185307179586, ad) - kk * 2.4492935982947064e-16;
            const double r2 = r * r;
            double sn = -8.2206352466243297e-18; sn = fma(sn, r2, 2.8114572543455206e-15); sn = fma(sn, r2, -7.6471637318198165e-13); sn = fma(sn, r2, 1.6059043836821613e-10);
            sn = fma(sn, r2, -2.5052108385441720e-08); sn = fma(sn, r2, 2.7557319223985893e-06); sn = fma(sn, r2, -1.9841269841269841e-04); sn = fma(sn, r2, 8.3333333333333332e-03);
            sn = fma(sn, r2, -1.6666666666666666e-01); sn = fma(sn * r2, r, r);
            double cn = 4.1103176233121648e-19; cn = fma(cn, r2, -1.5619206968586226e-16); cn = fma(cn, r2, 4.7794773323873853e-14); cn = fma(cn, r2, -1.1470745597729725e-11);
            cn = fma(cn, r2, 2.0876756987868099e-09); cn = fma(cn, r2, -2.7557319223985888e-07); cn = fma(cn, r2, 2.4801587301587302e-05); cn = fma(cn, r2, -1.3888888888888889e-03);
            cn = fma(cn, r2, 4.1666666666666664e-02); cn = fma(cn, r2, -0.5); cn = fma(cn, r2, 1.0);
            CS[t * 32 + k] = (float)cn; CS[t * 32 + 16 + k] = (float)sn;
            if (k == 0) POSF[t] = p;
        }
    }
    SEAM(0);
    if (IN(1)) {
        pg8::Gemm g{XB, W1T, M, NPROJ, 1024, 1024}; pg8::StaticOrder So; So.init(M, NPROJ, G, bx);
        EpiProj E{PROJ, CS, SSQ, IKC, KRC, KAC, VAC, CQC, CKVC};
        pg8::gemm_phase<EpiProj>(lds, g, So, E, wave);
    }
    SEAM(1);
    if (IN(2)) {
        { pg8::Gemm g{CQC, WUQT, M, NQB, 384, 384}; pg8::StaticOrder So; So.init(M, NQB, G, bx);
          EpiUp E{QB, NQB, SSQ, 0, 3, 1.0f / 384.0f, CS, 2, nullptr, nullptr};
          pg8::gemm_phase<EpiUp>(lds, g, So, E, wave); }
        { pg8::Gemm g{CKVC, WUKVT, M, NKVB, 256, 256}; pg8::StaticOrder So; So.init(M, NKVB, G, bx);
          EpiUp E{KVB, NKVB, SSQ, 12, 2, 1.0f / 256.0f, CS, -1, KNC, VBC};
          pg8::gemm_phase<EpiUp>(lds, g, So, E, wave); }
    }
    NOSEAM(2);
    if (IN(3)) {
        idx_phase(vcu >> 4, vcu & 15, PROJ, IKC, MASK, lds, wave);
    }
    SEAM(3);
    if (IN(4)) {
        const int bh = vcu >> 1, s = vcu & 1, b = bh >> 3, h = bh & 7;
        bf16x8 qf[2][6];
        mla_prime(b, h, 7 - s, QB, KNC, VBC, KRC, lds, wave, qf);
#pragma unroll
        for (int j = 0; j < 4; ++j) {
            const int qa = 2 * (j >> 1) + s, qb = (j & 1) ? qa : 7 - qa, jn = j + 1, qan = 2 * (jn >> 1) + s, qbn = (jn & 1) ? qan : 7 - qan;
            mla_unit(b, h, qb, j < 3 ? qbn : -1, qf, QB, PROJ, KNC, VBC, KRC, OAB, OSS, lds, wave);
        }
    }
    NOSEAM(4);
    if (IN(5)) {
        const int bg = vcu >> 3, s = vcu & 7, b = bg >> 1, g = bg & 1;
        bf16x8 qf[2][6]; float pta;
        dsa_prime(b, g, 31 - s, PROJ, KAC, VAC, MASK, POSF, lds, wave, qf, pta);
#pragma unroll
        for (int j = 0; j < 4; ++j) {
            const int qa = 8 * (j >> 1) + s, qb = (j & 1) ? qa : 31 - qa, jn = j + 1, qan = 8 * (jn >> 1) + s, qbn = (jn & 1) ? qan : 31 - qan;
            dsa_unit(b, g, qb, j < 3 ? qbn : -1, qf, pta, PROJ, KAC, VAC, MASK, POSF, OAB, OSS, lds, wave);
        }
    }
    SEAM(5);
    if (IN(7)) {
        pg8::Gemm g{OAB, WOT, M, DM, 1024, 1024}; pg8::StaticOrder So; So.init(M, DM, G, bx);
        EpiOut E{a.x, a.out, (unsigned long long*)(ws + WS_STATS), (unsigned*)(ws + WS_PCNT), OSS, a.ln_g, a.ln_b};
        pg8::gemm_phase<EpiOut>(lds, g, So, E, wave);
    }
#undef IN
#undef lane
#undef tid
#undef gt
#undef SEAM
#undef NOSEAM
}

constexpr int N_PHASES = 9;
#ifndef PROBE_PHASE
#define PROBE_PHASE -1
#endif
extern "C" void kernel_launch(void* const* d_in, const int* in_sizes, int n_in, void* d_out, int out_size, void* d_ws, size_t ws_size, hipStream_t stream) {
    static int grid = 0;
    if (grid == 0) {
        if (n_in != 12 || in_sizes[0] != M * DM || out_size != M * DM || ws_size < WS_END) { fprintf(stderr, "kernel_launch: unexpected shapes (n_in %d, in0 %d, out %d, ws %zu)\n", n_in, n_in > 0 ? in_sizes[0] : -1, out_size, ws_size); grid = -1; return; }
        int dev = 0, cus = 0, per_cu = 0;
        if (hipGetDevice(&dev) != hipSuccess || hipDeviceGetAttribute(&cus, hipDeviceAttributeMultiprocessorCount, dev) != hipSuccess) { grid = -1; return; }
        if (hipFuncSetAttribute((const void*)hybrid_fwd, hipFuncAttributeMaxDynamicSharedMemorySize, LDS_BYTES) != hipSuccess) { fprintf(stderr, "kernel_launch: hipFuncSetAttribute failed\n"); grid = -1; return; }
        if (hipOccupancyMaxActiveBlocksPerMultiprocessor(&per_cu, (const void*)hybrid_fwd, 512, LDS_BYTES) != hipSuccess || per_cu < 1) { fprintf(stderr, "kernel_launch: occupancy query says %d\n", per_cu); per_cu = 1; }
        (void)hipGetLastError();
        grid = cus;
        if (grid != 256) fprintf(stderr, "kernel_launch: %d CUs; this kernel's work deals assume 256\n", grid);
    }
    if (grid < 0) return;
    Args a{};
    a.x = (const float*)d_in[0]; a.pos = (const int*)d_in[1]; a.w_in = (const float*)d_in[2]; a.g_q = (const float*)d_in[3]; a.w_uq = (const float*)d_in[4]; a.g_kv = (const float*)d_in[5];
    a.w_ukv = (const float*)d_in[6]; a.g_oa = (const float*)d_in[7]; a.g_ob = (const float*)d_in[8]; a.w_out = (const float*)d_in[9]; a.ln_g = (const float*)d_in[10]; a.ln_b = (const float*)d_in[11];
    a.out = (float*)d_out; a.ws = (unsigned char*)d_ws;
    (void)hipMemsetAsync(d_ws, 0, 4096 + 256 * 256, stream);
#if MK_N_LAUNCHES == 1
    a.ph_lo = 0; a.ph_hi = N_PHASES;
    void* args[] = {&a};
    hipError_t e = hipLaunchCooperativeKernel((const void*)hybrid_fwd, dim3(grid), dim3(512), args, LDS_BYTES, stream);
    if (e != hipSuccess) fprintf(stderr, "kernel_launch: cooperative launch failed: %s (grid %d)\n", hipGetErrorString(e), grid);
#else
    for (int p = 0; p < N_PHASES; ++p) {
        a.ph_lo = p; a.ph_hi = p + 1;
        for (int rep = 0; rep < ((p == PROBE_PHASE) ? 2 : 1); ++rep) hipLaunchKernelGGL(hybrid_fwd, dim3(grid), dim3(512), LDS_BYTES, stream, a);
    }
#endif
}
```

```cpp
#include <hip/hip_runtime.h>
#include <hip/hip_cooperative_groups.h>
#include <cstdio>
#include <cstdint>
namespace cg = cooperative_groups;

#ifndef MK_N_LAUNCHES
#define MK_N_LAUNCHES 1
#endif

#define LAS __attribute__((address_space(3)))
typedef unsigned short bf16_t;
typedef short bf16x8 __attribute__((ext_vector_type(8)));
typedef short s16x4 __attribute__((ext_vector_type(4)));
typedef float f32x4 __attribute__((ext_vector_type(4)));
typedef float f32x2 __attribute__((ext_vector_type(2)));
typedef float f32x16 __attribute__((ext_vector_type(16)));
typedef unsigned u32x4 __attribute__((ext_vector_type(4)));
typedef unsigned u32x2 __attribute__((ext_vector_type(2)));

constexpr int NB = 16, S = 4096, M = NB * S, DM = 1024;
constexpr int NPROJ = 3072;
constexpr int C_QA = 0, C_KA = 512, C_VA = 640, C_IQ = 768, C_CQ = 1280, C_CKV = 1664, C_IK = 1920, C_KR = 1984, C_IW = 2016, C_Z = 2048;
constexpr int D_IN = 3048;
constexpr int NQB = 768, NKVB = 1024;
constexpr float LOG2E = 1.4426950408889634f;
constexpr float QA_SCALE = 0.125f * LOG2E;
constexpr float QB_SCALE = 0.10206207261596577f * LOG2E;
constexpr float IW_SCALE = 0.04419417382415922f;
constexpr float DN_ALPHA = 1.189207115002721f;
constexpr int KTOP = 256;

constexpr size_t MiB = 1u << 20;
constexpr size_t WS_W1T = 1 * MiB, WS_WUQT = 7 * MiB, WS_WUKVT = 8 * MiB, WS_WOT = 9 * MiB, WS_CS = 11 * MiB, WS_SSQ = 19 * MiB, WS_POSF = 25 * MiB,
                 WS_OSS = 26 * MiB, WS_STATS = 30 * MiB, WS_XB = 64 * MiB, WS_PROJ = 192 * MiB, WS_QB = 576 * MiB, WS_KVB = 672 * MiB, WS_MASK = 800 * MiB,
                 WS_IKC = 832 * MiB, WS_KRC = 840 * MiB, WS_KAC = 848 * MiB, WS_VAC = 864 * MiB, WS_CQC = 880 * MiB, WS_CKVC = 928 * MiB, WS_END = 960 * MiB;
constexpr size_t WS_KNC = WS_KVB, WS_VBC = WS_KVB + 64 * MiB;
constexpr size_t WS_PCNT = 4096;
constexpr size_t WS_OAB = WS_XB;
constexpr size_t WS_Y = WS_KVB;

constexpr int LDS_BYTES = 149504;

__device__ __forceinline__ unsigned cvt_pk_bf16(float lo, float hi) { unsigned r; asm volatile("v_cvt_pk_bf16_f32 %0, %1, %2" : "=v"(r) : "v"(lo), "v"(hi)); return r; }
__device__ __forceinline__ float bf_lo(unsigned u) { return __uint_as_float(u << 16); }
__device__ __forceinline__ float bf_hi(unsigned u) { return __uint_as_float(u & 0xffff0000u); }
__device__ __forceinline__ int crow(int r, int hi) { return (r & 3) + 8 * (r >> 2) + 4 * hi; }
__device__ __forceinline__ float silu_f(float v) { return v * __builtin_amdgcn_rcpf(1.0f + __builtin_amdgcn_exp2f(-v * LOG2E)); }
__device__ __forceinline__ size_t proj_off(size_t row, int col) { return ((row >> 4) * (size_t)(3072 / 8) + (size_t)(col >> 3)) * 128 + (row & 15) * 8 + (col & 7); }
__device__ __forceinline__ size_t vb_off(size_t row, int col) { return ((row >> 4) * (size_t)(1024 / 8) + (size_t)(col >> 3)) * 128 + (row & 15) * 8 + (col & 7); }
__device__ __forceinline__ float relu_f(float x) { const int b = __float_as_int(x); return __int_as_float(b > 0 ? b : 0); }
__device__ __forceinline__ int lane_id() { return (int)__builtin_amdgcn_mbcnt_hi(~0u, __builtin_amdgcn_mbcnt_lo(~0u, 0u)); }
__device__ __forceinline__ void glds16(const void* g, LAS unsigned char* l) { __builtin_amdgcn_global_load_lds((const unsigned*)g, (LAS unsigned*)l, 16, 0, 0); }

namespace pg8 {
constexpr int BM = 256, BK = 64, HALF = 128, HTB = HALF * BK * 2, STAGE_BYTES = 8 * HTB, NXCD = 8, WGM = 8;
__host__ __device__ __forceinline__ int lds_byte(int r, int c) { const int st = (r >> 4) * 2 + (c >> 5), rr = r & 15, cc = c & 31, ob = rr * 64 + cc * 2; return st * 1024 + (ob ^ (((ob >> 9) & 1) << 5)); }
__host__ __device__ __forceinline__ void stage_rc(int b, int& R, int& C) { const int st = b / 1024, sb = b % 1024, swz = sb ^ (((sb >> 9) & 1) << 5); R = (st >> 1) * 16 + swz / 64; C = (st & 1) * 32 + (swz % 64) / 2; }
__host__ __device__ __forceinline__ int perm32(int rho) { const int n = rho >> 4, i = rho & 15; return 8 * (i >> 2) + 4 * n + (i & 3); }

struct Unit { int pm, pn; };
struct Gemm { const bf16_t* A; const bf16_t* Bt; int M, N, K, lda; };

struct StaticOrder {
    int nM, nN, nwg, G, c;
    __host__ __device__ void init(int M_, int N_, int G_, int c_) { nM = M_ / BM; nN = N_ / BM; nwg = nM * nN; G = G_; c = c_; }
    __host__ __device__ bool next(int i, Unit& u) const {
        const long L = (long)i * G + c; if (L >= nwg) return false;
        int wgid = (int)L; { const int q = nwg / NXCD, r = nwg % NXCD, xcd = wgid % NXCD; int off = wgid / NXCD;
            if (nN == 12 && G % NXCD == 0) { const int per = G / NXCD, st = off / per, j = off % per; off = st * per + (j + 8 * (st / 3)) % per; }
            wgid = (xcd < r ? xcd * (q + 1) : r * (q + 1) + (xcd - r) * q) + off; }
        const int nig = WGM * nN, gid = wgid / nig, fm = gid * WGM, gsz = (nM - fm) < WGM ? (nM - fm) : WGM;
        u.pm = fm + ((wgid % nig) % gsz); u.pn = (wgid % nig) / gsz; return true;
    }
};

template <class Epi>
__device__ __forceinline__ void gemm_phase(LAS unsigned char* lds, const Gemm g, const StaticOrder& S, const Epi& E, const int wid) {
    const int lane = lane_id(), tid = wid * 64 + lane, wr = wid >> 2, wc = wid & 3, fr = lane & 15, fq = lane >> 4;
    const int K = g.K, nt = K / BK, lda = g.lda;
    unsigned voffA[2], voffB[2];
#pragma unroll
    for (int i = 0; i < 2; ++i) { int R, C; stage_rc(tid * 16 + i * 8192, R, C); const int Rb = Epi::PERM ? ((R & ~31) + perm32(R & 31)) : R;
        voffA[i] = (unsigned)(R * lda + C) * 2u; voffB[i] = (unsigned)(Rb * K + C) * 2u; }
    const size_t kstep = (size_t)(BK * 2);
    const size_t hstepA = (size_t)HALF * lda * 2, tstepA = 2 * hstepA;
    const size_t hstepB = (size_t)HALF * K * 2, tstepB = 2 * hstepB;
    const unsigned ldsw = (unsigned)wid * 1024u;
    const int aoff = lds_byte(wr * 64 + fr, fq * 8), boff = lds_byte(wc * 32 + fr, fq * 8);
#define PG8_SA(b, h) (((b) * 2 + (h)) * HTB)
#define PG8_SB(b, h) ((4 + (b) * 2 + (h)) * HTB)
#define PG8_STAGE(bufoff, gbase, voff) do { _Pragma("unroll") for (int _i = 0; _i < 2; ++_i) \
        __builtin_amdgcn_global_load_lds((const unsigned*)((const char*)(gbase) + (voff)[_i]), (LAS unsigned*)(lds + (bufoff) + ldsw + _i * 8192), 16, 0, 0); } while (0)
#define PG8_LDA(dst, b, h) do { _Pragma("unroll") for (int m = 0; m < 4; ++m) _Pragma("unroll") for (int k = 0; k < 2; ++k) dst[m][k] = *(const LAS bf16x8*)(lds + PG8_SA(b, h) + aoff + m * 2048 + k * 1024); } while (0)
#define PG8_LDB(dst, b, h) do { _Pragma("unroll") for (int n = 0; n < 2; ++n) _Pragma("unroll") for (int k = 0; k < 2; ++k) dst[n][k] = *(const LAS bf16x8*)(lds + PG8_SB(b, h) + boff + n * 2048 + k * 1024); } while (0)
#define PG8_MMA(ai, bj, At, Bt) do { __builtin_amdgcn_s_setprio(1); _Pragma("unroll") for (int m = 0; m < 4; ++m) _Pragma("unroll") for (int n = 0; n < 2; ++n) _Pragma("unroll") for (int k = 0; k < 2; ++k) \
        acc[ai][bj][m][n] = __builtin_amdgcn_mfma_f32_16x16x32_bf16(Bt[n][k], At[m][k], acc[ai][bj][m][n], 0, 0, 0); __builtin_amdgcn_s_setprio(0); } while (0)
#define PG8_WAIT_V(n) asm volatile("s_waitcnt vmcnt(" #n ")" ::: "memory")
#define PG8_WAIT_L(n) asm volatile("s_waitcnt lgkmcnt(" #n ")" ::: "memory")
#define PG8_BAR __builtin_amdgcn_s_barrier()
#define PG8_SCHED __builtin_amdgcn_sched_barrier(0)
    Unit cur, nxt; int ui = 0;
    if (!S.next(0, cur)) return;
    f32x4 acc[2][2][4][2];
#pragma unroll
    for (int a = 0; a < 2; ++a)
#pragma unroll
        for (int b = 0; b < 2; ++b)
#pragma unroll
            for (int m = 0; m < 4; ++m)
#pragma unroll
                for (int n = 0; n < 2; ++n) acc[a][b][m][n] = (f32x4){0.f, 0.f, 0.f, 0.f};
    bf16x8 At[4][2], B0[2][2], B1[2][2];
    const char* cA = (const char*)g.A + (size_t)cur.pm * tstepA; const char* cB = (const char*)g.Bt + (size_t)cur.pn * tstepB;
    PG8_STAGE(PG8_SB(0, 0), cB, voffB); PG8_STAGE(PG8_SB(0, 1), cB + hstepB, voffB); PG8_STAGE(PG8_SA(0, 0), cA, voffA); PG8_STAGE(PG8_SA(0, 1), cA + hstepA, voffA);
    if (wr == 1) PG8_BAR;
    PG8_WAIT_V(2); PG8_BAR;
    PG8_STAGE(PG8_SB(1, 0), cB + kstep, voffB); PG8_STAGE(PG8_SA(1, 0), cA + kstep, voffA); PG8_STAGE(PG8_SB(1, 1), cB + hstepB + kstep, voffB);
    PG8_WAIT_V(6); PG8_BAR;
    for (;;) {
        const bool has_next = S.next(ui + 1, nxt);
        const char* nA = has_next ? (const char*)g.A + (size_t)nxt.pm * tstepA : cA; const char* nB = has_next ? (const char*)g.Bt + (size_t)nxt.pn * tstepB : cB;
        for (int t = 0; t < nt; t += 2) {
            if constexpr (Epi::MID) {
                if (t == nt / 2) {
                    float midf[2][4]; E.mid_load(midf, cur, wr, ui, lds + 131072);
#pragma unroll
                    for (int a = 0; a < 2; ++a)
#pragma unroll
                        for (int b = 0; b < 2; ++b)
#pragma unroll
                            for (int m = 0; m < 4; ++m)
#pragma unroll
                                for (int n = 0; n < 2; ++n) acc[a][b][m][n] *= midf[a][m];
                }
            }
            const bool last = (t == nt - 2);
            const char* a1 = cA + (size_t)(t + 1) * kstep;
            const char* a2 = last ? nA : cA + (size_t)(t + 2) * kstep; const char* b2 = last ? nB : cB + (size_t)(t + 2) * kstep;
            const char* a3 = a2 + kstep; const char* b3 = b2 + kstep;
            PG8_LDB(B0, 0, 0); PG8_LDB(B1, 0, 1); PG8_SCHED; PG8_LDA(At, 0, 0); PG8_STAGE(PG8_SA(1, 1), a1 + hstepA, voffA);
            PG8_WAIT_V(8); PG8_WAIT_L(0); PG8_BAR; PG8_MMA(0, 0, At, B0); PG8_MMA(0, 1, At, B1); PG8_BAR; PG8_SCHED;
            PG8_LDA(At, 0, 1); PG8_STAGE(PG8_SB(0, 0), b2, voffB); PG8_STAGE(PG8_SB(0, 1), b2 + hstepB, voffB); PG8_STAGE(PG8_SA(0, 0), a2, voffA);
            PG8_WAIT_V(8); PG8_WAIT_L(0); PG8_BAR; PG8_MMA(1, 0, At, B0); PG8_MMA(1, 1, At, B1); PG8_BAR; PG8_SCHED;
            PG8_LDB(B0, 1, 0); PG8_LDB(B1, 1, 1); PG8_SCHED; PG8_LDA(At, 1, 0); PG8_STAGE(PG8_SA(0, 1), a2 + hstepA, voffA);
            PG8_WAIT_V(8); PG8_WAIT_L(0); PG8_BAR; PG8_MMA(0, 0, At, B0); PG8_MMA(0, 1, At, B1); PG8_BAR; PG8_SCHED;
            PG8_LDA(At, 1, 1); PG8_STAGE(PG8_SB(1, 0), b3, voffB); PG8_STAGE(PG8_SB(1, 1), b3 + hstepB, voffB); PG8_STAGE(PG8_SA(1, 0), a3, voffA);
            PG8_WAIT_V(8); PG8_WAIT_L(0); PG8_BAR; PG8_MMA(1, 0, At, B0); PG8_MMA(1, 1, At, B1); PG8_BAR; PG8_SCHED;
        }
        if (wr == 0) PG8_BAR;
        if constexpr (Epi::FUSED) E.fused(acc, cur, wr, wc, lds + 131072, wid, ui); else E(acc, cur, wr, wc, fr, fq);
        if (!has_next) break;
#pragma unroll
        for (int a = 0; a < 2; ++a)
#pragma unroll
            for (int b = 0; b < 2; ++b)
#pragma unroll
                for (int m = 0; m < 4; ++m)
#pragma unroll
                    for (int n = 0; n < 2; ++n) acc[a][b][m][n] = (f32x4){0.f, 0.f, 0.f, 0.f};
        cur = nxt; cA = nA; cB = nB; ++ui;
        if (wr == 1) PG8_BAR;
    }
    PG8_WAIT_V(0);
    PG8_BAR;
#undef PG8_SA
#undef PG8_SB
#undef PG8_STAGE
#undef PG8_LDA
#undef PG8_LDB
#undef PG8_MMA
#undef PG8_WAIT_V
#undef PG8_WAIT_L
#undef PG8_BAR
#undef PG8_SCHED
}
}

__device__ __forceinline__ int lane_id_nohoist() { int l; asm volatile("v_mbcnt_lo_u32_b32 %0, -1, 0\n\tv_mbcnt_hi_u32_b32 %0, -1, %0" : "=v"(l)); return l; }

__device__ __forceinline__ void rope8(f32x4& v0, f32x4& v1, const float* csrow, int fq) {
    const f32x4 c = *(const f32x4*)(csrow + 4 * fq), s = *(const f32x4*)(csrow + 16 + 4 * fq);
    const float a0 = v0[0] * c[0] - v0[1] * s[0], b0 = v0[0] * s[0] + v0[1] * c[0];
    const float a1 = v0[2] * c[1] - v0[3] * s[1], b1 = v0[2] * s[1] + v0[3] * c[1];
    const float a2 = v1[0] * c[2] - v1[1] * s[2], b2 = v1[0] * s[2] + v1[1] * c[2];
    const float a3 = v1[2] * c[3] - v1[3] * s[3], b3 = v1[2] * s[3] + v1[3] * c[3];
    v0 = (f32x4){a0, b0, a1, b1}; v1 = (f32x4){a2, b2, a3, b3};
}
__device__ __forceinline__ void rope8r(f32x4& v0, f32x4& v1, const f32x4& c, const f32x4& s) {
    const float a0 = v0[0] * c[0] - v0[1] * s[0], b0 = v0[0] * s[0] + v0[1] * c[0];
    const float a1 = v0[2] * c[1] - v0[3] * s[1], b1 = v0[2] * s[1] + v0[3] * c[1];
    const float a2 = v1[0] * c[2] - v1[1] * s[2], b2 = v1[0] * s[2] + v1[1] * c[2];
    const float a3 = v1[2] * c[3] - v1[3] * s[3], b3 = v1[2] * s[3] + v1[3] * c[3];
    v0 = (f32x4){a0, b0, a1, b1}; v1 = (f32x4){a2, b2, a3, b3};
}
__device__ __forceinline__ void store8(bf16_t* p, const f32x4& v0, const f32x4& v1) {
    u32x4 w; w.x = cvt_pk_bf16(v0[0], v0[1]); w.y = cvt_pk_bf16(v0[2], v0[3]); w.z = cvt_pk_bf16(v1[0], v1[1]); w.w = cvt_pk_bf16(v1[2], v1[3]);
    *(u32x4*)p = w;
}

struct EpiProj {
    static constexpr bool PERM = true, MID = false, FUSED = false;
    bf16_t* P; const float* cs; float* ssq; bf16_t* IKC; bf16_t* KRC; bf16_t* KAC; bf16_t* VAC; bf16_t* CQC; bf16_t* CKVC;
    __device__ __forceinline__ void operator()(const f32x4 (&acc)[2][2][4][2], const pg8::Unit& u, int wr, int wc, int fr_, int fq_) const {
        const int l_ = lane_id_nohoist(), fr = l_ & 15, fq = l_ >> 4;
        const int row0 = u.pm * 256 + wr * 64 + fr, colt = u.pn * 256 + wc * 32 + 8 * fq, pn = u.pn;
#pragma unroll
        for (int ai = 0; ai < 2; ++ai) {
            f32x4 rc[4], rs[4];
            if (pn == 7 && wc == 2) {
#pragma unroll
                for (int m = 0; m < 4; ++m) { const float* cp = cs + (size_t)(row0 + ai * 128 + m * 16) * 32 + 4 * fq; rc[m] = *(const f32x4*)cp; rs[m] = *(const f32x4*)(cp + 16); }
            }
#pragma unroll
            for (int m = 0; m < 4; ++m) {
                const int row = row0 + ai * 128 + m * 16;
#pragma unroll
                for (int bj = 0; bj < 2; ++bj) {
                    f32x4 v0 = acc[ai][bj][m][0], v1 = acc[ai][bj][m][1];
                    bf16_t* dst = P + proj_off((size_t)row, colt + bj * 128);
                    if (pn >= 8) {
#pragma unroll
                        for (int j = 0; j < 4; ++j) { v0[j] = silu_f(v0[j]); v1[j] = silu_f(v1[j]); }
                    } else if (pn == 2) {
                        const size_t tb = (size_t)((row >> 12) * 2 + (wc >> 1)) * 64 + ((row & 4095) >> 6); const int k = row & 63;
                        dst = (bj == 0) ? KAC + (tb * 8 + 4 * (wc & 1) + fq) * 512 + k * 8 : VAC + (tb * 2 + (wc & 1)) * 2048 + k * 32 + 8 * fq;
                    } else if (pn >= 5) {
                        int slot = -1;
                        if (pn == 5) { slot = bj * 4 + wc; dst = CQC + (size_t)row * 384 + bj * 128 + wc * 32 + 8 * fq; }
                        else if (pn == 6) { if (bj == 0) { slot = 8 + wc; dst = CQC + (size_t)row * 384 + 256 + wc * 32 + 8 * fq; } else { slot = 12 + wc; dst = CKVC + (size_t)row * 256 + wc * 32 + 8 * fq; } }
                        else if (bj == 0) { slot = 16 + wc; dst = CKVC + (size_t)row * 256 + 128 + wc * 32 + 8 * fq; }
                        if (slot >= 0) {
                            float s = (v0[0] * v0[0] + v0[1] * v0[1]) + (v0[2] * v0[2] + v0[3] * v0[3]) + (v1[0] * v1[0] + v1[1] * v1[1]) + (v1[2] * v1[2] + v1[3] * v1[3]);
                            s += __shfl_xor(s, 16); s += __shfl_xor(s, 32);
                            if (fq == 0) ssq[(size_t)row * 20 + slot] = s;
                        } else if (wc < 2) dst = IKC + ((size_t)(row >> 5) * 8 + 4 * wc + fq) * 256 + (row & 31) * 8;
                        else if (wc == 2) { rope8r(v0, v1, rc[m], rs[m]); dst = KRC + ((size_t)(row >> 6) * 4 + fq) * 512 + (row & 63) * 8; }
                    }
                    store8(dst, v0, v1);
                }
                asm volatile("" ::: "memory");
            }
        }
    }
};
struct EpiUp {
    static constexpr bool PERM = true, MID = false, FUSED = false;
    bf16_t* O; int ldc; const float* ssq; int slot0, nslot4; float invK; const float* cs; int rope_pn; bf16_t* HK; bf16_t* HV;
    __device__ __forceinline__ void operator()(const f32x4 (&acc)[2][2][4][2], const pg8::Unit& u, int wr, int wc, int fr_, int fq_) const {
        const int l_ = lane_id_nohoist(), fr = l_ & 15, fq = l_ >> 4;
        const int row0 = u.pm * 256 + wr * 64 + fr, colt = u.pn * 256 + wc * 32 + 8 * fq;
#pragma unroll
        for (int ai = 0; ai < 2; ++ai) {
            float rstd[4];
            { f32x4 tq[4][3];
#pragma unroll
              for (int m = 0; m < 4; ++m)
#pragma unroll
                  for (int q = 0; q < 3; ++q) tq[m][q] = (q < nslot4) ? *(const f32x4*)(ssq + (size_t)(row0 + ai * 128 + m * 16) * 20 + slot0 + 4 * q) : (f32x4){0.f, 0.f, 0.f, 0.f};
#pragma unroll
              for (int m = 0; m < 4; ++m) { const f32x4 t = tq[m][0] + tq[m][1] + tq[m][2]; rstd[m] = __builtin_amdgcn_rsqf(((t[0] + t[1]) + (t[2] + t[3])) * invK + 1e-6f); } }
            f32x4 rc[4], rs[4];
            if (u.pn == rope_pn) {
#pragma unroll
                for (int m = 0; m < 4; ++m) { const float* cp = cs + (size_t)(row0 + ai * 128 + m * 16) * 32 + 4 * fq; rc[m] = *(const f32x4*)cp; rs[m] = *(const f32x4*)(cp + 16); }
            }
#pragma unroll
            for (int m = 0; m < 4; ++m) {
                const int row = row0 + ai * 128 + m * 16; bf16_t* rowp = O + (size_t)row * ldc + colt;
#pragma unroll
                for (int bj = 0; bj < 2; ++bj) {
                    f32x4 v0 = acc[ai][bj][m][0] * rstd[m], v1 = acc[ai][bj][m][1] * rstd[m];
                    if (u.pn == rope_pn) rope8r(v0, v1, rc[m], rs[m]);
                    bf16_t* dst = rowp + bj * 128;
                    if (HK) { const int h = 4 * (u.pn & 1) + 2 * bj + (wc >> 1);
                        const size_t tb = (size_t)((row >> 12) * 8 + h) * 64 + ((row & 4095) >> 6); const int k = row & 63;
                        dst = (u.pn < 2) ? HK + (tb * 8 + 4 * (wc & 1) + fq) * 512 + k * 8 : HV + (tb * 2 + (wc & 1)) * 2048 + k * 32 + 8 * fq; }
                    store8(dst, v0, v1);
                }
                asm volatile("" ::: "memory");
            }
        }
    }
};
struct EpiOut {
    static constexpr bool PERM = true, MID = true, FUSED = true;
    const float* x; float* out; unsigned long long* xbuf; unsigned* cnt; const float* oss; const float* ln_g; const float* ln_b;
    __device__ __forceinline__ float rstd_of(const float* p) const { const f32x4 s0 = *(const f32x4*)p, s1 = *(const f32x4*)(p + 4);
        return __builtin_amdgcn_rsqf((((s0[0] + s0[1]) + (s0[2] + s0[3])) + ((s1[0] + s1[1]) + (s1[2] + s1[3]))) * (1.0f / 512.0f) + 1e-6f); }
    __device__ __forceinline__ void fill_rs(const pg8::StaticOrder& So, LAS unsigned char* tl, int tid_) const {
        LAS f32x2* RS = (LAS f32x2*)(tl + 10240);
        f32x4 v[2][4]; int ok[2];
#pragma unroll
        for (int k = 0; k < 2; ++k) { const int r = tid_ + 512 * k; pg8::Unit u; ok[k] = So.next(r >> 8, u) ? 1 : 0; const float* p = oss + (size_t)((ok[k] ? u.pm : 0) * 256 + (r & 255)) * 16;
#pragma unroll
            for (int q = 0; q < 4; ++q) v[k][q] = *(const f32x4*)(p + 4 * q); }
#pragma unroll
        for (int k = 0; k < 2; ++k) { const int r = tid_ + 512 * k;
            const float ra = __builtin_amdgcn_rsqf((((v[k][0][0] + v[k][0][1]) + (v[k][0][2] + v[k][0][3])) + ((v[k][1][0] + v[k][1][1]) + (v[k][1][2] + v[k][1][3]))) * (1.0f / 512.0f) + 1e-6f);
            const float rb = __builtin_amdgcn_rsqf((((v[k][2][0] + v[k][2][1]) + (v[k][2][2] + v[k][2][3])) + ((v[k][3][0] + v[k][3][1]) + (v[k][3][2] + v[k][3][3]))) * (1.0f / 512.0f) + 1e-6f);
            RS[r] = (f32x2){ra / rb, rb}; }
        asm volatile("s_waitcnt lgkmcnt(0)" ::: "memory"); __builtin_amdgcn_s_barrier(); asm volatile("" ::: "memory");
    }
    __device__ __forceinline__ void mid_load(float (&f)[2][4], const pg8::Unit& u, int wr, int ui, LAS unsigned char* tl) const {
        const LAS f32x2* RS = (const LAS f32x2*)(tl + 10240) + ui * 256;
        const int fr = lane_id_nohoist() & 15;
#pragma unroll
        for (int ai = 0; ai < 2; ++ai)
#pragma unroll
            for (int m = 0; m < 4; ++m) f[ai][m] = RS[wr * 64 + fr + ai * 128 + m * 16].x;
    }
    __device__ __forceinline__ void fused(f32x4 (&acc)[2][2][4][2], const pg8::Unit& u, int wr, int wc, LAS unsigned char* tl, int wid, int ui) const {
        LAS f32x2* P = (LAS f32x2*)tl;
        LAS f32x2* SX = (LAS f32x2*)(tl + 8192);
        { const int l_ = lane_id_nohoist(), fr = l_ & 15, fq = l_ >> 4;
          const int row0 = u.pm * 256 + wr * 64 + fr, col0 = u.pn * 256 + wc * 32 + 8 * fq;
#pragma unroll
          for (int ai = 0; ai < 2; ++ai)
#pragma unroll
            for (int m = 0; m < 4; ++m) {
                const int row = row0 + ai * 128 + m * 16; const size_t off = (size_t)row * DM + col0;
                const float rb = ((const LAS f32x2*)(tl + 10240))[ui * 256 + ai * 128 + wr * 64 + m * 16 + fr].y;
                float sm = 0.f, q = 0.f;
#pragma unroll
                for (int bj = 0; bj < 2; ++bj) {
                    const f32x4 x0 = *(const f32x4*)(x + off + bj * 128), x1 = *(const f32x4*)(x + off + bj * 128 + 4);
                    const f32x4 v0 = x0 * DN_ALPHA + acc[ai][bj][m][0] * rb, v1 = x1 * DN_ALPHA + acc[ai][bj][m][1] * rb;
                    sm += ((v0[0] + v0[1]) + (v0[2] + v0[3])) + ((v1[0] + v1[1]) + (v1[2] + v1[3]));
                    q += ((v0[0] * v0[0] + v0[1] * v0[1]) + (v0[2] * v0[2] + v0[3] * v0[3])) + ((v1[0] * v1[0] + v1[1] * v1[1]) + (v1[2] * v1[2] + v1[3] * v1[3]));
                    acc[ai][bj][m][0] = v0; acc[ai][bj][m][1] = v1;
                }
                sm += __shfl_xor(sm, 16); sm += __shfl_xor(sm, 32); q += __shfl_xor(q, 16); q += __shfl_xor(q, 32);
                if (fq == 0) P[(ai * 128 + wr * 64 + m * 16 + fr) * 4 + wc] = (f32x2){sm, q};
                asm volatile("" ::: "memory");
            } }
        asm volatile("s_waitcnt lgkmcnt(0)" ::: "memory"); __builtin_amdgcn_s_barrier(); asm volatile("" ::: "memory");
        const int ln = lane_id_nohoist(), rl = wid * 32 + (ln & 31);
        if (ln < 32) {
            const f32x2 a = P[rl * 4 + 0], b = P[rl * 4 + 1], c = P[rl * 4 + 2], d = P[rl * 4 + 3];
            const float st = (a.x + b.x) + (c.x + d.x), qt = (a.y + b.y) + (c.y + d.y);
            __hip_atomic_store(xbuf + ((size_t)(u.pm * 256 + rl) * 4 + u.pn), ((unsigned long long)__float_as_uint(qt) << 32) | __float_as_uint(st), __ATOMIC_RELAXED, __HIP_MEMORY_SCOPE_AGENT);
        }
        asm volatile("s_waitcnt vmcnt(0)" ::: "memory");
        if (ln == 0) __hip_atomic_fetch_add(cnt + 64 * u.pm, 1u, __ATOMIC_RELAXED, __HIP_MEMORY_SCOPE_AGENT);
        if (wid == 0) {
            unsigned spins = 0;
            while ((unsigned)__builtin_amdgcn_readfirstlane((int)__hip_atomic_load(cnt + 64 * u.pm, __ATOMIC_RELAXED, __HIP_MEMORY_SCOPE_AGENT)) < 32u) { __builtin_amdgcn_s_sleep(1); if (++spins > (1u << 24)) break; }
            __builtin_amdgcn_fence(__ATOMIC_ACQUIRE, "agent");
        }
        asm volatile("s_waitcnt vmcnt(0) lgkmcnt(0)" ::: "memory"); __builtin_amdgcn_s_barrier(); asm volatile("" ::: "memory");
        if (ln < 32) {
            const unsigned long long* slot = xbuf + (size_t)(u.pm * 256 + rl) * 4; float st = 0.f, qt = 0.f;
#pragma unroll
            for (int t = 0; t < 4; ++t) { const unsigned long long w = __hip_atomic_load(slot + t, __ATOMIC_RELAXED, __HIP_MEMORY_SCOPE_AGENT); st += __uint_as_float((unsigned)w); qt += __uint_as_float((unsigned)(w >> 32)); }
            const float mean = st * (1.0f / DM), var = qt * (1.0f / DM) - mean * mean;
            SX[rl] = (f32x2){mean, 1.0f / sqrtf(fmaxf(var, 0.f) + 1e-5f)};
        }
        asm volatile("s_waitcnt lgkmcnt(0)" ::: "memory"); __builtin_amdgcn_s_barrier(); asm volatile("" ::: "memory");
        { const int l_ = lane_id_nohoist(), fr = l_ & 15, fq = l_ >> 4;
          const int col0 = u.pn * 256 + wc * 32 + 8 * fq;
#pragma unroll
          for (int bj = 0; bj < 2; ++bj) {
              const int col = col0 + bj * 128;
              const f32x4 g0 = *(const f32x4*)(ln_g + col), g1 = *(const f32x4*)(ln_g + col + 4), b0 = *(const f32x4*)(ln_b + col), b1 = *(const f32x4*)(ln_b + col + 4);
#pragma unroll
              for (int ai = 0; ai < 2; ++ai)
#pragma unroll
                  for (int m = 0; m < 4; ++m) { const int r = ai * 128 + wr * 64 + m * 16 + fr; const f32x2 sr = SX[r];
                      float* op = out + (size_t)(u.pm * 256 + r) * DM + col;
                      *(f32x4*)op = (acc[ai][bj][m][0] - sr.x) * sr.y * g0 + b0; *(f32x4*)(op + 4) = (acc[ai][bj][m][1] - sr.x) * sr.y * g1 + b1; }
              asm volatile("" ::: "memory");
          } }
    }
    __device__ __forceinline__ void operator()(const f32x4 (&acc)[2][2][4][2], const pg8::Unit& u, int wr, int wc, int fr_, int fq_) const {}
};

constexpr int AT_KB = 12288, AT_VOFF = 3 * AT_KB, AT_VB = 8192, AT_POS = 8192, AT_MSK = 8448;
__device__ __forceinline__ s16x4 vtr(const LAS unsigned char* p) {
    typedef short v4i16_t __attribute__((ext_vector_type(4)));
    return __builtin_bit_cast(s16x4, __builtin_amdgcn_ds_read_tr16_b64_v4i16((LAS v4i16_t*)p));
}
typedef __bf16 bf16x2_t __attribute__((ext_vector_type(2)));
__device__ __forceinline__ unsigned cvtpk(float lo, float hi) { f32x2 v = {lo, hi}; bf16x2_t bb = __builtin_convertvector(v, bf16x2_t); return __builtin_bit_cast(unsigned, bb); }
__device__ __forceinline__ float swap32_max(float x) { auto r = __builtin_amdgcn_permlane32_swap(__float_as_uint(x), __float_as_uint(x), false, false); return fmaxf(__uint_as_float(r[0]), __uint_as_float(r[1])); }
__device__ __forceinline__ float swap32_sum(float x) { auto r = __builtin_amdgcn_permlane32_swap(__float_as_uint(x), __float_as_uint(x), false, false); return __uint_as_float(r[0]) + __uint_as_float(r[1]); }
__device__ __forceinline__ void dma16(const void* gbase, unsigned voff, unsigned lds_dst) { unsigned keep;
    asm volatile("s_mov_b32 %0, m0\n\ts_mov_b32 m0, %3\n\ts_nop 0\n\tglobal_load_lds_dwordx4 %1, %2\n\ts_mov_b32 m0, %0" : "=&s"(keep) : "v"(voff), "s"(gbase), "s"(lds_dst) : "memory"); }
__device__ __forceinline__ void dma4(const void* gbase, unsigned voff, unsigned lds_dst) { unsigned keep;
    asm volatile("s_mov_b32 %0, m0\n\ts_mov_b32 m0, %3\n\ts_nop 0\n\tglobal_load_lds_dword %1, %2\n\ts_mov_b32 m0, %0" : "=&s"(keep) : "v"(voff), "s"(gbase), "s"(lds_dst) : "memory"); }
#define AT_SYNC() asm volatile("s_waitcnt vmcnt(0) lgkmcnt(0)\n\ts_barrier" ::: "memory")

constexpr int AT_BUF = AT_KB + AT_VB;
constexpr float AT_THR = 8.0f;
constexpr int AT_MSK2 = AT_MSK + 1024;
template <int MODE>
__device__ __forceinline__ void attn_prime(const bf16_t* ksrc, const bf16_t* rsrc, const bf16_t* vsrc, const unsigned long long* msrc, const float* psrc, LAS unsigned char* lds, const int wid) {
    const unsigned _b = (unsigned)(uintptr_t)lds; const unsigned _l = (unsigned)lane_id_nohoist();
    dma16(ksrc, _l * 16u, (unsigned)__builtin_amdgcn_readfirstlane(_b + wid * 1024));
    if (MODE == 0) { if (wid >= 4) dma16(rsrc, _l * 16u, (unsigned)__builtin_amdgcn_readfirstlane(_b + (8 + (wid & 3)) * 1024)); }
    else { if (wid == 0) dma4(psrc, _l * 4u, (unsigned)__builtin_amdgcn_readfirstlane(_b + AT_POS));
           if (wid == 1) dma16(msrc, (_l & 31u) * 16u + (_l >> 5) * 32768u, (unsigned)__builtin_amdgcn_readfirstlane(_b + AT_MSK)); }
    dma16(vsrc, _l * 16u, (unsigned)__builtin_amdgcn_readfirstlane(_b + AT_KB + wid * 1024));
}
template <int MODE>
__device__ __forceinline__ void attn_core(const bf16x8 (&qf)[2][6], const int NT, const int tlast, const int tqbase, const int tlastb, const int tqbaseb, const bf16_t* ksrc, const bf16_t* rsrc, const bf16_t* vsrc,
                                          const unsigned long long* msrc, const float* psrc, const float pta, const float nsa, const float nsb, const int qjbase,
                                          LAS unsigned char* lds, const int wid, const int lane, f32x16 (&oT)[2][2], float (&l_out)[2]) {
    constexpr int NKS = (MODE == 0) ? 6 : 4;
    const int r32 = lane & 31, hi = lane >> 5;
    const int vboff = ((lane >> 4) & 1) * 32 + (lane & 3) * 8 + (4 * hi + ((lane & 15) >> 2)) * 64;
    const unsigned lds0 = (unsigned)(uintptr_t)lds;
#define AT_DMA(t, bsel) do { const unsigned _b = lds0 + (bsel) * AT_BUF; const unsigned _l = (unsigned)lane_id_nohoist(); \
        dma16(ksrc + (size_t)(t) * 4096, _l * 16u, (unsigned)__builtin_amdgcn_readfirstlane(_b + wid * 1024)); \
        if (MODE == 0) { if (wid >= 4) dma16(rsrc + (size_t)(t) * 2048, _l * 16u, (unsigned)__builtin_amdgcn_readfirstlane(_b + (8 + (wid & 3)) * 1024)); } \
        else { if (wid == 0) dma4(psrc + (size_t)(t) * 64, _l * 4u, (unsigned)__builtin_amdgcn_readfirstlane(_b + AT_POS)); \
               if (wid == 1) dma16(msrc + (size_t)(t) * 64, (_l & 31u) * 16u + (_l >> 5) * 32768u, (unsigned)__builtin_amdgcn_readfirstlane(_b + AT_MSK)); } \
        dma16(vsrc + (size_t)(t) * 4096, _l * 16u, (unsigned)__builtin_amdgcn_readfirstlane(_b + AT_KB + wid * 1024)); } while (0)
#define AT_SOFTMAX(p0, p1, o, mref, l, first) do { \
        float a = fmaxf(fmaxf(p0[0], p1[0]), p0[1]), bq = fmaxf(fmaxf(p1[1], p0[2]), p1[2]); \
        _Pragma("unroll") for (int r = 3; r < 15; r += 2) { a = fmaxf(fmaxf(a, p0[r]), p1[r]); bq = fmaxf(fmaxf(bq, p0[r + 1]), p1[r + 1]); } \
        const float mx = swap32_max(fmaxf(fmaxf(a, bq), fmaxf(p0[15], p1[15]))) - mref; \
        const bool mv = first ? (mx > -INFINITY) : (mx > AT_THR); \
        if (__any(mv)) { const float dl = (mx > -INFINITY && (first || mx > 0.f)) ? mx : 0.f; mref += dl; const float f = first ? 0.f : __builtin_amdgcn_exp2f(-dl); \
            _Pragma("unroll") for (int r = 0; r < 16; ++r) { o[0][r] *= f; o[1][r] *= f; } \
            l *= f; if (mx > -INFINITY) first = false; } \
        float sacc = 0.f; \
        _Pragma("unroll") for (int r = 0; r < 16; ++r) { p0[r] = __builtin_amdgcn_exp2f(p0[r] - mref); p1[r] = __builtin_amdgcn_exp2f(p1[r] - mref); sacc += p0[r] + p1[r]; } \
        l += sacc; } while (0)
#define AT_PACK(pw, p0, p1) _Pragma("unroll") for (int s4 = 0; s4 < 4; ++s4) { const f32x16& p = (s4 < 2) ? p0 : p1; const int o = 8 * (s4 & 1); \
            pw[s4] = (u32x4){cvtpk(p[o], p[o + 1]), cvtpk(p[o + 2], p[o + 3]), cvtpk(p[o + 4], p[o + 5]), cvtpk(p[o + 6], p[o + 7])}; }
    float mrefa = 0.f, mrefb = 0.f, la = 0.f, lb = 0.f; bool firsta = true, firstb = true;
    oT[0][0] = f32x16{}; oT[0][1] = f32x16{}; oT[1][0] = f32x16{}; oT[1][1] = f32x16{};
    AT_SYNC();
    for (int t = 0; t < NT; ++t) {
        const int cur = t & 1;
        if (t + 1 < NT) AT_DMA(t + 1, cur ^ 1);
        if (MODE == 0 && t > tlast && t <= tlastb) {
            const LAS unsigned char* buf = lds + cur * AT_BUF;
            f32x16 pb0 = f32x16{}, pb1 = f32x16{};
            { const LAS unsigned char* kb = buf + hi * 1024 + r32 * 16;
              __builtin_amdgcn_s_setprio(1);
#pragma unroll
              for (int d0 = 0; d0 < NKS; ++d0) { const bf16x8 a0 = *(const LAS bf16x8*)(kb + d0 * 2048), a1 = *(const LAS bf16x8*)(kb + d0 * 2048 + 512);
                  pb0 = __builtin_amdgcn_mfma_f32_32x32x16_bf16(a0, qf[1][d0], pb0, 0, 0, 0); pb1 = __builtin_amdgcn_mfma_f32_32x32x16_bf16(a1, qf[1][d0], pb1, 0, 0, 0); }
              __builtin_amdgcn_s_setprio(0); }
            if (t * 64 + 63 > tqbaseb) { const int kb0 = t * 64 + 4 * hi, tqb = tqbaseb + (lane_id_nohoist() & 31);
#pragma unroll
                for (int r = 0; r < 16; ++r) { const int ks = kb0 + (r & 3) + 8 * (r >> 2); if (ks > tqb) pb0[r] = -INFINITY; if (ks + 32 > tqb) pb1[r] = -INFINITY; } }
            AT_SOFTMAX(pb0, pb1, oT[1], mrefb, lb, firstb);
            u32x4 pwb[4];
            AT_PACK(pwb, pb0, pb1)
            { const LAS unsigned char* vbase = buf + AT_KB + vboff;
              __builtin_amdgcn_s_setprio(1);
#pragma unroll
              for (int d0 = 0; d0 < 2; ++d0)
#pragma unroll
                  for (int s4 = 0; s4 < 4; ++s4) {
                      const s16x4 vlo = vtr(vbase + d0 * 4096 + s4 * 1024), vhi = vtr(vbase + d0 * 4096 + s4 * 1024 + 512);
                      const bf16x8 vf = (bf16x8){vlo[0], vlo[1], vlo[2], vlo[3], vhi[0], vhi[1], vhi[2], vhi[3]};
                      oT[1][d0] = __builtin_amdgcn_mfma_f32_32x32x16_bf16(vf, __builtin_bit_cast(bf16x8, pwb[s4]), oT[1][d0], 0, 0, 0);
                  }
              __builtin_amdgcn_s_setprio(0); }
        } else
        if (t <= tlast) {
        const LAS unsigned char* buf = lds + cur * AT_BUF;
        f32x16 pa0 = f32x16{}, pa1 = f32x16{}, pb0 = f32x16{}, pb1 = f32x16{};
        if (MODE == 1) {
            const u32x2 mwa = *(const LAS u32x2*)(buf + AT_MSK + (qjbase + (lane_id_nohoist() & 31)) * 8);
            const unsigned wa0 = ~(mwa.x >> (4 * hi)), wa1 = ~(mwa.y >> (4 * hi));
#pragma unroll
            for (int r = 0; r < 16; ++r) { const int bit = 8 * (r >> 2) + (r & 3);
                pa0[r] = __uint_as_float((unsigned)__builtin_amdgcn_sbfe((int)wa0, bit, 1) & 0xff800000u); pa1[r] = __uint_as_float((unsigned)__builtin_amdgcn_sbfe((int)wa1, bit, 1) & 0xff800000u); }
        }
        { const LAS unsigned char* kb = buf + hi * 1024 + r32 * 16;
          __builtin_amdgcn_s_setprio(1);
#pragma unroll
          for (int d0 = 0; d0 < NKS; ++d0) { const bf16x8 a0 = *(const LAS bf16x8*)(kb + d0 * 2048), a1 = *(const LAS bf16x8*)(kb + d0 * 2048 + 512);
              if (MODE == 1 && d0 == 0) {
                  pb0 = __builtin_amdgcn_mfma_f32_32x32x16_bf16(a0, qf[1][d0], pa0, 0, 0, 0); pb1 = __builtin_amdgcn_mfma_f32_32x32x16_bf16(a1, qf[1][d0], pa1, 0, 0, 0);
                  pa0 = __builtin_amdgcn_mfma_f32_32x32x16_bf16(a0, qf[0][d0], pa0, 0, 0, 0); pa1 = __builtin_amdgcn_mfma_f32_32x32x16_bf16(a1, qf[0][d0], pa1, 0, 0, 0);
              } else {
              pa0 = __builtin_amdgcn_mfma_f32_32x32x16_bf16(a0, qf[0][d0], pa0, 0, 0, 0); pa1 = __builtin_amdgcn_mfma_f32_32x32x16_bf16(a1, qf[0][d0], pa1, 0, 0, 0);
              pb0 = __builtin_amdgcn_mfma_f32_32x32x16_bf16(a0, qf[1][d0], pb0, 0, 0, 0); pb1 = __builtin_amdgcn_mfma_f32_32x32x16_bf16(a1, qf[1][d0], pb1, 0, 0, 0); } }
          __builtin_amdgcn_s_setprio(0); }
        if (MODE == 0) {
            if (t * 64 + 63 > tqbase) { const int kb0 = t * 64 + 4 * hi, tqa = tqbase + (lane_id_nohoist() & 31), tqb = tqbaseb + (lane_id_nohoist() & 31);
#pragma unroll
                for (int r = 0; r < 16; ++r) { const int ks = kb0 + (r & 3) + 8 * (r >> 2);
                    if (ks > tqa) pa0[r] = -INFINITY; if (ks + 32 > tqa) pa1[r] = -INFINITY; if (ks > tqb) pb0[r] = -INFINITY; if (ks + 32 > tqb) pb1[r] = -INFINITY; } }
        } else {
#pragma unroll
            for (int c = 0; c < 4; ++c) { const f32x4 k0 = *(const LAS f32x4*)(buf + AT_POS + (4 * hi + 8 * c) * 4), k1 = *(const LAS f32x4*)(buf + AT_POS + (32 + 4 * hi + 8 * c) * 4);
#pragma unroll
                for (int j = 0; j < 4; ++j) { const int r = 4 * c + j;
                    const float d0_ = __builtin_fabsf(pta - k0[j]), d1_ = __builtin_fabsf(pta - k1[j]);
                    pa0[r] = __builtin_fmaf(nsa, d0_, pa0[r]); pa1[r] = __builtin_fmaf(nsa, d1_, pa1[r]);
                    pb0[r] = __builtin_fmaf(nsb, d0_, pb0[r]); pb1[r] = __builtin_fmaf(nsb, d1_, pb1[r]); }
                if (c == 1) __builtin_amdgcn_sched_barrier(0); }
        }
        AT_SOFTMAX(pa0, pa1, oT[0], mrefa, la, firsta);
        AT_SOFTMAX(pb0, pb1, oT[1], mrefb, lb, firstb);
        u32x4 pwa[4], pwb[4];
        AT_PACK(pwa, pa0, pa1)
        AT_PACK(pwb, pb0, pb1)
        { const LAS unsigned char* vbase = buf + AT_KB + vboff;
          __builtin_amdgcn_s_setprio(1);
#pragma unroll
          for (int d0 = 0; d0 < 2; ++d0)
#pragma unroll
              for (int s4 = 0; s4 < 4; ++s4) {
                  const s16x4 vlo = vtr(vbase + d0 * 4096 + s4 * 1024), vhi = vtr(vbase + d0 * 4096 + s4 * 1024 + 512);
                  const bf16x8 vf = (bf16x8){vlo[0], vlo[1], vlo[2], vlo[3], vhi[0], vhi[1], vhi[2], vhi[3]};
                  oT[0][d0] = __builtin_amdgcn_mfma_f32_32x32x16_bf16(vf, __builtin_bit_cast(bf16x8, pwa[s4]), oT[0][d0], 0, 0, 0);
                  oT[1][d0] = __builtin_amdgcn_mfma_f32_32x32x16_bf16(vf, __builtin_bit_cast(bf16x8, pwb[s4]), oT[1][d0], 0, 0, 0);
              }
          __builtin_amdgcn_s_setprio(0); }
        }
        AT_SYNC();
    }
    l_out[0] = la; l_out[1] = lb;
#undef AT_DMA
#undef AT_SOFTMAX
#undef AT_PACK
}
__device__ __forceinline__ void attn_store(const f32x16 (&oT)[2], float l, bf16_t* OAB, float* OSS, const bf16_t* PROJ, size_t tbase, int ch, int ohead) {
    const int ln = lane_id_nohoist(), r32 = ln & 31, hi = ln >> 5;
    const size_t grow = tbase + r32;
    bf16_t* orow = OAB + grow * DM + ch; const bf16_t* szrow = PROJ + proj_off(grow, C_Z + ch) + 4 * hi;
    l = swap32_sum(l);
    const float inv = 1.0f / l;
    float ssq = 0.f;
    u32x2 zz[8];
#pragma unroll
    for (int k = 0; k < 8; ++k) zz[k] = *(const u32x2*)(szrow + k * 128);
#pragma unroll
    for (int d0 = 0; d0 < 2; ++d0)
#pragma unroll
        for (int c = 0; c < 4; ++c) {
            const u32x2 z = zz[4 * d0 + c];
            const float a = oT[d0][4 * c] * inv, b = oT[d0][4 * c + 1] * inv, cc = oT[d0][4 * c + 2] * inv, d = oT[d0][4 * c + 3] * inv;
            ssq += (a * a + b * b) + (cc * cc + d * d);
            *(u32x2*)(orow + 32 * d0 + 8 * c + 4 * hi) = (u32x2){cvtpk(a * bf_lo(z.x), b * bf_hi(z.x)), cvtpk(cc * bf_lo(z.y), d * bf_hi(z.y))};
        }
    ssq = swap32_sum(ssq);
    if (hi == 0) OSS[grow * 16 + ohead] = ssq;
}

__device__ __forceinline__ void mla_prime(int b, int h, int qb, const bf16_t* QB, const bf16_t* KNC, const bf16_t* VBC, const bf16_t* KRC, LAS unsigned char* lds, const int wid, bf16x8 (&qf)[2][6]) {
    const int lane = lane_id(), r32 = lane & 31, hi = lane >> 5;
    const size_t rowbase = (size_t)b * S; const int q0 = qb * 512, ra0 = q0 + 32 * wid, rb0 = q0 + 32 * (15 - wid);
    const size_t hb = ((size_t)(b * 8 + h) * S) * 64;
#pragma unroll
    for (int c = 0; c < 2; ++c) { const bf16_t* qrow = QB + (rowbase + (c ? rb0 : ra0) + r32) * NQB;
#pragma unroll
      for (int d0 = 0; d0 < 4; ++d0) qf[c][d0] = *(const bf16x8*)(qrow + h * 64 + d0 * 16 + hi * 8);
#pragma unroll
      for (int d0 = 4; d0 < 6; ++d0) qf[c][d0] = *(const bf16x8*)(qrow + 512 + h * 32 + (d0 - 4) * 16 + hi * 8); }
    attn_prime<0>(KNC + hb + wid * 512, KRC + rowbase * 32 + (wid & 3) * 512, VBC + hb + wid * 512, nullptr, nullptr, lds, wid);
}
__device__ __forceinline__ void mla_unit(int b, int h, int qb, int qb_next, bf16x8 (&qf)[2][6], const bf16_t* QB, const bf16_t* PROJ, const bf16_t* KNC, const bf16_t* VBC, const bf16_t* KRC, bf16_t* OAB, float* OSS, LAS unsigned char* lds, const int wid) {
    const int lane = lane_id();
    const size_t rowbase = (size_t)b * S; const int q0 = qb * 512, ra0 = q0 + 32 * wid, rb0 = q0 + 32 * (15 - wid);
    const size_t hb = ((size_t)(b * 8 + h) * S) * 64;
    f32x16 oT[2][2]; float l[2];
    attn_core<0>(qf, 8 * (qb + 1), (ra0 + 31) >> 6, ra0, (rb0 + 31) >> 6, rb0, KNC + hb + wid * 512, KRC + rowbase * 32 + (wid & 3) * 512, VBC + hb + wid * 512,
                 nullptr, nullptr, 0.f, 0.f, 0.f, 0, lds, wid, lane, oT, l);
    if (qb_next >= 0) mla_prime(b, h, qb_next, QB, KNC, VBC, KRC, lds, wid, qf);
    attn_store(oT[0], l[0], OAB, OSS, PROJ, rowbase + ra0, 512 + h * 64, 8 + h);
    attn_store(oT[1], l[1], OAB, OSS, PROJ, rowbase + rb0, 512 + h * 64, 8 + h);
}
__device__ __forceinline__ void dsa_prime(int b, int g, int qb, const bf16_t* PROJ, const bf16_t* KAC, const bf16_t* VAC, const unsigned long long* MASKT, const float* POSF, LAS unsigned char* lds, const int wid,
                                          bf16x8 (&qf)[2][6], float& pta) {
    const int lane = lane_id(), r32 = lane & 31, hi = lane >> 5;
    const size_t rowbase = (size_t)b * S; const int q0 = qb * 128, qblk = wid >> 1, head0 = 4 * g + 2 * (wid & 1), tqa = q0 + 32 * qblk + r32;
    const size_t gb = ((size_t)(b * 2 + g) * S) * 64;
#pragma unroll
    for (int c = 0; c < 2; ++c) { const bf16_t* qrow = PROJ + proj_off(rowbase + tqa, C_QA + (head0 + c) * 64 + hi * 8);
#pragma unroll
      for (int d0 = 0; d0 < 4; ++d0) qf[c][d0] = *(const bf16x8*)(qrow + d0 * 256);
      qf[c][4] = qf[c][0]; qf[c][5] = qf[c][0]; }
    pta = POSF[rowbase + tqa];
    attn_prime<1>(KAC + gb + wid * 512, nullptr, VAC + gb + wid * 512, MASKT + ((size_t)(b * 64 + 2 * qb) * 64) * 64, POSF + rowbase, lds, wid);
}
__device__ __forceinline__ void dsa_unit(int b, int g, int qb, int qb_next, bf16x8 (&qf)[2][6], float& pta_io, const bf16_t* PROJ, const bf16_t* KAC, const bf16_t* VAC, const unsigned long long* MASKT, const float* POSF,
                                         bf16_t* OAB, float* OSS, LAS unsigned char* lds, const int wid) {
    const int lane = lane_id();
    const size_t rowbase = (size_t)b * S; const int q0 = qb * 128, qblk = wid >> 1, head0 = 4 * g + 2 * (wid & 1);
    const size_t gb = ((size_t)(b * 2 + g) * S) * 64;
    const float pta = pta_io;
    const float nsa = -__builtin_amdgcn_exp2f(-(float)(head0 + 1)) * LOG2E, nsb = 0.5f * nsa;
    f32x16 oT[2][2]; float l[2];
    attn_core<1>(qf, 2 * (qb + 1), (q0 + 32 * qblk + 31) >> 6, q0 + 32 * qblk, (q0 + 32 * qblk + 31) >> 6, q0 + 32 * qblk, KAC + gb + wid * 512, nullptr, VAC + gb + wid * 512,
                 MASKT + ((size_t)(b * 64 + 2 * qb) * 64) * 64, POSF + rowbase, pta, nsa, nsb, 32 * qblk, lds, wid, lane, oT, l);
    if (qb_next >= 0) dsa_prime(b, g, qb_next, PROJ, KAC, VAC, MASKT, POSF, lds, wid, qf, pta_io);
    attn_store(oT[0], l[0], OAB, OSS, PROJ, rowbase + q0 + 32 * qblk, head0 * 64, head0);
    attn_store(oT[1], l[1], OAB, OSS, PROJ, rowbase + q0 + 32 * qblk, (head0 + 1) * 64, head0 + 1);
}

__device__ __forceinline__ int wave_sum_i(int x) {
    x += __builtin_amdgcn_update_dpp(0, x, 0xB1, 0xf, 0xf, true);
    x += __builtin_amdgcn_update_dpp(0, x, 0x4E, 0xf, 0xf, true);
    x += __builtin_amdgcn_update_dpp(0, x, 0x141, 0xf, 0xf, true);
    x += __builtin_amdgcn_update_dpp(0, x, 0x140, 0xf, 0xf, true);
    { auto r = __builtin_amdgcn_permlane16_swap((unsigned)x, (unsigned)x, false, false); x = (int)(r[0] + r[1]); }
    { auto r = __builtin_amdgcn_permlane32_swap((unsigned)x, (unsigned)x, false, false); x = (int)(r[0] + r[1]); }
    return __builtin_amdgcn_readfirstlane(x);
}
__device__ __forceinline__ float wave_max_f(float x) {
    x = fmaxf(x, __uint_as_float(__builtin_amdgcn_update_dpp(0, __float_as_uint(x), 0xB1, 0xf, 0xf, true)));
    x = fmaxf(x, __uint_as_float(__builtin_amdgcn_update_dpp(0, __float_as_uint(x), 0x4E, 0xf, 0xf, true)));
    x = fmaxf(x, __uint_as_float(__builtin_amdgcn_update_dpp(0, __float_as_uint(x), 0x141, 0xf, 0xf, true)));
    x = fmaxf(x, __uint_as_float(__builtin_amdgcn_update_dpp(0, __float_as_uint(x), 0x140, 0xf, 0xf, true)));
    { auto r = __builtin_amdgcn_permlane16_swap(__float_as_uint(x), __float_as_uint(x), false, false); x = fmaxf(__uint_as_float(r[0]), __uint_as_float(r[1])); }
    { auto r = __builtin_amdgcn_permlane32_swap(__float_as_uint(x), __float_as_uint(x), false, false); x = fmaxf(__uint_as_float(r[0]), __uint_as_float(r[1])); }
    return __uint_as_float(__builtin_amdgcn_readfirstlane(__float_as_uint(x)));
}
typedef short s16x2_t __attribute__((ext_vector_type(2)));
#define SEL_P4(k0, k1, k2, k3) \
    "v_pk_sub_u16 %2, %" #k0 ", %14 clamp\n\tv_pk_sub_u16 %3, %" #k1 ", %14 clamp\n\tv_pk_sub_u16 %4, %" #k2 ", %14 clamp\n\tv_pk_sub_u16 %5, %" #k3 ", %14 clamp\n\t" \
    "v_pk_min_u16 %2, %2, %15\n\tv_pk_min_u16 %3, %3, %15\n\tv_pk_min_u16 %4, %4, %15\n\tv_pk_min_u16 %5, %5, %15\n\t" \
    "v_pk_add_u16 %0, %0, %2\n\tv_pk_add_u16 %1, %1, %3\n\tv_pk_add_u16 %0, %0, %4\n\tv_pk_add_u16 %1, %1, %5\n\t"
#define SEL_P8_ASM(a0, a1, K, base, t1, one2) do { unsigned q0_, q1_, q2_, q3_; asm volatile( \
    SEL_P4(6, 7, 8, 9) SEL_P4(10, 11, 12, 13) \
    : "+v"(a0), "+v"(a1), "=&v"(q0_), "=&v"(q1_), "=&v"(q2_), "=&v"(q3_) \
    : "v"(K[(base) + 0]), "v"(K[(base) + 1]), "v"(K[(base) + 2]), "v"(K[(base) + 3]), "v"(K[(base) + 4]), "v"(K[(base) + 5]), "v"(K[(base) + 6]), "v"(K[(base) + 7]), "s"(t1), "s"(one2)); } while (0)
__device__ __forceinline__ int wave_sum_pk(unsigned x) {
    x += (unsigned)__builtin_amdgcn_update_dpp(0, (int)x, 0xB1, 0xf, 0xf, true);
    x += (unsigned)__builtin_amdgcn_update_dpp(0, (int)x, 0x4E, 0xf, 0xf, true);
    x += (unsigned)__builtin_amdgcn_update_dpp(0, (int)x, 0x141, 0xf, 0xf, true);
    x += (unsigned)__builtin_amdgcn_update_dpp(0, (int)x, 0x140, 0xf, 0xf, true);
    x += (unsigned)__builtin_amdgcn_update_dpp(0, (int)x, 0x142, 0xa, 0xf, false);
    x += (unsigned)__builtin_amdgcn_update_dpp(0, (int)x, 0x143, 0xc, 0xf, false);
    const unsigned r = (unsigned)__builtin_amdgcn_readlane((int)x, 63);
    return (int)((r & 0xffffu) + (r >> 16));
}
__device__ __forceinline__ unsigned pk_min_u16(unsigned a, unsigned b) { unsigned d; asm("v_pk_min_u16 %0, %1, %2" : "=v"(d) : "v"(a), "v"(b)); return d; }
__device__ __forceinline__ unsigned wave_min_u(unsigned x) {
    { const unsigned y = (unsigned)__builtin_amdgcn_update_dpp(0, (int)x, 0xB1, 0xf, 0xf, true); x = x < y ? x : y; }
    { const unsigned y = (unsigned)__builtin_amdgcn_update_dpp(0, (int)x, 0x4E, 0xf, 0xf, true); x = x < y ? x : y; }
    { const unsigned y = (unsigned)__builtin_amdgcn_update_dpp(0, (int)x, 0x141, 0xf, 0xf, true); x = x < y ? x : y; }
    { const unsigned y = (unsigned)__builtin_amdgcn_update_dpp(0, (int)x, 0x140, 0xf, 0xf, true); x = x < y ? x : y; }
    { auto r = __builtin_amdgcn_permlane16_swap(x, x, false, false); x = r[0] < r[1] ? r[0] : r[1]; }
    { auto r = __builtin_amdgcn_permlane32_swap(x, x, false, false); x = r[0] < r[1] ? r[0] : r[1]; }
    return (unsigned)__builtin_amdgcn_readfirstlane((int)x);
}
__device__ __forceinline__ unsigned long long select_row(int t, const LAS unsigned* sc, int lane) {
    const int n = t + 1;
    if (n <= KTOP) {
        const int cnt = n - 64 * lane;
        return cnt >= 64 ? ~0ull : (cnt <= 0 ? 0ull : ((1ull << cnt) - 1ull));
    }
    const int nw = (n + 127) >> 7;
    unsigned kv[32];
#define SEL_LD8(base) _Pragma("unroll") for (int j = (base); j < (base) + 8; ++j) { const unsigned h_ = sc[64 * j + lane]; \
        const unsigned m_ = __builtin_bit_cast(unsigned, __builtin_bit_cast(s16x2_t, h_) >> 15) | 0x80008000u; kv[j] = h_ ^ m_; }
#define SEL_Z8(base) _Pragma("unroll") for (int j = (base); j < (base) + 8; ++j) kv[j] = 0u;
    SEL_LD8(0)
    if (nw > 8) { SEL_LD8(8) } else { SEL_Z8(8) }
    if (nw > 16) { SEL_LD8(16) } else { SEL_Z8(16) }
    if (nw > 24) { SEL_LD8(24) } else { SEL_Z8(24) }
#undef SEL_LD8
#undef SEL_Z8
    const int nl = n - lane;
#define SEL_MK8(base) _Pragma("unroll") for (int j = (base); j < (base) + 8; ++j) { const unsigned ml_ = (128 * j < nl) ? 0xffffu : 0u, mh_ = (128 * j + 64 < nl) ? 0xffff0000u : 0u; kv[j] &= (ml_ | mh_); }
    if (nw > 8) { if (nw > 16) { if (nw > 24) { SEL_MK8(24) } else { SEL_MK8(16) } } else { SEL_MK8(8) } } else { SEL_MK8(0) }
#undef SEL_MK8
    const unsigned one2 = 0x00010001u;
#define SEL_COUNT(T) do { unsigned a0_ = 0, a1_ = 0; const unsigned t1_ = (unsigned)((T) - 1) * 0x10001u; SEL_P8_ASM(a0_, a1_, kv, 0, t1_, one2); \
        if (nw > 8) { SEL_P8_ASM(a0_, a1_, kv, 8, t1_, one2); } if (nw > 16) { SEL_P8_ASM(a0_, a1_, kv, 16, t1_, one2); } if (nw > 24) { SEL_P8_ASM(a0_, a1_, kv, 24, t1_, one2); } \
        c = wave_sum_pk(a0_ + a1_); } while (0)
    int c, lo = 0x0400, hi = 0xFC00, chi = 0, theta = 0; bool exact = false;
#pragma unroll 1
    while (hi - lo > 1) {
        const int mid = (lo + hi) >> 1;
        SEL_COUNT(mid);
        if (c == KTOP) { exact = true; theta = mid; break; }
        if (c > KTOP) lo = mid; else { hi = mid; chi = c; }
    }
#undef SEL_COUNT
    unsigned long long myw = 0ull;
    {   const unsigned th = exact ? (unsigned)theta : (unsigned)lo + 1u, thh = th << 16;
#define SEL_OUT8(base) _Pragma("unroll") for (int j = (base); j < (base) + 8; ++j) { const unsigned long long m0_ = __ballot((kv[j] & 0xffffu) >= th); if (lane == 2 * j) myw = m0_; \
            const unsigned long long m1_ = __ballot(kv[j] >= thh); if (lane == 2 * j + 1) myw = m1_; }
        SEL_OUT8(0) if (nw > 8) { SEL_OUT8(8) } if (nw > 16) { SEL_OUT8(16) } if (nw > 24) { SEL_OUT8(24) }
#undef SEL_OUT8
    }
    if (!exact) {
        const unsigned tt = (unsigned)lo * 0x10001u, one2v = 0x00010001u;
        unsigned bml = 0u, bmh = 0u;
#define SEL_EQ8(base) _Pragma("unroll") for (int j = (base); j < (base) + 8; ++j) { const unsigned e_ = pk_min_u16(kv[j] ^ tt, one2v) ^ one2v;        \
            const unsigned t2_ = (e_ >> 15) | (e_ & 1u); if (j < 16) bml |= t2_ << (2 * (j & 15)); else bmh |= t2_ << (2 * (j & 15)); }
        SEL_EQ8(0) if (nw > 8) { SEL_EQ8(8) } if (nw > 16) { SEL_EQ8(16) } if (nw > 24) { SEL_EQ8(24) }
#undef SEL_EQ8
        const int need = KTOP - chi;
#pragma unroll 1
        for (int r = 0; r < need; ++r) {
            const unsigned cl = (unsigned)__builtin_ctz(bml | 0x80000000u), ch = 32u + (unsigned)__builtin_ctz(bmh | 0x80000000u);
            const unsigned cand = bml ? cl : (bmh ? ch : 0xffffu);
            const unsigned m = wave_min_u(cand * 64u + (unsigned)lane);
            const unsigned cs = m >> 6, ls = m & 63u;
            if ((unsigned)lane == ls) { if (cs < 32u) bml &= ~(1u << cs); else bmh &= ~(1u << (cs - 32u)); }
            if ((unsigned)lane == cs) myw |= 1ull << ls;
        }
    }
    return myw;
}

#define IDX_BAR() asm volatile("s_waitcnt lgkmcnt(0)\n\ts_barrier" ::: "memory")
#define IDX_BARV() asm volatile("s_waitcnt vmcnt(0) lgkmcnt(0)\n\ts_barrier" ::: "memory")
constexpr int IDX_QST = 131072;
__device__ __forceinline__ float fma_mix_lo(unsigned w2, float r, float s) { asm("v_fma_mix_f32 %0, %1, %2, %0 op_sel:[0,0,0] op_sel_hi:[1,0,0]" : "+v"(s) : "v"(w2), "v"(r)); return s; }
__device__ __forceinline__ float fma_mix_hi(unsigned w2, float r, float s) { asm("v_fma_mix_f32 %0, %1, %2, %0 op_sel:[1,0,0] op_sel_hi:[1,0,0]" : "+v"(s) : "v"(w2), "v"(r)); return s; }
__device__ __forceinline__ unsigned bf2_to_h2(unsigned u) { return __builtin_bit_cast(unsigned, __builtin_amdgcn_cvt_pkrtz(bf_lo(u), bf_hi(u))); }
__device__ __forceinline__ void idx_phase(int b, int sdeal, const bf16_t* PROJ, const bf16_t* IKC, unsigned long long* MASK, LAS unsigned char* lds, const int wid) {
    const int lane = lane_id(), r32 = lane & 31, hi = lane >> 5;
    const size_t rowbase = (size_t)b * S;
    LAS _Float16* SC = (LAS _Float16*)lds;
    const int qi = 2 * ((r32 >> 2) & 1) + (r32 >> 4), hd = (r32 & 3) + 4 * ((r32 >> 3) & 1);
    const int qcol = C_IQ + hd * 64 + hi * 8;
    const bf16_t* kbase = IKC + (rowbase + wid * 32) * 64 + hi * 256 + r32 * 8;
    const int scl = ((wid >> 2) * 64 + (wid & 1) * 32 + r32) * 2 + ((wid >> 1) & 1);
    bf16x8 af[4][4]; u32x4 wv[4][2]; bf16x8 f0[4], f1[4], f2[4];
#define IDX_J(u) (16 * (u) + (((u) & 1) ? 15 - sdeal : sdeal))
#define IDX_CNT(t0) ((((t0) + 16 + 31) >> 5) - wid + 7) >> 3
#define IDX_LOAD(dst, i, cnt) do { const int _i = ((i) < (cnt)) ? (i) : ((cnt) - 1); const bf16_t* _p = kbase + (size_t)_i * (256 * 64); \
        _Pragma("unroll") for (int d0 = 0; d0 < 4; ++d0) dst[d0] = *(const bf16x8*)(_p + d0 * 512); } while (0)
#define IDX_PREFETCH(t0) do { if ((t0) + 16 > KTOP) { const int _c = IDX_CNT(t0); const unsigned _l = (unsigned)lane_id_nohoist(); \
        _Pragma("unroll") for (int pp = 0; pp < 2; ++pp) { const int pi_ = 2 * wid + pp, mt_ = pi_ >> 2, d0_ = pi_ & 3; \
            const int r32_ = _l & 31, hi_ = _l >> 5, qi_ = 2 * ((r32_ >> 2) & 1) + (r32_ >> 4), hd_ = (r32_ & 3) + 4 * ((r32_ >> 3) & 1); \
            dma16(PROJ, (unsigned)((proj_off(rowbase + (t0) + 4 * mt_ + qi_, C_IQ + hd_ * 64 + hi_ * 8) + (size_t)d0_ * 256) * 2), (unsigned)__builtin_amdgcn_readfirstlane((int)(qst0 + pi_ * 1024))); } \
        if (wid == 7) dma4(PROJ, (unsigned)(proj_off(rowbase + (t0) + (_l >> 2), C_IW) * 2 + (_l & 3u) * 4u), (unsigned)__builtin_amdgcn_readfirstlane((int)(qst0 + 16384))); \
        IDX_LOAD(f0, 0, _c); IDX_LOAD(f1, 1, _c); } } while (0)
#define IDX_FETCHQ() do { \
        _Pragma("unroll") for (int mt = 0; mt < 4; ++mt) { \
            _Pragma("unroll") for (int d0 = 0; d0 < 4; ++d0) af[mt][d0] = *(const LAS bf16x8*)(lds + IDX_QST + (mt * 4 + d0) * 1024 + lane * 16); \
            _Pragma("unroll") for (int e = 0; e < 2; ++e) wv[mt][e] = *(const LAS u32x4*)(lds + IDX_QST + 16384 + (4 * mt + 2 * hi + e) * 16); } } while (0)
#define IDX_S8(acc, e, mt) do { float s = 0.f; \
        s = fma_mix_lo(wh[mt][e][0], relu_f(acc[8 * (e) + 0]), s); s = fma_mix_hi(wh[mt][e][0], relu_f(acc[8 * (e) + 1]), s); \
        s = fma_mix_lo(wh[mt][e][1], relu_f(acc[8 * (e) + 2]), s); s = fma_mix_hi(wh[mt][e][1], relu_f(acc[8 * (e) + 3]), s); \
        s = fma_mix_lo(wh[mt][e][2], relu_f(acc[8 * (e) + 4]), s); s = fma_mix_hi(wh[mt][e][2], relu_f(acc[8 * (e) + 5]), s); \
        s = fma_mix_lo(wh[mt][e][3], relu_f(acc[8 * (e) + 6]), s); s = fma_mix_hi(wh[mt][e][3], relu_f(acc[8 * (e) + 7]), s); \
        SC[(4 * (mt) + 2 * hi + (e)) * 4096 + 256 * (i_) + scl] = (_Float16)s; } while (0)
#define IDX_COMP(src, i) do { const int i_ = (i); _Pragma("unroll") for (int mp = 0; mp < 2; ++mp) { f32x16 a0 = f32x16{}, a1 = f32x16{}; \
        _Pragma("unroll") for (int d0 = 0; d0 < 4; ++d0) { a0 = __builtin_amdgcn_mfma_f32_32x32x16_bf16(af[2 * mp][d0], src[d0], a0, 0, 0, 0); a1 = __builtin_amdgcn_mfma_f32_32x32x16_bf16(af[2 * mp + 1][d0], src[d0], a1, 0, 0, 0); } \
        IDX_S8(a0, 0, 2 * mp); IDX_S8(a0, 1, 2 * mp); IDX_S8(a1, 0, 2 * mp + 1); IDX_S8(a1, 1, 2 * mp + 1); } } while (0)
    const unsigned qst0 = (unsigned)(uintptr_t)lds + IDX_QST;
    { const int t0 = 16 * IDX_J(0); IDX_PREFETCH(t0); }
    IDX_BARV();
    for (int u = 0; u < 16; ++u) {
        const int t0 = 16 * IDX_J(u);
        if (t0 + 16 > KTOP) {
            IDX_FETCHQ();
            unsigned wh[4][2][4];
#pragma unroll
            for (int mt = 0; mt < 4; ++mt)
#pragma unroll
                for (int e = 0; e < 2; ++e) { wh[mt][e][0] = bf2_to_h2(wv[mt][e].x); wh[mt][e][1] = bf2_to_h2(wv[mt][e].y); wh[mt][e][2] = bf2_to_h2(wv[mt][e].z); wh[mt][e][3] = bf2_to_h2(wv[mt][e].w); }
            const int cnt = IDX_CNT(t0);
            for (int i = 0; i < cnt; i += 3) {
                IDX_LOAD(f2, i + 2, cnt); IDX_COMP(f0, i);
                if (i + 1 < cnt) { IDX_LOAD(f0, i + 3, cnt); IDX_COMP(f1, i + 1); }
                if (i + 2 < cnt) { IDX_LOAD(f1, i + 4, cnt); IDX_COMP(f2, i + 2); }
            }
        }
        IDX_BAR();
        if (u + 1 < 16) { const int t1 = 16 * IDX_J(u + 1); IDX_PREFETCH(t1); }
        unsigned long long mw0 = 0ull, mw1 = 0ull;
#pragma unroll 1
        for (int rr = 0; rr < 2; ++rr) { const int q = 8 * rr + wid;
            const unsigned long long w_ = select_row(t0 + q, (const LAS unsigned*)(SC + q * 4096), lane); if (rr == 0) mw0 = w_; else mw1 = w_; }
        { const int ta = t0 + wid, tb = t0 + 8 + wid;
          MASK[((size_t)(b * 64 + (ta >> 6)) * 64) * 64 + (ta & 63) + (size_t)lane * 64] = mw0;
          MASK[((size_t)(b * 64 + (tb >> 6)) * 64) * 64 + (tb & 63) + (size_t)lane * 64] = mw1; }
        IDX_BARV();
    }
#undef IDX_J
#undef IDX_CNT
#undef IDX_LOAD
#undef IDX_PREFETCH
#undef IDX_FETCHQ
#undef IDX_S8
#undef IDX_COMP
}

__device__ __forceinline__ void grid_bar(unsigned* ctr, unsigned target, int wave) {
    asm volatile("s_waitcnt vmcnt(0) lgkmcnt(0)" ::: "memory");
    __syncthreads();
    if (wave == 0 && lane_id() == 0) {
        __builtin_amdgcn_fence(__ATOMIC_RELEASE, "agent");
        asm volatile("s_waitcnt vmcnt(0)" ::: "memory");
        __hip_atomic_fetch_add(ctr, 1u, __ATOMIC_RELAXED, __HIP_MEMORY_SCOPE_AGENT);
        unsigned spins = 0;
        while (__hip_atomic_load(ctr, __ATOMIC_RELAXED, __HIP_MEMORY_SCOPE_AGENT) < target) { __builtin_amdgcn_s_sleep(2); if (++spins > (1u << 26)) break; }
        __builtin_amdgcn_fence(__ATOMIC_ACQUIRE, "agent");
        asm volatile("s_waitcnt vmcnt(0)" ::: "memory");
    }
    __syncthreads();
}

struct Args { const float* x; const int* pos; const float* w_in; const float* g_q; const float* w_uq; const float* g_kv; const float* w_ukv; const float* g_oa; const float* g_ob;
              const float* w_out; const float* ln_g; const float* ln_b; float* out; unsigned char* ws; int ph_lo, ph_hi; };

__device__ __forceinline__ void src_map(int kind, int n, int& src, float& sc) {
    sc = 1.f;
    if (kind == 0) {
        if (n < 512) { src = n; sc = QA_SCALE; }
        else if (n < 1280) src = n;
        else if (n < 1664) src = n - 1280 + 1352;
        else if (n < 1920) src = n - 1664 + 1736;
        else if (n < 1984) src = n - 1920 + 1280;
        else if (n < 2016) { const int e = n - 1984; src = 1992 + (e >> 1) + 16 * (e & 1); }
        else if (n < 2024) { src = n - 2016 + 1344; sc = IW_SCALE; }
        else if (n < 2048) src = -1;
        else src = n - 2048 + 2024;
    } else if (kind == 1) {
        if (n < 512) { const int h = n >> 6, d = n & 63; src = h * 96 + d; }
        else { const int e = n - 512, h = e >> 5, r = e & 31; src = h * 96 + 64 + (r >> 1) + 16 * (r & 1); }
        sc = QB_SCALE;
    } else if (kind == 2) {
        if (n < 512) { const int h = n >> 6, d = n & 63; src = h * 128 + d; }
        else { const int e = n - 512, h = e >> 6, d = e & 63; src = h * 128 + 64 + d; }
    } else src = n;
}
__device__ __forceinline__ void p0_transpose_item(const float* W, int K, int Nsrc, int Ndst, bf16_t* WT, int kind, const float* ks0, const float* ks1, LAS float* scr, int item, int lane) {
    const int nblk = Ndst / 32, kb = item / nblk, nb = item % nblk, k0 = 64 * kb, n0 = 32 * nb;
    int src; float sc; src_map(kind, n0 + (lane & 31), src, sc);
    const int srcc = src >= 0 ? src : 0; const float scm = src >= 0 ? sc : 0.f;
    const float* ksb = ks0 ? ((k0 < 512 || !ks1) ? ks0 + k0 : ks1 + (k0 - 512)) : nullptr;
    float wv_[32], kv_[32];
    const float* wp_ = W + (size_t)(k0 + (lane >> 5)) * Nsrc + srcc;
#pragma unroll
    for (int i = 0; i < 32; ++i) wv_[i] = wp_[(size_t)(2 * i) * Nsrc];
    if (ksb) {
#pragma unroll
        for (int i = 0; i < 32; ++i) kv_[i] = ksb[2 * i + (lane >> 5)];
    } else {
#pragma unroll
        for (int i = 0; i < 32; ++i) kv_[i] = 1.f;
    }
#pragma unroll
    for (int i = 0; i < 32; ++i) scr[(2 * i + (lane >> 5)) * 33 + (lane & 31)] = wv_[i] * (scm * kv_[i]);
    asm volatile("s_waitcnt lgkmcnt(0)" ::: "memory");
    const int c = lane & 7;
#pragma unroll
    for (int jj = 0; jj < 4; ++jj) { const int n = (lane >> 3) + 8 * jj; const LAS float* s = scr + (8 * c) * 33 + n;
        u32x4 o; o.x = cvt_pk_bf16(s[0 * 33], s[1 * 33]); o.y = cvt_pk_bf16(s[2 * 33], s[3 * 33]); o.z = cvt_pk_bf16(s[4 * 33], s[5 * 33]); o.w = cvt_pk_bf16(s[6 * 33], s[7 * 33]);
        *(u32x4*)(WT + (size_t)(n0 + n) * K + k0 + 8 * c) = o; }
    asm volatile("s_waitcnt lgkmcnt(0)" ::: "memory");
}
__device__ __forceinline__ float wave_sum(float v) {
#pragma unroll
    for (int o = 1; o < 64; o <<= 1) v += __shfl_xor(v, o);
    return v;
}

__global__ void __launch_bounds__(512, 2) hybrid_fwd(Args a) {
    extern __shared__ __attribute__((aligned(16))) unsigned char lds_raw[];
    LAS unsigned char* lds = (LAS unsigned char*)lds_raw;
    const int wave = __builtin_amdgcn_readfirstlane(threadIdx.x >> 6);
#define lane lane_id()
#define tid (wave * 64 + lane_id())
    const int G = gridDim.x, bx = blockIdx.x, vcu = (G % 8 == 0) ? (bx % 8) * (G / 8) + bx / 8 : bx;
    unsigned char* ws = a.ws;
    bf16_t* W1T = (bf16_t*)(ws + WS_W1T); bf16_t* WUQT = (bf16_t*)(ws + WS_WUQT); bf16_t* WUKVT = (bf16_t*)(ws + WS_WUKVT); bf16_t* WOT = (bf16_t*)(ws + WS_WOT);
    float* CS = (float*)(ws + WS_CS); float* SSQ = (float*)(ws + WS_SSQ); float* POSF = (float*)(ws + WS_POSF); float* OSS = (float*)(ws + WS_OSS); float* STATS = (float*)(ws + WS_STATS);
    bf16_t* XB = (bf16_t*)(ws + WS_XB); bf16_t* PROJ = (bf16_t*)(ws + WS_PROJ); bf16_t* QB = (bf16_t*)(ws + WS_QB); bf16_t* KVB = (bf16_t*)(ws + WS_KVB);
    bf16_t* IKC = (bf16_t*)(ws + WS_IKC); bf16_t* KRC = (bf16_t*)(ws + WS_KRC); bf16_t* KAC = (bf16_t*)(ws + WS_KAC); bf16_t* VAC = (bf16_t*)(ws + WS_VAC);
    bf16_t* CQC = (bf16_t*)(ws + WS_CQC); bf16_t* CKVC = (bf16_t*)(ws + WS_CKVC); bf16_t* KNC = (bf16_t*)(ws + WS_KNC); bf16_t* VBC = (bf16_t*)(ws + WS_VBC);
    unsigned long long* MASK = (unsigned long long*)(ws + WS_MASK); bf16_t* OAB = (bf16_t*)(ws + WS_OAB); bf16_t* Y = (bf16_t*)(ws + WS_Y);
    const int lo = a.ph_lo, hi_ph = a.ph_hi;
#define IN(k) (lo <= (k) && (k) < hi_ph)
#define SEAM(k) do { if (IN(k) && IN((k) + 1)) { if ((k) == 0) cg::this_grid().sync(); else { ++nbar; grid_bar((unsigned*)ws, nbar * (unsigned)G, wave); } } } while (0)
    unsigned nbar = 0;
#define NOSEAM(k) do { if (IN(k) && IN((k) + 1)) { __syncthreads(); } } while (0)
    const int gw = vcu * 8 + wave, NGW = G * 8;
#define gt ((size_t)vcu * 512 + tid)
    const size_t NGT = (size_t)G * 512;

    if (IN(0)) {
        LAS float* scr = (LAS float*)(lds + wave * 16384);
        constexpr int I1 = (1024 / 64) * (NPROJ / 32), I2 = (384 / 64) * (NQB / 32), I3 = (256 / 64) * (NKVB / 32), I4 = (1024 / 64) * (1024 / 32);
        for (int it = gw; it < I1 + I2 + I3 + I4; it += NGW) {
            int r = it;
            if (r < I1) { p0_transpose_item(a.w_in, 1024, D_IN, NPROJ, W1T, 0, nullptr, nullptr, scr, r, lane); continue; } r -= I1;
            if (r < I2) { p0_transpose_item(a.w_uq, 384, NQB, NQB, WUQT, 1, a.g_q, nullptr, scr, r, lane); continue; } r -= I2;
            if (r < I3) { p0_transpose_item(a.w_ukv, 256, NKVB, NKVB, WUKVT, 2, a.g_kv, nullptr, scr, r, lane); continue; } r -= I3;
            p0_transpose_item(a.w_out, 1024, 1024, 1024, WOT, 3, a.g_oa, a.g_ob, scr, r, lane);
        }
        for (size_t c = gt; c < (size_t)M * 256; c += 8 * NGT) {
            f32x4 v[8];
#pragma unroll
            for (int k = 0; k < 8; ++k) v[k] = __builtin_nontemporal_load((const f32x4*)(a.x + (c + k * NGT) * 4));
#pragma unroll
            for (int k = 0; k < 8; ++k) *(u32x2*)(XB + (c + k * NGT) * 4) = (u32x2){cvt_pk_bf16(v[k][0], v[k][1]), cvt_pk_bf16(v[k][2], v[k][3])};
        }
        int pq[8];
#pragma unroll
        for (int j = 0; j < 8; ++j) { const size_t i_ = gt + (size_t)j * NGT; pq[j] = (i_ < (size_t)M * 16) ? a.pos[i_ >> 4] : 0; }
#pragma unroll
        for (int j = 0; j < 8; ++j) { const size_t i = gt + (size_t)j * NGT; if (i >= (size_t)M * 16) continue;
            const size_t t = i >> 4; const int k = (int)(i & 15);
            const float p = (float)pq[j];
            const float invf = exp2f(-(float)k * 0.8304820237218406f);
            const float ang = p * invf;
            const double ad = (double)ang;
            const double kk = rint(ad * 0.15915494309189535);
            const double r = fma(-kk, 6.283185307179586, ad) - kk * 2.4492935982947064e-16;
            const double r2 = r * r;
            double sn = -8.2206352466243297e-18; sn = fma(sn, r2, 2.8114572543455206e-15); sn = fma(sn, r2, -7.6471637318198165e-13); sn = fma(sn, r2, 1.6059043836821613e-10);
            sn = fma(sn, r2, -2.5052108385441720e-08); sn = fma(sn, r2, 2.7557319223985893e-06); sn = fma(sn, r2, -1.9841269841269841e-04); sn = fma(sn, r2, 8.3333333333333332e-03);
            sn = fma(sn, r2, -1.6666666666666666e-01); sn = fma(sn * r2, r, r);
            double cn = 4.1103176233121648e-19; cn = fma(cn, r2, -1.5619206968586226e-16); cn = fma(cn, r2, 4.7794773323873853e-14); cn = fma(cn, r2, -1.1470745597729725e-11);
            cn = fma(cn, r2, 2.0876756987868099e-09); cn = fma(cn, r2, -2.7557319223985888e-07); cn = fma(cn, r2, 2.4801587301587302e-05); cn = fma(cn, r2, -1.3888888888888889e-03);
            cn = fma(cn, r2, 4.1666666666666664e-02); cn = fma(cn, r2, -0.5); cn = fma(cn, r2, 1.0);
            CS[t * 32 + k] = (float)cn; CS[t * 32 + 16 + k] = (float)sn;
            if (k == 0) POSF[t] = p;
        }
    }
    SEAM(0);
    if (IN(1)) {
        pg8::Gemm g{XB, W1T, M, NPROJ, 1024, 1024}; pg8::StaticOrder So; So.init(M, NPROJ, G, bx);
        EpiProj E{PROJ, CS, SSQ, IKC, KRC, KAC, VAC, CQC, CKVC};
        pg8::gemm_phase<EpiProj>(lds, g, So, E, wave);
    }
    SEAM(1);
    if (IN(2)) {
        { pg8::Gemm g{CQC, WUQT, M, NQB, 384, 384}; pg8::StaticOrder So; So.init(M, NQB, G, bx);
          EpiUp E{QB, NQB, SSQ, 0, 3, 1.0f / 384.0f, CS, 2, nullptr, nullptr};
          pg8::gemm_phase<EpiUp>(lds, g, So, E, wave); }
        { pg8::Gemm g{CKVC, WUKVT, M, NKVB, 256, 256}; pg8::StaticOrder So; So.init(M, NKVB, G, bx);
          EpiUp E{KVB, NKVB, SSQ, 12, 2, 1.0f / 256.0f, CS, -1, KNC, VBC};
          pg8::gemm_phase<EpiUp>(lds, g, So, E, wave); }
    }
    NOSEAM(2);
    if (IN(3)) {
        idx_phase(vcu >> 4, vcu & 15, PROJ, IKC, MASK, lds, wave);
    }
    SEAM(3);
    if (IN(4)) {
        const int bh = vcu >> 1, s = vcu & 1, b = bh >> 3, h = bh & 7;
        bf16x8 qf[2][6];
        mla_prime(b, h, 7 - s, QB, KNC, VBC, KRC, lds, wave, qf);
#pragma unroll
        for (int j = 0; j < 4; ++j) {
            const int qa = 2 * (j >> 1) + s, qb = (j & 1) ? qa : 7 - qa, jn = j + 1, qan = 2 * (jn >> 1) + s, qbn = (jn & 1) ? qan : 7 - qan;
            mla_unit(b, h, qb, j < 3 ? qbn : -1, qf, QB, PROJ, KNC, VBC, KRC, OAB, OSS, lds, wave);
        }
    }
    NOSEAM(4);
    if (IN(5)) {
        const int bg = vcu >> 3, s = vcu & 7, b = bg >> 1, g = bg & 1;
        bf16x8 qf[2][6]; float pta;
        dsa_prime(b, g, 31 - s, PROJ, KAC, VAC, MASK, POSF, lds, wave, qf, pta);
#pragma unroll
        for (int j = 0; j < 4; ++j) {
            const int qa = 8 * (j >> 1) + s, qb = (j & 1) ? qa : 31 - qa, jn = j + 1, qan = 8 * (jn >> 1) + s, qbn = (jn & 1) ? qan : 31 - qan;
            dsa_unit(b, g, qb, j < 3 ? qbn : -1, qf, pta, PROJ, KAC, VAC, MASK, POSF, OAB, OSS, lds, wave);
        }
    }
    SEAM(5);
    if (IN(7)) {
        pg8::Gemm g{OAB, WOT, M, DM, 1024, 1024}; pg8::StaticOrder So; So.init(M, DM, G, bx);
        EpiOut E{a.x, a.out, (unsigned long long*)(ws + WS_STATS), (unsigned*)(ws + WS_PCNT), OSS, a.ln_g, a.ln_b};
        E.fill_rs(So, lds + 131072, tid);
        pg8::gemm_phase<EpiOut>(lds, g, So, E, wave);
    }
#undef IN
#undef lane
#undef tid
#undef gt
#undef SEAM
#undef NOSEAM
}

constexpr int N_PHASES = 9;
#ifndef PROBE_PHASE
#define PROBE_PHASE -1
#endif
extern "C" void kernel_launch(void* const* d_in, const int* in_sizes, int n_in, void* d_out, int out_size, void* d_ws, size_t ws_size, hipStream_t stream) {
    static int grid = 0;
    if (grid == 0) {
        if (n_in != 12 || in_sizes[0] != M * DM || out_size != M * DM || ws_size < WS_END) { fprintf(stderr, "kernel_launch: unexpected shapes (n_in %d, in0 %d, out %d, ws %zu)\n", n_in, n_in > 0 ? in_sizes[0] : -1, out_size, ws_size); grid = -1; return; }
        int dev = 0, cus = 0, per_cu = 0;
        if (hipGetDevice(&dev) != hipSuccess || hipDeviceGetAttribute(&cus, hipDeviceAttributeMultiprocessorCount, dev) != hipSuccess) { grid = -1; return; }
        if (hipFuncSetAttribute((const void*)hybrid_fwd, hipFuncAttributeMaxDynamicSharedMemorySize, LDS_BYTES) != hipSuccess) { fprintf(stderr, "kernel_launch: hipFuncSetAttribute failed\n"); grid = -1; return; }
        if (hipOccupancyMaxActiveBlocksPerMultiprocessor(&per_cu, (const void*)hybrid_fwd, 512, LDS_BYTES) != hipSuccess || per_cu < 1) { fprintf(stderr, "kernel_launch: occupancy query says %d\n", per_cu); per_cu = 1; }
        (void)hipGetLastError();
        grid = cus;
        if (grid != 256) fprintf(stderr, "kernel_launch: %d CUs; this kernel's work deals assume 256\n", grid);
    }
    if (grid < 0) return;
    Args a{};
    a.x = (const float*)d_in[0]; a.pos = (const int*)d_in[1]; a.w_in = (const float*)d_in[2]; a.g_q = (const float*)d_in[3]; a.w_uq = (const float*)d_in[4]; a.g_kv = (const float*)d_in[5];
    a.w_ukv = (const float*)d_in[6]; a.g_oa = (const float*)d_in[7]; a.g_ob = (const float*)d_in[8]; a.w_out = (const float*)d_in[9]; a.ln_g = (const float*)d_in[10]; a.ln_b = (const float*)d_in[11];
    a.out = (float*)d_out; a.ws = (unsigned char*)d_ws;
    (void)hipMemsetAsync(d_ws, 0, 4096 + 256 * 256, stream);
#if MK_N_LAUNCHES == 1
    a.ph_lo = 0; a.ph_hi = N_PHASES;
    void* args[] = {&a};
    hipError_t e = hipLaunchCooperativeKernel((const void*)hybrid_fwd, dim3(grid), dim3(512), args, LDS_BYTES, stream);
    if (e != hipSuccess) fprintf(stderr, "kernel_launch: cooperative launch failed: %s (grid %d)\n", hipGetErrorString(e), grid);
#else
    for (int p = 0; p < N_PHASES; ++p) {
        a.ph_lo = p; a.ph_hi = p + 1;
        for (int rep = 0; rep < ((p == PROBE_PHASE) ? 2 : 1); ++rep) hipLaunchKernelGGL(hybrid_fwd, dim3(grid), dim3(512), LDS_BYTES, stream, a);
    }
#endif
}
```

```cpp
#include <hip/hip_runtime.h>
#include <hip/hip_cooperative_groups.h>
#include <cstdio>
#include <cstdint>
namespace cg = cooperative_groups;
__device__ __forceinline__ void mk_syncthreads() {
    __builtin_amdgcn_fence(__ATOMIC_RELEASE, "workgroup");
    __builtin_amdgcn_s_barrier();
    __builtin_amdgcn_fence(__ATOMIC_ACQUIRE, "workgroup");
}
#define __syncthreads() mk_syncthreads()

#ifndef MK_N_LAUNCHES
#define MK_N_LAUNCHES 1
#endif

#define LAS __attribute__((address_space(3)))
typedef unsigned short bf16_t;
typedef short bf16x8 __attribute__((ext_vector_type(8)));
typedef short s16x4 __attribute__((ext_vector_type(4)));
typedef float f32x4 __attribute__((ext_vector_type(4)));
typedef float f32x2 __attribute__((ext_vector_type(2)));
typedef float f32x16 __attribute__((ext_vector_type(16)));
typedef unsigned u32x4 __attribute__((ext_vector_type(4)));
typedef unsigned u32x2 __attribute__((ext_vector_type(2)));

constexpr int NB = 16, S = 4096, M = NB * S, DM = 1024;
constexpr int NPROJ = 3072;
constexpr int C_QA = 0, C_KA = 512, C_VA = 640, C_IQ = 768, C_CQ = 1280, C_CKV = 1664, C_IK = 1920, C_KR = 1984, C_IW = 2016, C_Z = 2048;
constexpr int D_IN = 3048;
constexpr int NQB = 768, NKVB = 1024;
constexpr float LOG2E = 1.4426950408889634f;
constexpr float QA_SCALE = 0.125f * LOG2E;
constexpr float QB_SCALE = 0.10206207261596577f * LOG2E;
constexpr float IW_SCALE = 0.04419417382415922f;
constexpr float DN_ALPHA = 1.189207115002721f;
constexpr int KTOP = 256;

constexpr size_t MiB = 1u << 20;
constexpr size_t WS_W1T = 1 * MiB, WS_WUQT = 7 * MiB, WS_WUKVT = 8 * MiB, WS_WOT = 9 * MiB, WS_CS = 11 * MiB, WS_SSQ = 19 * MiB, WS_POSF = 25 * MiB,
                 WS_OSS = 26 * MiB, WS_STATS = 30 * MiB, WS_XB = 64 * MiB, WS_PROJ = 192 * MiB, WS_QB = 576 * MiB, WS_KVB = 672 * MiB, WS_MASK = 800 * MiB,
                 WS_IKC = 832 * MiB, WS_KRC = 840 * MiB, WS_KAC = 848 * MiB, WS_VAC = 864 * MiB, WS_CQC = 880 * MiB, WS_CKVC = 928 * MiB, WS_END = 1024 * MiB;
constexpr size_t WS_KNC = WS_KVB, WS_VBC = WS_KVB + 64 * MiB;
constexpr size_t WS_PCNT = 4096;
constexpr size_t WS_OAB = 960 * MiB;
constexpr size_t WS_OB = WS_CQC;
constexpr long OB_DELTA = ((long)WS_OB - (long)WS_OAB) / 2;
constexpr size_t WS_Y = WS_KVB;

constexpr int LDS_BYTES = 149504;

__device__ __forceinline__ unsigned cvt_pk_bf16(float lo, float hi) { unsigned r; asm volatile("v_cvt_pk_bf16_f32 %0, %1, %2" : "=v"(r) : "v"(lo), "v"(hi)); return r; }
__device__ __forceinline__ float bf_lo(unsigned u) { return __uint_as_float(u << 16); }
__device__ __forceinline__ float bf_hi(unsigned u) { return __uint_as_float(u & 0xffff0000u); }
__device__ __forceinline__ int crow(int r, int hi) { return (r & 3) + 8 * (r >> 2) + 4 * hi; }
__device__ __forceinline__ float silu_f(float v) { return v * __builtin_amdgcn_rcpf(1.0f + __builtin_amdgcn_exp2f(-v * LOG2E)); }
__device__ __forceinline__ size_t proj_off(size_t row, int col) { return ((row >> 4) * (size_t)(3072 / 8) + (size_t)(col >> 3)) * 128 + (row & 15) * 8 + (col & 7); }
__device__ __forceinline__ size_t vb_off(size_t row, int col) { return ((row >> 4) * (size_t)(1024 / 8) + (size_t)(col >> 3)) * 128 + (row & 15) * 8 + (col & 7); }
__device__ __forceinline__ float relu_f(float x) { const int b = __float_as_int(x); return __int_as_float(b > 0 ? b : 0); }
__device__ __forceinline__ int lane_id() { return (int)__builtin_amdgcn_mbcnt_hi(~0u, __builtin_amdgcn_mbcnt_lo(~0u, 0u)); }
__device__ __forceinline__ void glds16(const void* g, LAS unsigned char* l) { __builtin_amdgcn_global_load_lds((const unsigned*)g, (LAS unsigned*)l, 16, 0, 0); }

namespace pg8 {
constexpr int BM = 256, BK = 64, HALF = 128, HTB = HALF * BK * 2, STAGE_BYTES = 8 * HTB, NXCD = 8, WGM = 8;
__host__ __device__ __forceinline__ int lds_byte(int r, int c) { const int st = (r >> 4) * 2 + (c >> 5), rr = r & 15, cc = c & 31, ob = rr * 64 + cc * 2; return st * 1024 + (ob ^ (((ob >> 9) & 1) << 5)); }
__host__ __device__ __forceinline__ void stage_rc(int b, int& R, int& C) { const int st = b / 1024, sb = b % 1024, swz = sb ^ (((sb >> 9) & 1) << 5); R = (st >> 1) * 16 + swz / 64; C = (st & 1) * 32 + (swz % 64) / 2; }
__host__ __device__ __forceinline__ int perm32(int rho) { const int n = rho >> 4, i = rho & 15; return 8 * (i >> 2) + 4 * n + (i & 3); }

struct Unit { int pm, pn; };
struct Gemm { const bf16_t* A; const bf16_t* Bt; int M, N, K, lda; long ajump = 0; };

struct StaticOrder {
    int nM, nN, nwg, G, c;
    __host__ __device__ __forceinline__ void init(int M_, int N_, int G_, int c_) { nM = M_ / BM; nN = N_ / BM; nwg = nM * nN; G = G_; c = c_; }
    __host__ __device__ bool next(int i, Unit& u) const {
        const long L = (long)i * G + c; if (L >= nwg) return false;
        int wgid = (int)L; { const int q = nwg / NXCD, r = nwg % NXCD, xcd = wgid % NXCD; int off = wgid / NXCD;
            if (nN == 12 && G % NXCD == 0) { const int per = G / NXCD, st = off / per, j = off % per; off = st * per + (j + 8 * (st / 3)) % per; }
            wgid = (xcd < r ? xcd * (q + 1) : r * (q + 1) + (xcd - r) * q) + off; }
        const int nig = WGM * nN, gid = wgid / nig, fm = gid * WGM, gsz = (nM - fm) < WGM ? (nM - fm) : WGM;
        u.pm = fm + ((wgid % nig) % gsz); u.pn = (wgid % nig) / gsz; return true;
    }
};

template <class Epi>
__device__ __forceinline__ void gemm_phase(LAS unsigned char* lds, const Gemm g, const StaticOrder& S, const Epi& E, const int wid) {
    const int lane = lane_id(), tid = wid * 64 + lane, wr = wid >> 2, wc = wid & 3, fr = lane & 15, fq = lane >> 4;
    const int K = g.K, nt = K / BK, lda = g.lda;
    unsigned voffA[2], voffB[2];
#pragma unroll
    for (int i = 0; i < 2; ++i) { int R, C; stage_rc(tid * 16 + i * 8192, R, C); const int Rb = Epi::PERM ? ((R & ~31) + perm32(R & 31)) : R;
        voffA[i] = (unsigned)(R * lda + C) * 2u; voffB[i] = (unsigned)(Rb * K + C) * 2u; }
    const size_t kstep = (size_t)(BK * 2);
    const size_t hstepA = (size_t)HALF * lda * 2, tstepA = 2 * hstepA;
    const size_t hstepB = (size_t)HALF * K * 2, tstepB = 2 * hstepB;
    const unsigned ldsw = (unsigned)wid * 1024u;
    const int aoff = lds_byte(wr * 64 + fr, fq * 8), boff = lds_byte(wc * 32 + fr, fq * 8);
#define PG8_SA(b, h) (((b) * 2 + (h)) * HTB)
#define PG8_SB(b, h) ((4 + (b) * 2 + (h)) * HTB)
#define PG8_STAGE(bufoff, gbase, voff) do { _Pragma("unroll") for (int _i = 0; _i < 2; ++_i) \
        __builtin_amdgcn_global_load_lds((const unsigned*)((const char*)(gbase) + (voff)[_i]), (LAS unsigned*)(lds + (bufoff) + ldsw + _i * 8192), 16, 0, 0); } while (0)
#define PG8_LDA(dst, b, h) do { _Pragma("unroll") for (int m = 0; m < 4; ++m) _Pragma("unroll") for (int k = 0; k < 2; ++k) dst[m][k] = *(const LAS bf16x8*)(lds + PG8_SA(b, h) + aoff + m * 2048 + k * 1024); } while (0)
#define PG8_LDB(dst, b, h) do { _Pragma("unroll") for (int n = 0; n < 2; ++n) _Pragma("unroll") for (int k = 0; k < 2; ++k) dst[n][k] = *(const LAS bf16x8*)(lds + PG8_SB(b, h) + boff + n * 2048 + k * 1024); } while (0)
#define PG8_MMA(ai, bj, At, Bt) do { __builtin_amdgcn_s_setprio(1); _Pragma("unroll") for (int m = 0; m < 4; ++m) _Pragma("unroll") for (int n = 0; n < 2; ++n) _Pragma("unroll") for (int k = 0; k < 2; ++k) \
        acc[ai][bj][m][n] = __builtin_amdgcn_mfma_f32_16x16x32_bf16(Bt[n][k], At[m][k], acc[ai][bj][m][n], 0, 0, 0); __builtin_amdgcn_s_setprio(0); } while (0)
#define PG8_WAIT_V(n) asm volatile("s_waitcnt vmcnt(" #n ")" ::: "memory")
#define PG8_WAIT_L(n) asm volatile("s_waitcnt lgkmcnt(" #n ")" ::: "memory")
#define PG8_BAR __builtin_amdgcn_s_barrier()
#define PG8_SCHED __builtin_amdgcn_sched_barrier(0)
    Unit cur, nxt; int ui = 0;
    if (!S.next(0, cur)) return;
    f32x4 acc[2][2][4][2];
#pragma unroll
    for (int a = 0; a < 2; ++a)
#pragma unroll
        for (int b = 0; b < 2; ++b)
#pragma unroll
            for (int m = 0; m < 4; ++m)
#pragma unroll
                for (int n = 0; n < 2; ++n) acc[a][b][m][n] = (f32x4){0.f, 0.f, 0.f, 0.f};
    bf16x8 At[4][2], B0[2][2], B1[2][2];
    const char* cA = (const char*)g.A + (size_t)cur.pm * tstepA; const char* cB = (const char*)g.Bt + (size_t)cur.pn * tstepB;
    PG8_STAGE(PG8_SB(0, 0), cB, voffB); PG8_STAGE(PG8_SB(0, 1), cB + hstepB, voffB); PG8_STAGE(PG8_SA(0, 0), cA, voffA); PG8_STAGE(PG8_SA(0, 1), cA + hstepA, voffA);
    if (wr == 1) PG8_BAR;
    PG8_WAIT_V(2); PG8_BAR;
    PG8_STAGE(PG8_SB(1, 0), cB + kstep, voffB); PG8_STAGE(PG8_SA(1, 0), cA + kstep, voffA); PG8_STAGE(PG8_SB(1, 1), cB + hstepB + kstep, voffB);
    PG8_WAIT_V(6); PG8_BAR;
    for (;;) {
        const bool has_next = S.next(ui + 1, nxt);
        const char* nA = has_next ? (const char*)g.A + (size_t)nxt.pm * tstepA : cA; const char* nB = has_next ? (const char*)g.Bt + (size_t)nxt.pn * tstepB : cB;
        for (int t = 0; t < nt; t += 2) {
            if constexpr (Epi::MID) {
                if (t == nt / 2) {
                    float midf[2][4]; E.mid_load(midf, cur, wr, ui, lds + 131072);
#pragma unroll
                    for (int a = 0; a < 2; ++a)
#pragma unroll
                        for (int b = 0; b < 2; ++b)
#pragma unroll
                            for (int m = 0; m < 4; ++m)
#pragma unroll
                                for (int n = 0; n < 2; ++n) acc[a][b][m][n] *= midf[a][m];
                }
            }
            const bool last = (t == nt - 2);
            const long aj1 = (t + 1 >= nt / 2) ? g.ajump : 0, aj2 = (t + 2 >= nt / 2) ? g.ajump : 0, aj3 = (t + 3 >= nt / 2) ? g.ajump : 0;
            const char* a1 = cA + (size_t)(t + 1) * kstep + aj1;
            const char* a2 = last ? nA : cA + (size_t)(t + 2) * kstep + aj2; const char* b2 = last ? nB : cB + (size_t)(t + 2) * kstep;
            const char* a3 = last ? nA + kstep : cA + (size_t)(t + 3) * kstep + aj3; const char* b3 = b2 + kstep;
            PG8_LDB(B0, 0, 0); PG8_LDB(B1, 0, 1); PG8_SCHED; PG8_LDA(At, 0, 0); PG8_STAGE(PG8_SA(1, 1), a1 + hstepA, voffA);
            PG8_WAIT_V(8); PG8_WAIT_L(0); PG8_BAR; PG8_MMA(0, 0, At, B0); PG8_MMA(0, 1, At, B1); PG8_BAR; PG8_SCHED;
            PG8_LDA(At, 0, 1); PG8_STAGE(PG8_SB(0, 0), b2, voffB); PG8_STAGE(PG8_SB(0, 1), b2 + hstepB, voffB); PG8_STAGE(PG8_SA(0, 0), a2, voffA);
            PG8_WAIT_V(8); PG8_WAIT_L(0); PG8_BAR; PG8_MMA(1, 0, At, B0); PG8_MMA(1, 1, At, B1); PG8_BAR; PG8_SCHED;
            PG8_LDB(B0, 1, 0); PG8_LDB(B1, 1, 1); PG8_SCHED; PG8_LDA(At, 1, 0); PG8_STAGE(PG8_SA(0, 1), a2 + hstepA, voffA);
            PG8_WAIT_V(8); PG8_WAIT_L(0); PG8_BAR; PG8_MMA(0, 0, At, B0); PG8_MMA(0, 1, At, B1); PG8_BAR; PG8_SCHED;
            PG8_LDA(At, 1, 1); PG8_STAGE(PG8_SB(1, 0), b3, voffB); PG8_STAGE(PG8_SB(1, 1), b3 + hstepB, voffB); PG8_STAGE(PG8_SA(1, 0), a3, voffA);
            PG8_WAIT_V(8); PG8_WAIT_L(0); PG8_BAR; PG8_MMA(1, 0, At, B0); PG8_MMA(1, 1, At, B1); PG8_BAR; PG8_SCHED;
        }
        if (wr == 0) PG8_BAR;
        if constexpr (Epi::FUSED) E.fused(acc, cur, wr, wc, lds + 131072, wid, ui); else E(acc, cur, wr, wc, fr, fq);
        if (!has_next) break;
#pragma unroll
        for (int a = 0; a < 2; ++a)
#pragma unroll
            for (int b = 0; b < 2; ++b)
#pragma unroll
                for (int m = 0; m < 4; ++m)
#pragma unroll
                    for (int n = 0; n < 2; ++n) acc[a][b][m][n] = (f32x4){0.f, 0.f, 0.f, 0.f};
        cur = nxt; cA = nA; cB = nB; ++ui;
        if (wr == 1) PG8_BAR;
    }
    PG8_WAIT_V(0);
    PG8_BAR;
#undef PG8_SA
#undef PG8_SB
#undef PG8_STAGE
#undef PG8_LDA
#undef PG8_LDB
#undef PG8_MMA
#undef PG8_WAIT_V
#undef PG8_WAIT_L
#undef PG8_BAR
#undef PG8_SCHED
}
}

__device__ __forceinline__ int lane_id_nohoist() { int l; asm volatile("v_mbcnt_lo_u32_b32 %0, -1, 0\n\tv_mbcnt_hi_u32_b32 %0, -1, %0" : "=v"(l)); return l; }

__device__ __forceinline__ void rope8(f32x4& v0, f32x4& v1, const float* csrow, int fq) {
    const f32x4 c = *(const f32x4*)(csrow + 4 * fq), s = *(const f32x4*)(csrow + 16 + 4 * fq);
    const float a0 = v0[0] * c[0] - v0[1] * s[0], b0 = v0[0] * s[0] + v0[1] * c[0];
    const float a1 = v0[2] * c[1] - v0[3] * s[1], b1 = v0[2] * s[1] + v0[3] * c[1];
    const float a2 = v1[0] * c[2] - v1[1] * s[2], b2 = v1[0] * s[2] + v1[1] * c[2];
    const float a3 = v1[2] * c[3] - v1[3] * s[3], b3 = v1[2] * s[3] + v1[3] * c[3];
    v0 = (f32x4){a0, b0, a1, b1}; v1 = (f32x4){a2, b2, a3, b3};
}
__device__ __forceinline__ void rope8r(f32x4& v0, f32x4& v1, const f32x4& c, const f32x4& s) {
    const float a0 = v0[0] * c[0] - v0[1] * s[0], b0 = v0[0] * s[0] + v0[1] * c[0];
    const float a1 = v0[2] * c[1] - v0[3] * s[1], b1 = v0[2] * s[1] + v0[3] * c[1];
    const float a2 = v1[0] * c[2] - v1[1] * s[2], b2 = v1[0] * s[2] + v1[1] * c[2];
    const float a3 = v1[2] * c[3] - v1[3] * s[3], b3 = v1[2] * s[3] + v1[3] * c[3];
    v0 = (f32x4){a0, b0, a1, b1}; v1 = (f32x4){a2, b2, a3, b3};
}
__device__ __forceinline__ void store8(bf16_t* p, const f32x4& v0, const f32x4& v1) {
    u32x4 w; w.x = cvt_pk_bf16(v0[0], v0[1]); w.y = cvt_pk_bf16(v0[2], v0[3]); w.z = cvt_pk_bf16(v1[0], v1[1]); w.w = cvt_pk_bf16(v1[2], v1[3]);
    *(u32x4*)p = w;
}

struct EpiProj {
    static constexpr bool PERM = true, MID = false, FUSED = false;
    bf16_t* P; const float* cs; float* ssq; bf16_t* IKC; bf16_t* KRC; bf16_t* KAC; bf16_t* VAC; bf16_t* CQC; bf16_t* CKVC;
    __device__ __forceinline__ void operator()(const f32x4 (&acc)[2][2][4][2], const pg8::Unit& u, int wr, int wc, int fr_, int fq_) const {
        const int l_ = lane_id_nohoist(), fr = l_ & 15, fq = l_ >> 4;
        const int row0 = u.pm * 256 + wr * 64 + fr, colt = u.pn * 256 + wc * 32 + 8 * fq, pn = u.pn;
#pragma unroll
        for (int ai = 0; ai < 2; ++ai) {
            f32x4 rc[4], rs[4];
            if (pn == 7 && wc == 2) {
#pragma unroll
                for (int m = 0; m < 4; ++m) { const float* cp = cs + (size_t)(row0 + ai * 128 + m * 16) * 32 + 4 * fq; rc[m] = *(const f32x4*)cp; rs[m] = *(const f32x4*)(cp + 16); }
            }
#pragma unroll
            for (int m = 0; m < 4; ++m) {
                const int row = row0 + ai * 128 + m * 16;
#pragma unroll
                for (int bj = 0; bj < 2; ++bj) {
                    f32x4 v0 = acc[ai][bj][m][0], v1 = acc[ai][bj][m][1];
                    bf16_t* dst = P + proj_off((size_t)row, colt + bj * 128);
                    if (pn >= 8) {
#pragma unroll
                        for (int j = 0; j < 4; ++j) { v0[j] = silu_f(v0[j]); v1[j] = silu_f(v1[j]); }
                    } else if (pn == 2) {
                        const size_t tb = (size_t)((row >> 12) * 2 + (wc >> 1)) * 64 + ((row & 4095) >> 6); const int k = row & 63;
                        dst = (bj == 0) ? KAC + (tb * 8 + 4 * (wc & 1) + fq) * 512 + k * 8 : VAC + (tb * 2 + (wc & 1)) * 2048 + k * 32 + 8 * fq;
                    } else if (pn >= 5) {
                        int slot = -1;
                        if (pn == 5) { slot = bj * 4 + wc; dst = CQC + (size_t)row * 384 + bj * 128 + wc * 32 + 8 * fq; }
                        else if (pn == 6) { if (bj == 0) { slot = 8 + wc; dst = CQC + (size_t)row * 384 + 256 + wc * 32 + 8 * fq; } else { slot = 12 + wc; dst = CKVC + (size_t)row * 256 + wc * 32 + 8 * fq; } }
                        else if (bj == 0) { slot = 16 + wc; dst = CKVC + (size_t)row * 256 + 128 + wc * 32 + 8 * fq; }
                        if (slot >= 0) {
                            float s = (v0[0] * v0[0] + v0[1] * v0[1]) + (v0[2] * v0[2] + v0[3] * v0[3]) + (v1[0] * v1[0] + v1[1] * v1[1]) + (v1[2] * v1[2] + v1[3] * v1[3]);
                            s += __shfl_xor(s, 16); s += __shfl_xor(s, 32);
                            if (fq == 0) ssq[(size_t)row * 20 + slot] = s;
                        } else if (wc < 2) dst = IKC + ((size_t)(row >> 5) * 8 + 4 * wc + fq) * 256 + (row & 31) * 8;
                        else if (wc == 2) { rope8r(v0, v1, rc[m], rs[m]); dst = KRC + ((size_t)(row >> 6) * 4 + fq) * 512 + (row & 63) * 8; }
                    }
                    store8(dst, v0, v1);
                }
                asm volatile("" ::: "memory");
            }
        }
    }
};
struct EpiUp {
    static constexpr bool PERM = true, MID = false, FUSED = false;
    bf16_t* O; int ldc; const float* ssq; int slot0, nslot4; float invK; const float* cs; int rope_pn; bf16_t* HK; bf16_t* HV;
    __device__ __forceinline__ void operator()(const f32x4 (&acc)[2][2][4][2], const pg8::Unit& u, int wr, int wc, int fr_, int fq_) const {
        const int l_ = lane_id_nohoist(), fr = l_ & 15, fq = l_ >> 4;
        const int row0 = u.pm * 256 + wr * 64 + fr, colt = u.pn * 256 + wc * 32 + 8 * fq;
#pragma unroll
        for (int ai = 0; ai < 2; ++ai) {
            float rstd[4];
            { f32x4 tq[4][3];
#pragma unroll
              for (int m = 0; m < 4; ++m)
#pragma unroll
                  for (int q = 0; q < 3; ++q) tq[m][q] = (q < nslot4) ? *(const f32x4*)(ssq + (size_t)(row0 + ai * 128 + m * 16) * 20 + slot0 + 4 * q) : (f32x4){0.f, 0.f, 0.f, 0.f};
#pragma unroll
              for (int m = 0; m < 4; ++m) { const f32x4 t = tq[m][0] + tq[m][1] + tq[m][2]; rstd[m] = __builtin_amdgcn_rsqf(((t[0] + t[1]) + (t[2] + t[3])) * invK + 1e-6f); } }
            f32x4 rc[4], rs[4];
            if (u.pn == rope_pn) {
#pragma unroll
                for (int m = 0; m < 4; ++m) { const float* cp = cs + (size_t)(row0 + ai * 128 + m * 16) * 32 + 4 * fq; rc[m] = *(const f32x4*)cp; rs[m] = *(const f32x4*)(cp + 16); }
            }
#pragma unroll
            for (int m = 0; m < 4; ++m) {
                const int row = row0 + ai * 128 + m * 16; bf16_t* rowp = O + (size_t)row * ldc + colt;
#pragma unroll
                for (int bj = 0; bj < 2; ++bj) {
                    f32x4 v0 = acc[ai][bj][m][0] * rstd[m], v1 = acc[ai][bj][m][1] * rstd[m];
                    if (u.pn == rope_pn) rope8r(v0, v1, rc[m], rs[m]);
                    bf16_t* dst = rowp + bj * 128;
                    if (HK) { const int h = 4 * (u.pn & 1) + 2 * bj + (wc >> 1);
                        const size_t tb = (size_t)((row >> 12) * 8 + h) * 64 + ((row & 4095) >> 6); const int k = row & 63;
                        dst = (u.pn < 2) ? HK + (tb * 8 + 4 * (wc & 1) + fq) * 512 + k * 8 : HV + (tb * 2 + (wc & 1)) * 2048 + k * 32 + 8 * fq; }
                    store8(dst, v0, v1);
                }
                asm volatile("" ::: "memory");
            }
        }
    }
};
struct EpiOut {
    static constexpr bool PERM = true, MID = true, FUSED = true;
    const bf16_t* xb; float* out; unsigned long long* xbuf; unsigned* cnt; const float* oss; const float* ln_g; const float* ln_b;
    __device__ __forceinline__ float rstd_of(const float* p) const { const f32x4 s0 = *(const f32x4*)p, s1 = *(const f32x4*)(p + 4);
        return __builtin_amdgcn_rsqf((((s0[0] + s0[1]) + (s0[2] + s0[3])) + ((s1[0] + s1[1]) + (s1[2] + s1[3]))) * (1.0f / 512.0f) + 1e-6f); }
    __device__ __forceinline__ void fill_rs(const pg8::StaticOrder& So, LAS unsigned char* tl, int tid_) const {
        LAS f32x2* RS = (LAS f32x2*)(tl + 10240);
        f32x4 v[2][4]; int ok[2];
#pragma unroll
        for (int k = 0; k < 2; ++k) { const int r = tid_ + 512 * k; pg8::Unit u; ok[k] = So.next(r >> 8, u) ? 1 : 0; const float* p = oss + (size_t)((ok[k] ? u.pm : 0) * 256 + (r & 255)) * 16;
#pragma unroll
            for (int q = 0; q < 4; ++q) v[k][q] = *(const f32x4*)(p + 4 * q); }
#pragma unroll
        for (int k = 0; k < 2; ++k) { const int r = tid_ + 512 * k;
            const float ra = __builtin_amdgcn_rsqf((((v[k][0][0] + v[k][0][1]) + (v[k][0][2] + v[k][0][3])) + ((v[k][1][0] + v[k][1][1]) + (v[k][1][2] + v[k][1][3]))) * (1.0f / 512.0f) + 1e-6f);
            const float rb = __builtin_amdgcn_rsqf((((v[k][2][0] + v[k][2][1]) + (v[k][2][2] + v[k][2][3])) + ((v[k][3][0] + v[k][3][1]) + (v[k][3][2] + v[k][3][3]))) * (1.0f / 512.0f) + 1e-6f);
            RS[r] = (f32x2){ra / rb, rb}; }
        asm volatile("s_waitcnt lgkmcnt(0)" ::: "memory"); __builtin_amdgcn_s_barrier(); asm volatile("" ::: "memory");
    }
    __device__ __forceinline__ void mid_load(float (&f)[2][4], const pg8::Unit& u, int wr, int ui, LAS unsigned char* tl) const {
        const LAS f32x2* RS = (const LAS f32x2*)(tl + 10240) + ui * 256;
        const int fr = lane_id_nohoist() & 15;
#pragma unroll
        for (int ai = 0; ai < 2; ++ai)
#pragma unroll
            for (int m = 0; m < 4; ++m) f[ai][m] = RS[wr * 64 + fr + ai * 128 + m * 16].x;
    }
    __device__ __forceinline__ void fused(f32x4 (&acc)[2][2][4][2], const pg8::Unit& u, int wr, int wc, LAS unsigned char* tl, int wid, int ui) const {
        LAS f32x2* P = (LAS f32x2*)tl;
        LAS f32x2* SX = (LAS f32x2*)(tl + 8192);
        { const int l_ = lane_id_nohoist(), fr = l_ & 15, fq = l_ >> 4;
          const int row0 = u.pm * 256 + wr * 64 + fr, col0 = u.pn * 256 + wc * 32 + 8 * fq;
#pragma unroll
          for (int ai = 0; ai < 2; ++ai)
#pragma unroll
            for (int m = 0; m < 4; ++m) {
                const int row = row0 + ai * 128 + m * 16; const size_t off = (size_t)row * DM + col0;
                const float rb = ((const LAS f32x2*)(tl + 10240))[ui * 256 + ai * 128 + wr * 64 + m * 16 + fr].y;
                float sm = 0.f, q = 0.f;
#pragma unroll
                for (int bj = 0; bj < 2; ++bj) {
                    const u32x4 xw = *(const u32x4*)(xb + off + bj * 128);
                    const f32x4 x0 = (f32x4){bf_lo(xw.x), bf_hi(xw.x), bf_lo(xw.y), bf_hi(xw.y)}, x1 = (f32x4){bf_lo(xw.z), bf_hi(xw.z), bf_lo(xw.w), bf_hi(xw.w)};
                    const f32x4 v0 = x0 * DN_ALPHA + acc[ai][bj][m][0] * rb, v1 = x1 * DN_ALPHA + acc[ai][bj][m][1] * rb;
                    sm += ((v0[0] + v0[1]) + (v0[2] + v0[3])) + ((v1[0] + v1[1]) + (v1[2] + v1[3]));
                    q += ((v0[0] * v0[0] + v0[1] * v0[1]) + (v0[2] * v0[2] + v0[3] * v0[3])) + ((v1[0] * v1[0] + v1[1] * v1[1]) + (v1[2] * v1[2] + v1[3] * v1[3]));
                    acc[ai][bj][m][0] = v0; acc[ai][bj][m][1] = v1;
                }
                sm += __shfl_xor(sm, 16); sm += __shfl_xor(sm, 32); q += __shfl_xor(q, 16); q += __shfl_xor(q, 32);
                if (fq == 0) P[(ai * 128 + wr * 64 + m * 16 + fr) * 4 + wc] = (f32x2){sm, q};
                asm volatile("" ::: "memory");
            } }
        asm volatile("s_waitcnt lgkmcnt(0)" ::: "memory"); __builtin_amdgcn_s_barrier(); asm volatile("" ::: "memory");
        const int ln = lane_id_nohoist(), rl = wid * 32 + (ln & 31);
        if (ln < 32) {
            const f32x2 a = P[rl * 4 + 0], b = P[rl * 4 + 1], c = P[rl * 4 + 2], d = P[rl * 4 + 3];
            const float st = (a.x + b.x) + (c.x + d.x), qt = (a.y + b.y) + (c.y + d.y);
            __hip_atomic_store(xbuf + ((size_t)(u.pm * 256 + rl) * 4 + u.pn), ((unsigned long long)__float_as_uint(qt) << 32) | __float_as_uint(st), __ATOMIC_RELAXED, __HIP_MEMORY_SCOPE_AGENT);
        }
        asm volatile("s_waitcnt vmcnt(0)" ::: "memory");
        if (ln == 0) __hip_atomic_fetch_add(cnt + 64 * u.pm, 1u, __ATOMIC_RELAXED, __HIP_MEMORY_SCOPE_AGENT);
        if (wid == 0) {
            unsigned spins = 0;
            while ((unsigned)__builtin_amdgcn_readfirstlane((int)__hip_atomic_load(cnt + 64 * u.pm, __ATOMIC_RELAXED, __HIP_MEMORY_SCOPE_AGENT)) < 32u) { __builtin_amdgcn_s_sleep(1); if (++spins > (1u << 24)) break; }
            __builtin_amdgcn_fence(__ATOMIC_ACQUIRE, "agent");
        }
        asm volatile("s_waitcnt vmcnt(0) lgkmcnt(0)" ::: "memory"); __builtin_amdgcn_s_barrier(); asm volatile("" ::: "memory");
        if (ln < 32) {
            const unsigned long long* slot = xbuf + (size_t)(u.pm * 256 + rl) * 4; float st = 0.f, qt = 0.f;
#pragma unroll
            for (int t = 0; t < 4; ++t) { const unsigned long long w = __hip_atomic_load(slot + t, __ATOMIC_RELAXED, __HIP_MEMORY_SCOPE_AGENT); st += __uint_as_float((unsigned)w); qt += __uint_as_float((unsigned)(w >> 32)); }
            const float mean = st * (1.0f / DM), var = qt * (1.0f / DM) - mean * mean;
            SX[rl] = (f32x2){mean, 1.0f / sqrtf(fmaxf(var, 0.f) + 1e-5f)};
        }
        asm volatile("s_waitcnt lgkmcnt(0)" ::: "memory"); __builtin_amdgcn_s_barrier(); asm volatile("" ::: "memory");
        { const int l_ = lane_id_nohoist(), fr = l_ & 15, fq = l_ >> 4;
          const int col0 = u.pn * 256 + wc * 32 + 8 * fq;
#pragma unroll
          for (int bj = 0; bj < 2; ++bj) {
              const int col = col0 + bj * 128;
              const f32x4 g0 = *(const f32x4*)(ln_g + col), g1 = *(const f32x4*)(ln_g + col + 4), b0 = *(const f32x4*)(ln_b + col), b1 = *(const f32x4*)(ln_b + col + 4);
#pragma unroll
              for (int ai = 0; ai < 2; ++ai)
#pragma unroll
                  for (int m = 0; m < 4; ++m) { const int r = ai * 128 + wr * 64 + m * 16 + fr; const f32x2 sr = SX[r];
                      float* op = out + (size_t)(u.pm * 256 + r) * DM + col;
                      *(f32x4*)op = (acc[ai][bj][m][0] - sr.x) * sr.y * g0 + b0; *(f32x4*)(op + 4) = (acc[ai][bj][m][1] - sr.x) * sr.y * g1 + b1; }
              asm volatile("" ::: "memory");
          } }
    }
    __device__ __forceinline__ void operator()(const f32x4 (&acc)[2][2][4][2], const pg8::Unit& u, int wr, int wc, int fr_, int fq_) const {}
};

constexpr int AT_KB = 12288, AT_VOFF = 3 * AT_KB, AT_VB = 8192, AT_POS = 8192, AT_MSK = 8448;
__device__ __forceinline__ s16x4 vtr(const LAS unsigned char* p) {
    typedef short v4i16_t __attribute__((ext_vector_type(4)));
    return __builtin_bit_cast(s16x4, __builtin_amdgcn_ds_read_tr16_b64_v4i16((LAS v4i16_t*)p));
}
typedef __bf16 bf16x2_t __attribute__((ext_vector_type(2)));
__device__ __forceinline__ unsigned cvtpk(float lo, float hi) { f32x2 v = {lo, hi}; bf16x2_t bb = __builtin_convertvector(v, bf16x2_t); return __builtin_bit_cast(unsigned, bb); }
__device__ __forceinline__ float swap32_max(float x) { auto r = __builtin_amdgcn_permlane32_swap(__float_as_uint(x), __float_as_uint(x), false, false); return fmaxf(__uint_as_float(r[0]), __uint_as_float(r[1])); }
__device__ __forceinline__ float swap32_sum(float x) { auto r = __builtin_amdgcn_permlane32_swap(__float_as_uint(x), __float_as_uint(x), false, false); return __uint_as_float(r[0]) + __uint_as_float(r[1]); }
__device__ __forceinline__ void dma16(const void* gbase, unsigned voff, unsigned lds_dst) { unsigned keep;
    asm volatile("s_mov_b32 %0, m0\n\ts_mov_b32 m0, %3\n\ts_nop 0\n\tglobal_load_lds_dwordx4 %1, %2\n\ts_mov_b32 m0, %0" : "=&s"(keep) : "v"(voff), "s"(gbase), "s"(lds_dst) : "memory"); }
__device__ __forceinline__ void dma4(const void* gbase, unsigned voff, unsigned lds_dst) { unsigned keep;
    asm volatile("s_mov_b32 %0, m0\n\ts_mov_b32 m0, %3\n\ts_nop 0\n\tglobal_load_lds_dword %1, %2\n\ts_mov_b32 m0, %0" : "=&s"(keep) : "v"(voff), "s"(gbase), "s"(lds_dst) : "memory"); }
#define AT_SYNC() asm volatile("s_waitcnt vmcnt(0) lgkmcnt(0)\n\ts_barrier" ::: "memory")

constexpr int AT_BUF = AT_KB + AT_VB;
constexpr float AT_THR = 8.0f;
constexpr int AT_MSK2 = AT_MSK + 1024;
template <int MODE>
__device__ __forceinline__ void attn_prime(const bf16_t* ksrc, const bf16_t* rsrc, const bf16_t* vsrc, const unsigned long long* msrc, const float* psrc, LAS unsigned char* lds, const int wid) {
    const unsigned _b = (unsigned)(uintptr_t)lds; const unsigned _l = (unsigned)lane_id_nohoist();
    dma16(ksrc, _l * 16u, (unsigned)__builtin_amdgcn_readfirstlane(_b + wid * 1024));
    if (MODE == 0) { if (wid >= 4) dma16(rsrc, _l * 16u, (unsigned)__builtin_amdgcn_readfirstlane(_b + (8 + (wid & 3)) * 1024)); }
    else { if (wid == 0) dma4(psrc, _l * 4u, (unsigned)__builtin_amdgcn_readfirstlane(_b + AT_POS));
           if (wid == 1) dma16(msrc, (_l & 31u) * 16u + (_l >> 5) * 32768u, (unsigned)__builtin_amdgcn_readfirstlane(_b + AT_MSK)); }
    dma16(vsrc, _l * 16u, (unsigned)__builtin_amdgcn_readfirstlane(_b + AT_KB + wid * 1024));
}
template <int MODE>
__device__ __forceinline__ void attn_core(const bf16x8 (&qf)[2][6], const int NT, const int tlast, const int tqbase, const int tlastb, const int tqbaseb, const bf16_t* ksrc, const bf16_t* rsrc, const bf16_t* vsrc,
                                          const unsigned long long* msrc, const float* psrc, const float pta, const float nsa, const float nsb, const int qjbase,
                                          LAS unsigned char* lds, const int wid, const int lane, f32x16 (&oT)[2][2], float (&l_out)[2]) {
    constexpr int NKS = (MODE == 0) ? 6 : 4;
    const int r32 = lane & 31, hi = lane >> 5;
    const int vboff = ((lane >> 4) & 1) * 32 + (lane & 3) * 8 + (4 * hi + ((lane & 15) >> 2)) * 64;
    const unsigned lds0 = (unsigned)(uintptr_t)lds;
#define AT_DMA(t, bsel) do { const unsigned _b = lds0 + (bsel) * AT_BUF; const unsigned _l = (unsigned)lane_id_nohoist(); \
        dma16(ksrc + (size_t)(t) * 4096, _l * 16u, (unsigned)__builtin_amdgcn_readfirstlane(_b + wid * 1024)); \
        if (MODE == 0) { if (wid >= 4) dma16(rsrc + (size_t)(t) * 2048, _l * 16u, (unsigned)__builtin_amdgcn_readfirstlane(_b + (8 + (wid & 3)) * 1024)); } \
        else { if (wid == 0) dma4(psrc + (size_t)(t) * 64, _l * 4u, (unsigned)__builtin_amdgcn_readfirstlane(_b + AT_POS)); \
               if (wid == 1) dma16(msrc + (size_t)(t) * 64, (_l & 31u) * 16u + (_l >> 5) * 32768u, (unsigned)__builtin_amdgcn_readfirstlane(_b + AT_MSK)); } \
        dma16(vsrc + (size_t)(t) * 4096, _l * 16u, (unsigned)__builtin_amdgcn_readfirstlane(_b + AT_KB + wid * 1024)); } while (0)
#define AT_SM_MX(p0, p1, mxr) do { \
        float a = fmaxf(fmaxf(p0[0], p1[0]), p0[1]), bq = fmaxf(fmaxf(p1[1], p0[2]), p1[2]); \
        _Pragma("unroll") for (int r = 3; r < 15; r += 2) { a = fmaxf(fmaxf(a, p0[r]), p1[r]); bq = fmaxf(fmaxf(bq, p0[r + 1]), p1[r + 1]); } \
        mxr = swap32_max(fmaxf(fmaxf(a, bq), fmaxf(p0[15], p1[15]))); } while (0)
#define AT_SM_RS(mxr, o, mref, l, first) do { const float mx = mxr - mref; \
        const bool mv = first ? (mx > -INFINITY) : (mx > AT_THR); \
        if (__any(mv)) { const float dl = (mx > -INFINITY && (first || mx > 0.f)) ? mx : 0.f; mref += dl; const float f = first ? 0.f : __builtin_amdgcn_exp2f(-dl); \
            _Pragma("unroll") for (int r = 0; r < 16; ++r) { o[0][r] *= f; o[1][r] *= f; } \
            l *= f; if (mx > -INFINITY) first = false; } } while (0)
#define AT_SM_RS0(mxr, p0, p1, cs, o, mref, l, first) do { const float mx = mxr; \
        const bool mv = first ? (mx > -INFINITY) : (mx > AT_THR); \
        if (__any(mv)) { const float dl = (mx > -INFINITY && (first || mx > 0.f)) ? mx : 0.f; mref += dl; const float f = first ? 0.f : __builtin_amdgcn_exp2f(-dl); \
            _Pragma("unroll") for (int r = 0; r < 16; ++r) { o[0][r] *= f; o[1][r] *= f; p0[r] -= dl; p1[r] -= dl; cs[r] -= dl; } \
            asm volatile("" : "+v"(cs)); \
            l *= f; if (mx > -INFINITY) first = false; } } while (0)
#define AT_SM_EXP0(p0, p1, l) do { \
        float sacc = 0.f; \
        _Pragma("unroll") for (int r = 0; r < 16; ++r) { p0[r] = __builtin_amdgcn_exp2f(p0[r]); p1[r] = __builtin_amdgcn_exp2f(p1[r]); sacc += p0[r] + p1[r]; } \
        l += sacc; } while (0)
#define AT_SM_MAX(p0, p1, o, mref, l, first) do { float mxr_; AT_SM_MX(p0, p1, mxr_); AT_SM_RS(mxr_, o, mref, l, first); } while (0)
#define AT_SM_EXP(p0, p1, mref, l) do { \
        float sacc = 0.f; \
        _Pragma("unroll") for (int r = 0; r < 16; ++r) { p0[r] = __builtin_amdgcn_exp2f(p0[r] - mref); p1[r] = __builtin_amdgcn_exp2f(p1[r] - mref); sacc += p0[r] + p1[r]; } \
        l += sacc; } while (0)
#define AT_SOFTMAX(p0, p1, o, mref, l, first) do { AT_SM_MAX(p0, p1, o, mref, l, first); AT_SM_EXP(p0, p1, mref, l); } while (0)
#define AT_PV(oX, pw) do { const LAS unsigned char* vbase = buf + AT_KB + vboff; \
        _Pragma("unroll") for (int d0 = 0; d0 < 2; ++d0) \
        _Pragma("unroll") for (int s4 = 0; s4 < 4; ++s4) { \
            const s16x4 vlo = vtr(vbase + d0 * 4096 + s4 * 1024), vhi = vtr(vbase + d0 * 4096 + s4 * 1024 + 512); \
            const bf16x8 vf = (bf16x8){vlo[0], vlo[1], vlo[2], vlo[3], vhi[0], vhi[1], vhi[2], vhi[3]}; \
            oX[d0] = __builtin_amdgcn_mfma_f32_32x32x16_bf16(vf, __builtin_bit_cast(bf16x8, pw[s4]), oX[d0], 0, 0, 0); } } while (0)
#define AT_PACK(pw, p0, p1) _Pragma("unroll") for (int s4 = 0; s4 < 4; ++s4) { const f32x16& p = (s4 < 2) ? p0 : p1; const int o = 8 * (s4 & 1); \
            pw[s4] = (u32x4){cvtpk(p[o], p[o + 1]), cvtpk(p[o + 2], p[o + 3]), cvtpk(p[o + 4], p[o + 5]), cvtpk(p[o + 6], p[o + 7])}; }
    float mrefa = 0.f, mrefb = 0.f, la = 0.f, lb = 0.f; bool firsta = true, firstb = true;
    f32x16 csa = f32x16{}, csb = f32x16{};
    if (MODE == 0) { asm volatile("" : "+v"(csa)); asm volatile("" : "+v"(csb)); }
    oT[0][0] = f32x16{}; oT[0][1] = f32x16{}; oT[1][0] = f32x16{}; oT[1][1] = f32x16{};
    AT_SYNC();
    for (int t = 0; t < NT; ++t) {
        const int cur = t & 1;
        if (t + 1 < NT) AT_DMA(t + 1, cur ^ 1);
        if (MODE == 0 && t > tlast && t <= tlastb) {
            const LAS unsigned char* buf = lds + cur * AT_BUF;
            f32x16 pb0 = csb, pb1 = csb;
            { const LAS unsigned char* kb = buf + hi * 1024 + r32 * 16;

#pragma unroll
              for (int d0 = 0; d0 < NKS; ++d0) { const bf16x8 a0 = *(const LAS bf16x8*)(kb + d0 * 2048), a1 = *(const LAS bf16x8*)(kb + d0 * 2048 + 512);
                  pb0 = __builtin_amdgcn_mfma_f32_32x32x16_bf16(a0, qf[1][d0], pb0, 0, 0, 0); pb1 = __builtin_amdgcn_mfma_f32_32x32x16_bf16(a1, qf[1][d0], pb1, 0, 0, 0); }
               }
            if (t * 64 + 63 > tqbaseb) { const int kb0 = t * 64 + 4 * hi, tqb = tqbaseb + (lane_id_nohoist() & 31);
#pragma unroll
                for (int r = 0; r < 16; ++r) { const int ks = kb0 + (r & 3) + 8 * (r >> 2); if (ks > tqb) pb0[r] = -INFINITY; if (ks + 32 > tqb) pb1[r] = -INFINITY; } }
            { float mxb_; AT_SM_MX(pb0, pb1, mxb_); AT_SM_RS0(mxb_, pb0, pb1, csb, oT[1], mrefb, lb, firstb); AT_SM_EXP0(pb0, pb1, lb); }
            u32x4 pwb[4];
            AT_PACK(pwb, pb0, pb1)
            { const LAS unsigned char* vbase = buf + AT_KB + vboff;

#pragma unroll
              for (int d0 = 0; d0 < 2; ++d0)
#pragma unroll
                  for (int s4 = 0; s4 < 4; ++s4) {
                      const s16x4 vlo = vtr(vbase + d0 * 4096 + s4 * 1024), vhi = vtr(vbase + d0 * 4096 + s4 * 1024 + 512);
                      const bf16x8 vf = (bf16x8){vlo[0], vlo[1], vlo[2], vlo[3], vhi[0], vhi[1], vhi[2], vhi[3]};
                      oT[1][d0] = __builtin_amdgcn_mfma_f32_32x32x16_bf16(vf, __builtin_bit_cast(bf16x8, pwb[s4]), oT[1][d0], 0, 0, 0);
                  }
               }
        } else
        if (t <= tlast) {
        const LAS unsigned char* buf = lds + cur * AT_BUF;
        f32x16 pa0 = (MODE == 0) ? csa : f32x16{}, pa1 = pa0, pb0 = (MODE == 0) ? csb : f32x16{}, pb1 = pb0;
        if (MODE == 1) {
            const u32x2 mwa = *(const LAS u32x2*)(buf + AT_MSK + (qjbase + (lane_id_nohoist() & 31)) * 8);
            const unsigned wa0 = ~(mwa.x >> (4 * hi)), wa1 = ~(mwa.y >> (4 * hi));
#define DSA_MI(r) { int m0_, m1_; asm("v_bfe_i32 %0, %1, %2, 1" : "=v"(m0_) : "v"(wa0), "n"(8 * ((r) >> 2) + ((r) & 3))); asm("v_bfe_i32 %0, %1, %2, 1" : "=v"(m1_) : "v"(wa1), "n"(8 * ((r) >> 2) + ((r) & 3))); \
                pa0[r] = __uint_as_float((unsigned)m0_ & 0xff800000u); pa1[r] = __uint_as_float((unsigned)m1_ & 0xff800000u); }
            DSA_MI(0) DSA_MI(1) DSA_MI(2) DSA_MI(3) DSA_MI(4) DSA_MI(5) DSA_MI(6) DSA_MI(7) DSA_MI(8) DSA_MI(9) DSA_MI(10) DSA_MI(11) DSA_MI(12) DSA_MI(13) DSA_MI(14) DSA_MI(15)
#undef DSA_MI
        }
        float mxa_, mxb_;
        if (MODE == 0) {
        { const LAS unsigned char* kb = buf + hi * 1024 + r32 * 16;
#pragma unroll
          for (int d0 = 0; d0 < NKS; ++d0) { const bf16x8 a0 = *(const LAS bf16x8*)(kb + d0 * 2048), a1 = *(const LAS bf16x8*)(kb + d0 * 2048 + 512);
              pa0 = __builtin_amdgcn_mfma_f32_32x32x16_bf16(a0, qf[0][d0], pa0, 0, 0, 0); pa1 = __builtin_amdgcn_mfma_f32_32x32x16_bf16(a1, qf[0][d0], pa1, 0, 0, 0);
              pb0 = __builtin_amdgcn_mfma_f32_32x32x16_bf16(a0, qf[1][d0], pb0, 0, 0, 0); pb1 = __builtin_amdgcn_mfma_f32_32x32x16_bf16(a1, qf[1][d0], pb1, 0, 0, 0); } }
            if (t * 64 + 63 > tqbase) { const int kb0 = t * 64 + 4 * hi, tqa = tqbase + (lane_id_nohoist() & 31), tqb = tqbaseb + (lane_id_nohoist() & 31);
#pragma unroll
                for (int r = 0; r < 16; ++r) { const int ks = kb0 + (r & 3) + 8 * (r >> 2);
                    if (ks > tqa) pa0[r] = -INFINITY; if (ks + 32 > tqa) pa1[r] = -INFINITY; if (ks > tqb) pb0[r] = -INFINITY; if (ks + 32 > tqb) pb1[r] = -INFINITY; } }
            AT_SM_MX(pa0, pa1, mxa_); AT_SM_MX(pb0, pb1, mxb_);
        } else {
            const LAS unsigned char* kb = buf + hi * 1024 + r32 * 16;
            { const bf16x8 a0 = *(const LAS bf16x8*)(kb), a1 = *(const LAS bf16x8*)(kb + 512);
              pb0 = __builtin_amdgcn_mfma_f32_32x32x16_bf16(a0, qf[1][0], pa0, 0, 0, 0); pb1 = __builtin_amdgcn_mfma_f32_32x32x16_bf16(a1, qf[1][0], pa1, 0, 0, 0);
              pa0 = __builtin_amdgcn_mfma_f32_32x32x16_bf16(a0, qf[0][0], pa0, 0, 0, 0); pa1 = __builtin_amdgcn_mfma_f32_32x32x16_bf16(a1, qf[0][0], pa1, 0, 0, 0); }
#pragma unroll
            for (int d0 = 1; d0 < NKS; ++d0) { const bf16x8 a0 = *(const LAS bf16x8*)(kb + d0 * 2048), a1 = *(const LAS bf16x8*)(kb + d0 * 2048 + 512);
                pa0 = __builtin_amdgcn_mfma_f32_32x32x16_bf16(a0, qf[0][d0], pa0, 0, 0, 0); pa1 = __builtin_amdgcn_mfma_f32_32x32x16_bf16(a1, qf[0][d0], pa1, 0, 0, 0); }
#pragma unroll
            for (int c = 0; c < 4; ++c) { const f32x4 k0 = *(const LAS f32x4*)(buf + AT_POS + (4 * hi + 8 * c) * 4), k1 = *(const LAS f32x4*)(buf + AT_POS + (32 + 4 * hi + 8 * c) * 4);
#pragma unroll
                for (int j = 0; j < 4; ++j) { const int r = 4 * c + j;
                    pa0[r] = __builtin_fmaf(nsa, __builtin_fabsf(pta - k0[j]), pa0[r]); pa1[r] = __builtin_fmaf(nsa, __builtin_fabsf(pta - k1[j]), pa1[r]); } }
            AT_SM_MX(pa0, pa1, mxa_);
#pragma unroll
            for (int d0 = 1; d0 < NKS; ++d0) { const bf16x8 a0 = *(const LAS bf16x8*)(kb + d0 * 2048), a1 = *(const LAS bf16x8*)(kb + d0 * 2048 + 512);
                pb0 = __builtin_amdgcn_mfma_f32_32x32x16_bf16(a0, qf[1][d0], pb0, 0, 0, 0); pb1 = __builtin_amdgcn_mfma_f32_32x32x16_bf16(a1, qf[1][d0], pb1, 0, 0, 0); }
#pragma unroll
            for (int c = 0; c < 4; ++c) { const f32x4 k0 = *(const LAS f32x4*)(buf + AT_POS + (4 * hi + 8 * c) * 4), k1 = *(const LAS f32x4*)(buf + AT_POS + (32 + 4 * hi + 8 * c) * 4);
#pragma unroll
                for (int j = 0; j < 4; ++j) { const int r = 4 * c + j;
                    pb0[r] = __builtin_fmaf(nsb, __builtin_fabsf(pta - k0[j]), pb0[r]); pb1[r] = __builtin_fmaf(nsb, __builtin_fabsf(pta - k1[j]), pb1[r]); } }
            AT_SM_MX(pb0, pb1, mxb_);
        }
        if (MODE == 0) { AT_SM_RS0(mxa_, pa0, pa1, csa, oT[0], mrefa, la, firsta); AT_SM_RS0(mxb_, pb0, pb1, csb, oT[1], mrefb, lb, firstb); AT_SM_EXP0(pa0, pa1, la); }
        else { AT_SM_RS(mxa_, oT[0], mrefa, la, firsta); AT_SM_RS(mxb_, oT[1], mrefb, lb, firstb); AT_SM_EXP(pa0, pa1, mrefa, la); }
        u32x4 pwa[4];
        AT_PACK(pwa, pa0, pa1)
        AT_PV(oT[0], pwa);
        if (MODE == 0) AT_SM_EXP0(pb0, pb1, lb); else AT_SM_EXP(pb0, pb1, mrefb, lb);
        u32x4 pwb[4];
        AT_PACK(pwb, pb0, pb1)
        AT_PV(oT[1], pwb);
        }
        AT_SYNC();
    }
    l_out[0] = la; l_out[1] = lb;
#undef AT_DMA
#undef AT_SOFTMAX
#undef AT_SM_MAX
#undef AT_SM_MX
#undef AT_SM_RS
#undef AT_SM_RS0
#undef AT_SM_EXP0
#undef AT_SM_EXP
#undef AT_PV
#undef AT_PACK
}
__device__ __forceinline__ void attn_zfetch(u32x2 (&zz)[8], const bf16_t* PROJ, size_t tbase, int ch) {
    const int ln = lane_id_nohoist(), r32 = ln & 31, hi = ln >> 5;
    const bf16_t* szrow = PROJ + proj_off(tbase + r32, C_Z + ch) + 4 * hi;
#pragma unroll
    for (int k = 0; k < 8; ++k) zz[k] = *(const u32x2*)(szrow + k * 128);
}
__device__ __forceinline__ void attn_store(const f32x16 (&oT)[2], float l, const u32x2 (&zz)[8], bf16_t* OAB, float* OSS, size_t tbase, int ch, int ohead) {
    const int ln = lane_id_nohoist(), r32 = ln & 31, hi = ln >> 5;
    const size_t grow = tbase + r32;
    bf16_t* orow = OAB + (ch < 512 ? 0 : OB_DELTA) + (long)(grow * 512 + (size_t)(ch & 511));
    l = swap32_sum(l);
    const float inv = 1.0f / l;
    float ssq = 0.f;
#pragma unroll
    for (int d0 = 0; d0 < 2; ++d0)
#pragma unroll
        for (int c = 0; c < 4; ++c) {
            const u32x2 z = zz[4 * d0 + c];
            const float a = oT[d0][4 * c] * inv, b = oT[d0][4 * c + 1] * inv, cc = oT[d0][4 * c + 2] * inv, d = oT[d0][4 * c + 3] * inv;
            ssq += (a * a + b * b) + (cc * cc + d * d);
            *(u32x2*)(orow + 32 * d0 + 8 * c + 4 * hi) = (u32x2){cvtpk(a * bf_lo(z.x), b * bf_hi(z.x)), cvtpk(cc * bf_lo(z.y), d * bf_hi(z.y))};
        }
    ssq = swap32_sum(ssq);
    if (hi == 0) OSS[grow * 16 + ohead] = ssq;
}

__device__ __forceinline__ void mla_prime(int b, int h, int qb, const bf16_t* QB, const bf16_t* KNC, const bf16_t* VBC, const bf16_t* KRC, LAS unsigned char* lds, const int wid, bf16x8 (&qf)[2][6]) {
    const int lane = lane_id(), r32 = lane & 31, hi = lane >> 5;
    const size_t rowbase = (size_t)b * S; const int q0 = qb * 512, ra0 = q0 + 32 * wid, rb0 = q0 + 32 * (15 - wid);
    const size_t hb = ((size_t)(b * 8 + h) * S) * 64;
#pragma unroll
    for (int c = 0; c < 2; ++c) { const bf16_t* qrow = QB + (rowbase + (c ? rb0 : ra0) + r32) * NQB;
#pragma unroll
      for (int d0 = 0; d0 < 4; ++d0) qf[c][d0] = *(const bf16x8*)(qrow + h * 64 + d0 * 16 + hi * 8);
#pragma unroll
      for (int d0 = 4; d0 < 6; ++d0) qf[c][d0] = *(const bf16x8*)(qrow + 512 + h * 32 + (d0 - 4) * 16 + hi * 8); }
    attn_prime<0>(KNC + hb + wid * 512, KRC + rowbase * 32 + (wid & 3) * 512, VBC + hb + wid * 512, nullptr, nullptr, lds, wid);
}
__device__ __forceinline__ void mla_unit(int b, int h, int qb, int qb_next, bf16x8 (&qf)[2][6], const bf16_t* QB, const bf16_t* PROJ, const bf16_t* KNC, const bf16_t* VBC, const bf16_t* KRC, bf16_t* OAB, float* OSS, LAS unsigned char* lds, const int wid) {
    const int lane = lane_id();
    const size_t rowbase = (size_t)b * S; const int q0 = qb * 512, ra0 = q0 + 32 * wid, rb0 = q0 + 32 * (15 - wid);
    const size_t hb = ((size_t)(b * 8 + h) * S) * 64;
    f32x16 oT[2][2]; float l[2];
    attn_core<0>(qf, 8 * (qb + 1), (ra0 + 31) >> 6, ra0, (rb0 + 31) >> 6, rb0, KNC + hb + wid * 512, KRC + rowbase * 32 + (wid & 3) * 512, VBC + hb + wid * 512,
                 nullptr, nullptr, 0.f, 0.f, 0.f, 0, lds, wid, lane, oT, l);
    u32x2 za[8], zb[8];
    attn_zfetch(za, PROJ, rowbase + ra0, 512 + h * 64); attn_zfetch(zb, PROJ, rowbase + rb0, 512 + h * 64);
    if (qb_next >= 0) mla_prime(b, h, qb_next, QB, KNC, VBC, KRC, lds, wid, qf);
    attn_store(oT[0], l[0], za, OAB, OSS, rowbase + ra0, 512 + h * 64, 8 + h);
    attn_store(oT[1], l[1], zb, OAB, OSS, rowbase + rb0, 512 + h * 64, 8 + h);
}
__device__ __forceinline__ void dsa_prime(int b, int g, int qb, const bf16_t* PROJ, const bf16_t* KAC, const bf16_t* VAC, const unsigned long long* MASKT, const float* POSF, LAS unsigned char* lds, const int wid,
                                          bf16x8 (&qf)[2][6], float& pta) {
    const int lane = lane_id(), r32 = lane & 31, hi = lane >> 5;
    const size_t rowbase = (size_t)b * S; const int q0 = qb * 128, qblk = wid >> 1, head0 = 4 * g + 2 * (wid & 1), tqa = q0 + 32 * qblk + r32;
    const size_t gb = ((size_t)(b * 2 + g) * S) * 64;
#pragma unroll
    for (int c = 0; c < 2; ++c) { const bf16_t* qrow = PROJ + proj_off(rowbase + tqa, C_QA + (head0 + c) * 64 + hi * 8);
#pragma unroll
      for (int d0 = 0; d0 < 4; ++d0) qf[c][d0] = *(const bf16x8*)(qrow + d0 * 256);
      qf[c][4] = qf[c][0]; qf[c][5] = qf[c][0]; }
    pta = POSF[rowbase + tqa];
    attn_prime<1>(KAC + gb + wid * 512, nullptr, VAC + gb + wid * 512, MASKT + ((size_t)(b * 64 + 2 * qb) * 64) * 64, POSF + rowbase, lds, wid);
}
__device__ __forceinline__ void dsa_unit(int b, int g, int qb, int qb_next, bf16x8 (&qf)[2][6], float& pta_io, const bf16_t* PROJ, const bf16_t* KAC, const bf16_t* VAC, const unsigned long long* MASKT, const float* POSF,
                                         bf16_t* OAB, float* OSS, LAS unsigned char* lds, const int wid) {
    const int lane = lane_id();
    const size_t rowbase = (size_t)b * S; const int q0 = qb * 128, qblk = wid >> 1, head0 = 4 * g + 2 * (wid & 1);
    const size_t gb = ((size_t)(b * 2 + g) * S) * 64;
    const float pta = pta_io;
    const float nsa = -__builtin_amdgcn_exp2f(-(float)(head0 + 1)) * LOG2E, nsb = 0.5f * nsa;
    f32x16 oT[2][2]; float l[2];
    attn_core<1>(qf, 2 * (qb + 1), (q0 + 32 * qblk + 31) >> 6, q0 + 32 * qblk, (q0 + 32 * qblk + 31) >> 6, q0 + 32 * qblk, KAC + gb + wid * 512, nullptr, VAC + gb + wid * 512,
                 MASKT + ((size_t)(b * 64 + 2 * qb) * 64) * 64, POSF + rowbase, pta, nsa, nsb, 32 * qblk, lds, wid, lane, oT, l);
    u32x2 za[8], zb[8];
    attn_zfetch(za, PROJ, rowbase + q0 + 32 * qblk, head0 * 64); attn_zfetch(zb, PROJ, rowbase + q0 + 32 * qblk, (head0 + 1) * 64);
    if (qb_next >= 0) dsa_prime(b, g, qb_next, PROJ, KAC, VAC, MASKT, POSF, lds, wid, qf, pta_io);
    attn_store(oT[0], l[0], za, OAB, OSS, rowbase + q0 + 32 * qblk, head0 * 64, head0);
    attn_store(oT[1], l[1], zb, OAB, OSS, rowbase + q0 + 32 * qblk, (head0 + 1) * 64, head0 + 1);
}

__device__ __forceinline__ int wave_sum_i(int x) {
    x += __builtin_amdgcn_update_dpp(0, x, 0xB1, 0xf, 0xf, true);
    x += __builtin_amdgcn_update_dpp(0, x, 0x4E, 0xf, 0xf, true);
    x += __builtin_amdgcn_update_dpp(0, x, 0x141, 0xf, 0xf, true);
    x += __builtin_amdgcn_update_dpp(0, x, 0x140, 0xf, 0xf, true);
    { auto r = __builtin_amdgcn_permlane16_swap((unsigned)x, (unsigned)x, false, false); x = (int)(r[0] + r[1]); }
    { auto r = __builtin_amdgcn_permlane32_swap((unsigned)x, (unsigned)x, false, false); x = (int)(r[0] + r[1]); }
    return __builtin_amdgcn_readfirstlane(x);
}
__device__ __forceinline__ int wave_sum_rb(int x) {
    x += __builtin_amdgcn_update_dpp(0, x, 0xB1, 0xf, 0xf, true);
    x += __builtin_amdgcn_update_dpp(0, x, 0x4E, 0xf, 0xf, true);
    x += __builtin_amdgcn_update_dpp(0, x, 0x141, 0xf, 0xf, true);
    x += __builtin_amdgcn_update_dpp(0, x, 0x140, 0xf, 0xf, true);
    x += __builtin_amdgcn_update_dpp(0, x, 0x142, 0xa, 0xf, false);
    x += __builtin_amdgcn_update_dpp(0, x, 0x143, 0xc, 0xf, false);
    return __builtin_amdgcn_readlane(x, 63);
}
__device__ __forceinline__ float wave_max_f(float x) {
    x = fmaxf(x, __uint_as_float(__builtin_amdgcn_update_dpp(0, __float_as_uint(x), 0xB1, 0xf, 0xf, true)));
    x = fmaxf(x, __uint_as_float(__builtin_amdgcn_update_dpp(0, __float_as_uint(x), 0x4E, 0xf, 0xf, true)));
    x = fmaxf(x, __uint_as_float(__builtin_amdgcn_update_dpp(0, __float_as_uint(x), 0x141, 0xf, 0xf, true)));
    x = fmaxf(x, __uint_as_float(__builtin_amdgcn_update_dpp(0, __float_as_uint(x), 0x140, 0xf, 0xf, true)));
    { auto r = __builtin_amdgcn_permlane16_swap(__float_as_uint(x), __float_as_uint(x), false, false); x = fmaxf(__uint_as_float(r[0]), __uint_as_float(r[1])); }
    { auto r = __builtin_amdgcn_permlane32_swap(__float_as_uint(x), __float_as_uint(x), false, false); x = fmaxf(__uint_as_float(r[0]), __uint_as_float(r[1])); }
    return __uint_as_float(__builtin_amdgcn_readfirstlane(__float_as_uint(x)));
}
typedef short s16x2_t __attribute__((ext_vector_type(2)));
#define SEL_P4(k0, k1, k2, k3) \
    "v_pk_sub_u16 %2, %" #k0 ", %14 clamp\n\tv_pk_sub_u16 %3, %" #k1 ", %14 clamp\n\tv_pk_sub_u16 %4, %" #k2 ", %14 clamp\n\tv_pk_sub_u16 %5, %" #k3 ", %14 clamp\n\t" \
    "v_pk_min_u16 %2, %2, %15\n\tv_pk_min_u16 %3, %3, %15\n\tv_pk_min_u16 %4, %4, %15\n\tv_pk_min_u16 %5, %5, %15\n\t" \
    "v_pk_add_u16 %0, %0, %2\n\tv_pk_add_u16 %1, %1, %3\n\tv_pk_add_u16 %0, %0, %4\n\tv_pk_add_u16 %1, %1, %5\n\t"
#define SEL_P8_ASM(a0, a1, K, base, t1, one2) do { unsigned q0_, q1_, q2_, q3_; asm volatile( \
    SEL_P4(6, 7, 8, 9) SEL_P4(10, 11, 12, 13) \
    : "+v"(a0), "+v"(a1), "=&v"(q0_), "=&v"(q1_), "=&v"(q2_), "=&v"(q3_) \
    : "v"(K[(base) + 0]), "v"(K[(base) + 1]), "v"(K[(base) + 2]), "v"(K[(base) + 3]), "v"(K[(base) + 4]), "v"(K[(base) + 5]), "v"(K[(base) + 6]), "v"(K[(base) + 7]), "s"(t1), "s"(one2)); } while (0)
__device__ __forceinline__ int wave_sum_pk(unsigned x) {
    x += (unsigned)__builtin_amdgcn_update_dpp(0, (int)x, 0xB1, 0xf, 0xf, true);
    x += (unsigned)__builtin_amdgcn_update_dpp(0, (int)x, 0x4E, 0xf, 0xf, true);
    x += (unsigned)__builtin_amdgcn_update_dpp(0, (int)x, 0x141, 0xf, 0xf, true);
    x += (unsigned)__builtin_amdgcn_update_dpp(0, (int)x, 0x140, 0xf, 0xf, true);
    x += (unsigned)__builtin_amdgcn_update_dpp(0, (int)x, 0x142, 0xa, 0xf, false);
    x += (unsigned)__builtin_amdgcn_update_dpp(0, (int)x, 0x143, 0xc, 0xf, false);
    const unsigned r = (unsigned)__builtin_amdgcn_readlane((int)x, 63);
    return (int)((r & 0xffffu) + (r >> 16));
}
__device__ __forceinline__ unsigned pk_min_u16(unsigned a, unsigned b) { unsigned d; asm("v_pk_min_u16 %0, %1, %2" : "=v"(d) : "v"(a), "v"(b)); return d; }
__device__ __forceinline__ unsigned wave_min_u(unsigned x) {
    { const unsigned y = (unsigned)__builtin_amdgcn_update_dpp(0, (int)x, 0xB1, 0xf, 0xf, true); x = x < y ? x : y; }
    { const unsigned y = (unsigned)__builtin_amdgcn_update_dpp(0, (int)x, 0x4E, 0xf, 0xf, true); x = x < y ? x : y; }
    { const unsigned y = (unsigned)__builtin_amdgcn_update_dpp(0, (int)x, 0x141, 0xf, 0xf, true); x = x < y ? x : y; }
    { const unsigned y = (unsigned)__builtin_amdgcn_update_dpp(0, (int)x, 0x140, 0xf, 0xf, true); x = x < y ? x : y; }
    { auto r = __builtin_amdgcn_permlane16_swap(x, x, false, false); x = r[0] < r[1] ? r[0] : r[1]; }
    { auto r = __builtin_amdgcn_permlane32_swap(x, x, false, false); x = r[0] < r[1] ? r[0] : r[1]; }
    return (unsigned)__builtin_amdgcn_readfirstlane((int)x);
}
__device__ __forceinline__ unsigned long long wave_bit_transpose(unsigned long long w, int lane) {
#define WBT_STAGE(d, bm) { const unsigned long long p_ = __shfl_xor(w, d); w = (lane & (d)) ? ((w & ~(bm)) | ((p_ & ~(bm)) >> (d))) : ((w & (bm)) | ((p_ & (bm)) << (d))); }
    WBT_STAGE(32, 0x00000000FFFFFFFFull) WBT_STAGE(16, 0x0000FFFF0000FFFFull) WBT_STAGE(8, 0x00FF00FF00FF00FFull)
    WBT_STAGE(4, 0x0F0F0F0F0F0F0F0Full) WBT_STAGE(2, 0x3333333333333333ull) WBT_STAGE(1, 0x5555555555555555ull)
#undef WBT_STAGE
    return w;
}
__device__ __forceinline__ unsigned long long select_row(int t, const LAS unsigned* sc, int lane) {
    const int n = t + 1;
    if (n <= KTOP) {
        const int cnt = n - 64 * (2 * (lane & 31) + (lane >> 5));
        return cnt >= 64 ? ~0ull : (cnt <= 0 ? 0ull : ((1ull << cnt) - 1ull));
    }
    const int nw = (n + 127) >> 7;
    unsigned kv[32];
#define SEL_LD8(base) _Pragma("unroll") for (int j = (base); j < (base) + 8; ++j) kv[j] = sc[64 * j + lane];
#define SEL_Z8(base) _Pragma("unroll") for (int j = (base); j < (base) + 8; ++j) kv[j] = 0u;
    SEL_LD8(0)
    if (nw > 8) { SEL_LD8(8) } else { SEL_Z8(8) }
    if (nw > 16) { SEL_LD8(16) } else { SEL_Z8(16) }
    if (nw > 24) { SEL_LD8(24) } else { SEL_Z8(24) }
#undef SEL_LD8
#undef SEL_Z8
#pragma unroll
    for (int j = 0; j < 16; ++j) { const unsigned a = kv[j], b = kv[j + 16]; kv[j] = __builtin_amdgcn_perm(b, a, 0x05040100u); kv[j + 16] = __builtin_amdgcn_perm(b, a, 0x07060302u); }
#pragma unroll
    for (int j = 0; j < 32; ++j) if (!(j & 8)) { const unsigned a = kv[j], b = kv[j + 8]; kv[j] = __builtin_amdgcn_perm(b, a, 0x06020400u); kv[j + 8] = __builtin_amdgcn_perm(b, a, 0x07030501u); }
#define SEL_TSTAGE(m, sh) _Pragma("unroll") for (int j = 0; j < 32; ++j) if (!(j & (sh))) { const unsigned a = kv[j], b = kv[j + (sh)]; \
        kv[j] = (a & (m)) | ((b << (sh)) & ~(m)); kv[j + (sh)] = ((a >> (sh)) & (m)) | (b & ~(m)); }
    SEL_TSTAGE(0x0f0f0f0fu, 4) SEL_TSTAGE(0x33333333u, 2) SEL_TSTAGE(0x55555555u, 1)
#undef SEL_TSTAGE
    const int nl = n - lane, c0 = (nl + 127) >> 7, c1 = (nl + 63) >> 7;
    unsigned cand0 = c0 >= 32 ? ~0u : ((1u << c0) - 1u), cand1 = c1 >= 32 ? ~0u : ((1u << c1) - 1u);
    unsigned sel0 = 0u, sel1 = 0u; int need = KTOP; bool done = false;
    const unsigned sg0 = kv[15], sg1 = kv[31];
#pragma unroll
    for (int b = 15; b >= 0; --b) {
        if (!done) {
            const unsigned p0 = (b == 15) ? ~sg0 : (kv[b] ^ sg0), p1 = (b == 15) ? ~sg1 : (kv[16 + b] ^ sg1);
            const unsigned o0 = cand0 & p0, o1 = cand1 & p1;
            const int c = wave_sum_rb(__builtin_popcount(o0) + __builtin_popcount(o1));
            if (c >= need) { cand0 = o0; cand1 = o1;
                if (c == need) { sel0 |= o0; sel1 |= o1; cand0 = 0u; cand1 = 0u; done = true; } }
            else { sel0 |= o0; sel1 |= o1; need -= c; cand0 &= ~p0; cand1 &= ~p1; }
        }
    }
    if (!done) {
#pragma unroll 1
        for (int r = 0; r < need; ++r) {
            const unsigned a0 = cand0 ? 2u * (unsigned)__builtin_ctz(cand0 | 0x80000000u) : 0xffffu, a1 = cand1 ? 2u * (unsigned)__builtin_ctz(cand1 | 0x80000000u) + 1u : 0xffffu;
            const unsigned m = wave_min_u((a0 < a1 ? a0 : a1) * 64u + (unsigned)lane);
            const unsigned cs = m >> 6, ls = m & 63u;
            if ((unsigned)lane == ls) { const unsigned bit = 1u << (cs >> 1); if (cs & 1u) { cand1 &= ~bit; sel1 |= bit; } else { cand0 &= ~bit; sel0 |= bit; } }
        }
    }
    return wave_bit_transpose((unsigned long long)sel0 | ((unsigned long long)sel1 << 32), lane);
}

__device__ __forceinline__ void select_row2(int tA, const LAS unsigned* scA, const LAS unsigned* scB, int lane, unsigned long long& outA, unsigned long long& outB) {
    const int nA = tA + 1, nB = tA + 9;
    if (nB <= KTOP) {
        const int tl = 64 * (2 * (lane & 31) + (lane >> 5)), ca = nA - tl, cb = nB - tl;
        outA = ca >= 64 ? ~0ull : (ca <= 0 ? 0ull : ((1ull << ca) - 1ull)); outB = cb >= 64 ? ~0ull : (cb <= 0 ? 0ull : ((1ull << cb) - 1ull));
        return;
    }
    const int nw = (nB + 127) >> 7;
    unsigned ka[32], kb[32];
#define SEL_LD8(base) _Pragma("unroll") for (int j = (base); j < (base) + 8; ++j) { ka[j] = scA[64 * j + lane]; kb[j] = scB[64 * j + lane]; }
#define SEL_Z8(base) _Pragma("unroll") for (int j = (base); j < (base) + 8; ++j) { ka[j] = 0u; kb[j] = 0u; }
    SEL_LD8(0)
    if (nw > 8) { SEL_LD8(8) } else { SEL_Z8(8) }
    if (nw > 16) { SEL_LD8(16) } else { SEL_Z8(16) }
    if (nw > 24) { SEL_LD8(24) } else { SEL_Z8(24) }
#undef SEL_LD8
#undef SEL_Z8
#define SEL_TR(kv) { \
    _Pragma("unroll") for (int j = 0; j < 16; ++j) { const unsigned a = kv[j], b = kv[j + 16]; kv[j] = __builtin_amdgcn_perm(b, a, 0x05040100u); kv[j + 16] = __builtin_amdgcn_perm(b, a, 0x07060302u); } \
    _Pragma("unroll") for (int j = 0; j < 32; ++j) if (!(j & 8)) { const unsigned a = kv[j], b = kv[j + 8]; kv[j] = __builtin_amdgcn_perm(b, a, 0x06020400u); kv[j + 8] = __builtin_amdgcn_perm(b, a, 0x07030501u); } \
    SEL_TSTAGE(kv, 0x0f0f0f0fu, 4) SEL_TSTAGE(kv, 0x33333333u, 2) SEL_TSTAGE(kv, 0x55555555u, 1) }
#define SEL_TSTAGE(kv, m, sh) _Pragma("unroll") for (int j = 0; j < 32; ++j) if (!(j & (sh))) { const unsigned a = kv[j], b = kv[j + (sh)]; \
        kv[j] = (a & (m)) | ((b << (sh)) & ~(m)); kv[j + (sh)] = ((a >> (sh)) & (m)) | (b & ~(m)); }
    SEL_TR(ka) SEL_TR(kb)
#undef SEL_TR
#undef SEL_TSTAGE
    const int nlA = nA - lane, nlB = nB - lane, cA0 = (nlA + 127) >> 7, cA1 = (nlA + 63) >> 7, cB0 = (nlB + 127) >> 7, cB1 = (nlB + 63) >> 7;
    unsigned candA0 = cA0 >= 32 ? ~0u : (cA0 <= 0 ? 0u : ((1u << cA0) - 1u)), candA1 = cA1 >= 32 ? ~0u : (cA1 <= 0 ? 0u : ((1u << cA1) - 1u));
    unsigned candB0 = cB0 >= 32 ? ~0u : (cB0 <= 0 ? 0u : ((1u << cB0) - 1u)), candB1 = cB1 >= 32 ? ~0u : (cB1 <= 0 ? 0u : ((1u << cB1) - 1u));
    unsigned selA0 = 0u, selA1 = 0u, selB0 = 0u, selB1 = 0u; int needA = nA < KTOP ? nA : KTOP, needB = KTOP;
    const unsigned sA0 = ka[15], sA1 = ka[31], sB0 = kb[15], sB1 = kb[31];
#pragma unroll
    for (int b = 15; b >= 0; --b) {
        const unsigned pA0 = (b == 15) ? ~sA0 : (ka[b] ^ sA0), pA1 = (b == 15) ? ~sA1 : (ka[16 + b] ^ sA1), pB0 = (b == 15) ? ~sB0 : (kb[b] ^ sB0), pB1 = (b == 15) ? ~sB1 : (kb[16 + b] ^ sB1);
        const unsigned oA0 = candA0 & pA0, oA1 = candA1 & pA1, oB0 = candB0 & pB0, oB1 = candB1 & pB1;
        const int cAB = wave_sum_rb((__builtin_popcount(oA0) + __builtin_popcount(oA1)) | ((__builtin_popcount(oB0) + __builtin_popcount(oB1)) << 16));
        const int cA = cAB & 0xffff, cB = (int)((unsigned)cAB >> 16);
        const bool gA = cA > needA, gB = cB > needB;
        selA0 |= gA ? 0u : oA0; selA1 |= gA ? 0u : oA1; candA0 = gA ? oA0 : (candA0 & ~pA0); candA1 = gA ? oA1 : (candA1 & ~pA1); needA -= gA ? 0 : cA;
        selB0 |= gB ? 0u : oB0; selB1 |= gB ? 0u : oB1; candB0 = gB ? oB0 : (candB0 & ~pB0); candB1 = gB ? oB1 : (candB1 & ~pB1); needB -= gB ? 0 : cB;
    }
#define SEL_REST(cand0, cand1, sel0, sel1, need) _Pragma("unroll 1") for (int r = 0; r < need; ++r) { \
        const unsigned a0 = cand0 ? 2u * (unsigned)__builtin_ctz(cand0 | 0x80000000u) : 0xffffu, a1 = cand1 ? 2u * (unsigned)__builtin_ctz(cand1 | 0x80000000u) + 1u : 0xffffu; \
        const unsigned m = wave_min_u((a0 < a1 ? a0 : a1) * 64u + (unsigned)lane); \
        const unsigned cs = m >> 6, ls = m & 63u; \
        if ((unsigned)lane == ls) { const unsigned bit = 1u << (cs >> 1); if (cs & 1u) { cand1 &= ~bit; sel1 |= bit; } else { cand0 &= ~bit; sel0 |= bit; } } }
    SEL_REST(candA0, candA1, selA0, selA1, needA)
    SEL_REST(candB0, candB1, selB0, selB1, needB)
#undef SEL_REST
    outA = wave_bit_transpose((unsigned long long)selA0 | ((unsigned long long)selA1 << 32), lane);
    outB = wave_bit_transpose((unsigned long long)selB0 | ((unsigned long long)selB1 << 32), lane);
}

#define IDX_BAR() asm volatile("s_waitcnt lgkmcnt(0)\n\ts_barrier" ::: "memory")
#define IDX_BARV() asm volatile("s_waitcnt vmcnt(0) lgkmcnt(0)\n\ts_barrier" ::: "memory")
constexpr int IDX_QST = 131072;
__device__ __forceinline__ float fma_mix_lo(unsigned w2, float r, float s) { asm("v_fma_mix_f32 %0, %1, %2, %0 op_sel:[0,0,0] op_sel_hi:[1,0,0]" : "+v"(s) : "v"(w2), "v"(r)); return s; }
__device__ __forceinline__ float fma_mix_lo0(unsigned w2, float r) { float s; asm("v_fma_mix_f32 %0, %1, %2, 0 op_sel:[0,0,0] op_sel_hi:[1,0,0]" : "=v"(s) : "v"(w2), "v"(r)); return s; }
__device__ __forceinline__ float fma_mix_hi(unsigned w2, float r, float s) { asm("v_fma_mix_f32 %0, %1, %2, %0 op_sel:[1,0,0] op_sel_hi:[1,0,0]" : "+v"(s) : "v"(w2), "v"(r)); return s; }
__device__ __forceinline__ unsigned bf2_to_h2(unsigned u) { return __builtin_bit_cast(unsigned, __builtin_amdgcn_cvt_pkrtz(bf_lo(u), bf_hi(u))); }
__device__ __forceinline__ void idx_phase(int b, int sdeal, const bf16_t* PROJ, const bf16_t* IKC, unsigned long long* MASK, LAS unsigned char* lds, const int wid) {
    const int lane = lane_id(), r32 = lane & 31, hi = lane >> 5;
    const size_t rowbase = (size_t)b * S;
    LAS _Float16* SC = (LAS _Float16*)lds;
    const int qi = 2 * ((r32 >> 2) & 1) + (r32 >> 4), hd = (r32 & 3) + 4 * ((r32 >> 3) & 1);
    const int qcol = C_IQ + hd * 64 + hi * 8;
    const bf16_t* kbase = IKC + (rowbase + wid * 32) * 64 + hi * 256 + r32 * 8;
    const int scl = ((wid >> 2) * 64 + (wid & 1) * 32 + r32) * 2 + ((wid >> 1) & 1);
    bf16x8 af[4][4]; u32x4 wv[4][2]; bf16x8 f0[4], f1[4], f2[4];
#define IDX_J(u) (16 * (u) + (((u) & 1) ? 15 - sdeal : sdeal))
#define IDX_CNT(t0) ((((t0) + 16 + 31) >> 5) - wid + 7) >> 3
#define IDX_LOAD(dst, i, cnt) do { const int _i = ((i) < (cnt)) ? (i) : ((cnt) - 1); const bf16_t* _p = kbase + (size_t)_i * (256 * 64); \
        _Pragma("unroll") for (int d0 = 0; d0 < 4; ++d0) dst[d0] = *(const bf16x8*)(_p + d0 * 512); } while (0)
#define IDX_PREFETCH(t0) do { if ((t0) + 16 > KTOP) { const int _c = IDX_CNT(t0); const unsigned _l = (unsigned)lane_id_nohoist(); \
        _Pragma("unroll") for (int pp = 0; pp < 2; ++pp) { const int pi_ = 2 * wid + pp, mt_ = pi_ >> 2, d0_ = pi_ & 3; \
            const int r32_ = _l & 31, hi_ = _l >> 5, qi_ = 2 * ((r32_ >> 2) & 1) + (r32_ >> 4), hd_ = (r32_ & 3) + 4 * ((r32_ >> 3) & 1); \
            dma16(PROJ, (unsigned)((proj_off(rowbase + (t0) + 4 * mt_ + qi_, C_IQ + hd_ * 64 + hi_ * 8) + (size_t)d0_ * 256) * 2), (unsigned)__builtin_amdgcn_readfirstlane((int)(qst0 + pi_ * 1024))); } \
        if (wid == 7) dma4(PROJ, (unsigned)(proj_off(rowbase + (t0) + (_l >> 2), C_IW) * 2 + (_l & 3u) * 4u), (unsigned)__builtin_amdgcn_readfirstlane((int)(qst0 + 16384))); \
        IDX_LOAD(f0, 0, _c); IDX_LOAD(f1, 1, _c); } } while (0)
#define IDX_FETCHQ() do { \
        _Pragma("unroll") for (int mt = 0; mt < 4; ++mt) { \
            _Pragma("unroll") for (int d0 = 0; d0 < 4; ++d0) af[mt][d0] = *(const LAS bf16x8*)(lds + IDX_QST + (mt * 4 + d0) * 1024 + lane * 16); \
            _Pragma("unroll") for (int e = 0; e < 2; ++e) wv[mt][e] = *(const LAS u32x4*)(lds + IDX_QST + 16384 + (4 * mt + 2 * hi + e) * 16); } } while (0)
#define IDX_S8(acc, e, mt) do { float s; \
        s = fma_mix_lo0(wh[mt][e][0], relu_f(acc[8 * (e) + 0])); s = fma_mix_hi(wh[mt][e][0], relu_f(acc[8 * (e) + 1]), s); \
        s = fma_mix_lo(wh[mt][e][1], relu_f(acc[8 * (e) + 2]), s); s = fma_mix_hi(wh[mt][e][1], relu_f(acc[8 * (e) + 3]), s); \
        s = fma_mix_lo(wh[mt][e][2], relu_f(acc[8 * (e) + 4]), s); s = fma_mix_hi(wh[mt][e][2], relu_f(acc[8 * (e) + 5]), s); \
        s = fma_mix_lo(wh[mt][e][3], relu_f(acc[8 * (e) + 6]), s); s = fma_mix_hi(wh[mt][e][3], relu_f(acc[8 * (e) + 7]), s); \
        SC[(4 * (mt) + 2 * hi + (e)) * 4096 + 256 * (i_) + scl] = (_Float16)s; } while (0)
#define IDX_COMP(src, i) do { const int i_ = (i); _Pragma("unroll") for (int mt = 0; mt < 4; ++mt) { f32x16 a0 = f32x16{}; __builtin_amdgcn_s_setprio(1); \
        _Pragma("unroll") for (int d0 = 0; d0 < 4; ++d0) a0 = __builtin_amdgcn_mfma_f32_32x32x16_bf16(af[mt][d0], src[d0], a0, 0, 0, 0); __builtin_amdgcn_s_setprio(0); \
        IDX_S8(a0, 0, mt); IDX_S8(a0, 1, mt); } } while (0)
    const unsigned qst0 = (unsigned)(uintptr_t)lds + IDX_QST;
    { const int t0 = 16 * IDX_J(0); IDX_PREFETCH(t0); }
    IDX_BARV();
    for (int u = 0; u < 16; ++u) {
        const int t0 = 16 * IDX_J(u);
        if (t0 + 16 > KTOP) {
            IDX_FETCHQ();
            unsigned wh[4][2][4];
#pragma unroll
            for (int mt = 0; mt < 4; ++mt)
#pragma unroll
                for (int e = 0; e < 2; ++e) { wh[mt][e][0] = bf2_to_h2(wv[mt][e].x); wh[mt][e][1] = bf2_to_h2(wv[mt][e].y); wh[mt][e][2] = bf2_to_h2(wv[mt][e].z); wh[mt][e][3] = bf2_to_h2(wv[mt][e].w); }
            const int cnt = IDX_CNT(t0);
            for (int i = 0; i < cnt; i += 3) {
                IDX_LOAD(f2, i + 2, cnt); IDX_COMP(f0, i);
                if (i + 1 < cnt) { IDX_LOAD(f0, i + 3, cnt); IDX_COMP(f1, i + 1); }
                if (i + 2 < cnt) { IDX_LOAD(f1, i + 4, cnt); IDX_COMP(f2, i + 2); }
            }
        }
        IDX_BAR();
        if (u + 1 < 16) { const int t1 = 16 * IDX_J(u + 1); IDX_PREFETCH(t1); }
        unsigned long long mw0 = 0ull, mw1 = 0ull;
        select_row2(t0 + wid, (const LAS unsigned*)(SC + wid * 4096), (const LAS unsigned*)(SC + (8 + wid) * 4096), lane, mw0, mw1);
        { const int ta = t0 + wid, tb = t0 + 8 + wid;
          const size_t tile_ = (size_t)(2 * (lane & 31) + (lane >> 5));
          MASK[((size_t)(b * 64 + (ta >> 6)) * 64) * 64 + (ta & 63) + tile_ * 64] = mw0;
          MASK[((size_t)(b * 64 + (tb >> 6)) * 64) * 64 + (tb & 63) + tile_ * 64] = mw1; }
        IDX_BARV();
    }
#undef IDX_J
#undef IDX_CNT
#undef IDX_LOAD
#undef IDX_PREFETCH
#undef IDX_FETCHQ
#undef IDX_S8
#undef IDX_COMP
}

__device__ __forceinline__ void grid_bar(unsigned* ctr, unsigned target, int wave) {
    asm volatile("s_waitcnt vmcnt(0) lgkmcnt(0)" ::: "memory");
    __syncthreads();
    if (wave == 0 && lane_id() == 0) {
        __builtin_amdgcn_fence(__ATOMIC_RELEASE, "agent");
        asm volatile("s_waitcnt vmcnt(0)" ::: "memory");
        __hip_atomic_fetch_add(ctr, 1u, __ATOMIC_RELAXED, __HIP_MEMORY_SCOPE_AGENT);
        unsigned spins = 0;
        while (__hip_atomic_load(ctr, __ATOMIC_RELAXED, __HIP_MEMORY_SCOPE_AGENT) < target) { __builtin_amdgcn_s_sleep(2); if (++spins > (1u << 26)) break; }
        __builtin_amdgcn_fence(__ATOMIC_ACQUIRE, "agent");
        asm volatile("s_waitcnt vmcnt(0)" ::: "memory");
    }
    __syncthreads();
}

struct Args { const float* x; const int* pos; const float* w_in; const float* g_q; const float* w_uq; const float* g_kv; const float* w_ukv; const float* g_oa; const float* g_ob;
              const float* w_out; const float* ln_g; const float* ln_b; float* out; unsigned char* ws; int ph_lo, ph_hi; };

__device__ __forceinline__ void src_map(int kind, int n, int& src, float& sc) {
    sc = 1.f;
    if (kind == 0) {
        if (n < 512) { src = n; sc = QA_SCALE; }
        else if (n < 1280) src = n;
        else if (n < 1664) src = n - 1280 + 1352;
        else if (n < 1920) src = n - 1664 + 1736;
        else if (n < 1984) src = n - 1920 + 1280;
        else if (n < 2016) { const int e = n - 1984; src = 1992 + (e >> 1) + 16 * (e & 1); }
        else if (n < 2024) { src = n - 2016 + 1344; sc = IW_SCALE; }
        else if (n < 2048) src = -1;
        else src = n - 2048 + 2024;
    } else if (kind == 1) {
        if (n < 512) { const int h = n >> 6, d = n & 63; src = h * 96 + d; }
        else { const int e = n - 512, h = e >> 5, r = e & 31; src = h * 96 + 64 + (r >> 1) + 16 * (r & 1); }
        sc = QB_SCALE;
    } else if (kind == 2) {
        if (n < 512) { const int h = n >> 6, d = n & 63; src = h * 128 + d; }
        else { const int e = n - 512, h = e >> 6, d = e & 63; src = h * 128 + 64 + d; }
    } else src = n;
}
__device__ __forceinline__ void p0_transpose_item(const float* W, int K, int Nsrc, int Ndst, bf16_t* WT, int kind, const float* ks0, const float* ks1, LAS float* scr, int item, int lane) {
    const int nblk = Ndst / 32, kb = item / nblk, nb = item % nblk, k0 = 64 * kb, n0 = 32 * nb;
    int src; float sc; src_map(kind, n0 + (lane & 31), src, sc);
    const int srcc = src >= 0 ? src : 0; const float scm = src >= 0 ? sc : 0.f;
    const float* ksb = ks0 ? ((k0 < 512 || !ks1) ? ks0 + k0 : ks1 + (k0 - 512)) : nullptr;
    float wv_[32], kv_[32];
    const float* wp_ = W + (size_t)(k0 + (lane >> 5)) * Nsrc + srcc;
#pragma unroll
    for (int i = 0; i < 32; ++i) wv_[i] = wp_[(size_t)(2 * i) * Nsrc];
    if (ksb) {
#pragma unroll
        for (int i = 0; i < 32; ++i) kv_[i] = ksb[2 * i + (lane >> 5)];
    } else {
#pragma unroll
        for (int i = 0; i < 32; ++i) kv_[i] = 1.f;
    }
#pragma unroll
    for (int i = 0; i < 32; ++i) scr[(2 * i + (lane >> 5)) * 33 + (lane & 31)] = wv_[i] * (scm * kv_[i]);
    asm volatile("s_waitcnt lgkmcnt(0)" ::: "memory");
    const int c = lane & 7;
#pragma unroll
    for (int jj = 0; jj < 4; ++jj) { const int n = (lane >> 3) + 8 * jj; const LAS float* s = scr + (8 * c) * 33 + n;
        u32x4 o; o.x = cvt_pk_bf16(s[0 * 33], s[1 * 33]); o.y = cvt_pk_bf16(s[2 * 33], s[3 * 33]); o.z = cvt_pk_bf16(s[4 * 33], s[5 * 33]); o.w = cvt_pk_bf16(s[6 * 33], s[7 * 33]);
        *(u32x4*)(WT + (size_t)(n0 + n) * K + k0 + 8 * c) = o; }
    asm volatile("s_waitcnt lgkmcnt(0)" ::: "memory");
}
__device__ __forceinline__ float wave_sum(float v) {
#pragma unroll
    for (int o = 1; o < 64; o <<= 1) v += __shfl_xor(v, o);
    return v;
}

__global__ void __launch_bounds__(512, 2) __attribute__((target("no-packed-fp32-ops"))) hybrid_fwd(Args a) {
    extern __shared__ __attribute__((aligned(16))) unsigned char lds_raw[];
    LAS unsigned char* lds = (LAS unsigned char*)lds_raw;
    const int wave = __builtin_amdgcn_readfirstlane(threadIdx.x >> 6);
#define lane lane_id()
#define tid (wave * 64 + lane_id())
    const int G = gridDim.x, bx = blockIdx.x, vcu = (G % 8 == 0) ? (bx % 8) * (G / 8) + bx / 8 : bx;
    unsigned char* ws = a.ws;
    bf16_t* W1T = (bf16_t*)(ws + WS_W1T); bf16_t* WUQT = (bf16_t*)(ws + WS_WUQT); bf16_t* WUKVT = (bf16_t*)(ws + WS_WUKVT); bf16_t* WOT = (bf16_t*)(ws + WS_WOT);
    float* CS = (float*)(ws + WS_CS); float* SSQ = (float*)(ws + WS_SSQ); float* POSF = (float*)(ws + WS_POSF); float* OSS = (float*)(ws + WS_OSS); float* STATS = (float*)(ws + WS_STATS);
    bf16_t* XB = (bf16_t*)(ws + WS_XB); bf16_t* PROJ = (bf16_t*)(ws + WS_PROJ); bf16_t* QB = (bf16_t*)(ws + WS_QB); bf16_t* KVB = (bf16_t*)(ws + WS_KVB);
    bf16_t* IKC = (bf16_t*)(ws + WS_IKC); bf16_t* KRC = (bf16_t*)(ws + WS_KRC); bf16_t* KAC = (bf16_t*)(ws + WS_KAC); bf16_t* VAC = (bf16_t*)(ws + WS_VAC);
    bf16_t* CQC = (bf16_t*)(ws + WS_CQC); bf16_t* CKVC = (bf16_t*)(ws + WS_CKVC); bf16_t* KNC = (bf16_t*)(ws + WS_KNC); bf16_t* VBC = (bf16_t*)(ws + WS_VBC);
    unsigned long long* MASK = (unsigned long long*)(ws + WS_MASK); bf16_t* OAB = (bf16_t*)(ws + WS_OAB); bf16_t* Y = (bf16_t*)(ws + WS_Y);
    const int lo = a.ph_lo, hi_ph = a.ph_hi;
#define IN(k) (lo <= (k) && (k) < hi_ph)
#define SEAM(k) do { if (IN(k) && IN((k) + 1)) { ++nbar; grid_bar((unsigned*)ws, nbar * (unsigned)G, wave); } } while (0)
    unsigned nbar = 0;
#define NOSEAM(k) do { if (IN(k) && IN((k) + 1)) { __syncthreads(); } } while (0)
    const int gw = vcu * 8 + wave, NGW = G * 8;
#define gt ((size_t)vcu * 512 + tid)
    const size_t NGT = (size_t)G * 512;

    if (IN(0)) {
        LAS float* scr = (LAS float*)(lds + wave * 16384);
        constexpr int I1 = (1024 / 64) * (NPROJ / 32), I2 = (384 / 64) * (NQB / 32), I3 = (256 / 64) * (NKVB / 32), I4 = (1024 / 64) * (1024 / 32);
        for (int it = gw; it < I1 + I2 + I3 + I4; it += NGW) {
            int r = it;
            if (r < I1) { p0_transpose_item(a.w_in, 1024, D_IN, NPROJ, W1T, 0, nullptr, nullptr, scr, r, lane); continue; } r -= I1;
            if (r < I2) { p0_transpose_item(a.w_uq, 384, NQB, NQB, WUQT, 1, a.g_q, nullptr, scr, r, lane); continue; } r -= I2;
            if (r < I3) { p0_transpose_item(a.w_ukv, 256, NKVB, NKVB, WUKVT, 2, a.g_kv, nullptr, scr, r, lane); continue; } r -= I3;
            p0_transpose_item(a.w_out, 1024, 1024, 1024, WOT, 3, a.g_oa, a.g_ob, scr, r, lane);
        }
        for (size_t c = gt; c < (size_t)M * 256; c += 8 * NGT) {
            f32x4 v[8];
#pragma unroll
            for (int k = 0; k < 8; ++k) v[k] = __builtin_nontemporal_load((const f32x4*)(a.x + (c + k * NGT) * 4));
#pragma unroll
            for (int k = 0; k < 8; ++k) *(u32x2*)(XB + (c + k * NGT) * 4) = (u32x2){cvt_pk_bf16(v[k][0], v[k][1]), cvt_pk_bf16(v[k][2], v[k][3])};
        }
        int pq[8];
#pragma unroll
        for (int j = 0; j < 8; ++j) { const size_t i_ = gt + (size_t)j * NGT; pq[j] = (i_ < (size_t)M * 16) ? a.pos[i_ >> 4] : 0; }
#pragma unroll
        for (int j = 0; j < 8; ++j) { const size_t i = gt + (size_t)j * NGT; if (i >= (size_t)M * 16) continue;
            const size_t t = i >> 4; const int k = (int)(i & 15);
            const float p = (float)pq[j];
            const float invf = exp2f(-(float)k * 0.8304820237218406f);
            const float ang = p * invf;
            const double ad = (double)ang;
            const double kk = rint(ad * 0.15915494309189535);
            const double r = fma(-kk, 6.283185307179586, ad) - kk * 2.4492935982947064e-16;
            const double r2 = r * r;
            double sn = -8.2206352466243297e-18; sn = fma(sn, r2, 2.8114572543455206e-15); sn = fma(sn, r2, -7.6471637318198165e-13); sn = fma(sn, r2, 1.6059043836821613e-10);
            sn = fma(sn, r2, -2.5052108385441720e-08); sn = fma(sn, r2, 2.7557319223985893e-06); sn = fma(sn, r2, -1.9841269841269841e-04); sn = fma(sn, r2, 8.3333333333333332e-03);
            sn = fma(sn, r2, -1.6666666666666666e-01); sn = fma(sn * r2, r, r);
            double cn = 4.1103176233121648e-19; cn = fma(cn, r2, -1.5619206968586226e-16); cn = fma(cn, r2, 4.7794773323873853e-14); cn = fma(cn, r2, -1.1470745597729725e-11);
            cn = fma(cn, r2, 2.0876756987868099e-09); cn = fma(cn, r2, -2.7557319223985888e-07); cn = fma(cn, r2, 2.4801587301587302e-05); cn = fma(cn, r2, -1.3888888888888889e-03);
            cn = fma(cn, r2, 4.1666666666666664e-02); cn = fma(cn, r2, -0.5); cn = fma(cn, r2, 1.0);
            CS[t * 32 + k] = (float)cn; CS[t * 32 + 16 + k] = (float)sn;
            if (k == 0) POSF[t] = p;
        }
    }
    SEAM(0);
    if (IN(1)) {
        pg8::Gemm g{XB, W1T, M, NPROJ, 1024, 1024}; pg8::StaticOrder So; So.init(M, NPROJ, G, bx);
        EpiProj E{PROJ, CS, SSQ, IKC, KRC, KAC, VAC, CQC, CKVC};
        pg8::gemm_phase<EpiProj>(lds, g, So, E, wave);
    }
    SEAM(1);
    if (IN(2)) {
        { pg8::Gemm g{CQC, WUQT, M, NQB, 384, 384}; pg8::StaticOrder So; So.init(M, NQB, G, bx);
          EpiUp E{QB, NQB, SSQ, 0, 3, 1.0f / 384.0f, CS, 2, nullptr, nullptr};
          pg8::gemm_phase<EpiUp>(lds, g, So, E, wave); }
        { pg8::Gemm g{CKVC, WUKVT, M, NKVB, 256, 256}; pg8::StaticOrder So; So.init(M, NKVB, G, bx);
          EpiUp E{KVB, NKVB, SSQ, 12, 2, 1.0f / 256.0f, CS, -1, KNC, VBC};
          pg8::gemm_phase<EpiUp>(lds, g, So, E, wave); }
    }
    NOSEAM(2);
    if (IN(3)) {
        idx_phase(vcu >> 4, vcu & 15, PROJ, IKC, MASK, lds, wave);
    }
    SEAM(3);
    if (IN(4)) {
        const int bh = vcu >> 1, s = vcu & 1, b = bh >> 3, h = bh & 7;
        bf16x8 qf[2][6];
        mla_prime(b, h, 7 - s, QB, KNC, VBC, KRC, lds, wave, qf);
#pragma unroll
        for (int j = 0; j < 4; ++j) {
            const int qa = 2 * (j >> 1) + s, qb = (j & 1) ? qa : 7 - qa, jn = j + 1, qan = 2 * (jn >> 1) + s, qbn = (jn & 1) ? qan : 7 - qan;
            mla_unit(b, h, qb, j < 3 ? qbn : -1, qf, QB, PROJ, KNC, VBC, KRC, OAB, OSS, lds, wave);
        }
    }
    NOSEAM(4);
    if (IN(5)) {
        const int bg = vcu >> 3, s = vcu & 7, b = bg >> 1, g = bg & 1;
        bf16x8 qf[2][6]; float pta;
        dsa_prime(b, g, 31 - s, PROJ, KAC, VAC, MASK, POSF, lds, wave, qf, pta);
#pragma unroll
        for (int j = 0; j < 4; ++j) {
            const int qa = 8 * (j >> 1) + s, qb = (j & 1) ? qa : 31 - qa, jn = j + 1, qan = 8 * (jn >> 1) + s, qbn = (jn & 1) ? qan : 31 - qan;
            dsa_unit(b, g, qb, j < 3 ? qbn : -1, qf, pta, PROJ, KAC, VAC, MASK, POSF, OAB, OSS, lds, wave);
        }
    }
    SEAM(5);
    if (IN(7)) {
        pg8::Gemm g{OAB, WOT, M, DM, 1024, 512, 2 * OB_DELTA - 8 * 128}; pg8::StaticOrder So; So.init(M, DM, G, bx);
        EpiOut E{XB, a.out, (unsigned long long*)(ws + WS_STATS), (unsigned*)(ws + WS_PCNT), OSS, a.ln_g, a.ln_b};
        E.fill_rs(So, lds + 131072, tid);
        pg8::gemm_phase<EpiOut>(lds, g, So, E, wave);
    }
#undef IN
#undef lane
#undef tid
#undef gt
#undef SEAM
#undef NOSEAM
}

constexpr int N_PHASES = 9;
#ifndef PROBE_PHASE
#define PROBE_PHASE -1
#endif
extern "C" void kernel_launch(void* const* d_in, const int* in_sizes, int n_in, void* d_out, int out_size, void* d_ws, size_t ws_size, hipStream_t stream) {
    static int grid = 0;
    if (grid == 0) {
        if (n_in != 12 || in_sizes[0] != M * DM || out_size != M * DM || ws_size < WS_END) { fprintf(stderr, "kernel_launch: unexpected shapes (n_in %d, in0 %d, out %d, ws %zu)\n", n_in, n_in > 0 ? in_sizes[0] : -1, out_size, ws_size); grid = -1; return; }
        int dev = 0, cus = 0, per_cu = 0;
        if (hipGetDevice(&dev) != hipSuccess || hipDeviceGetAttribute(&cus, hipDeviceAttributeMultiprocessorCount, dev) != hipSuccess) { grid = -1; return; }
        if (hipFuncSetAttribute((const void*)hybrid_fwd, hipFuncAttributeMaxDynamicSharedMemorySize, LDS_BYTES) != hipSuccess) { fprintf(stderr, "kernel_launch: hipFuncSetAttribute failed\n"); grid = -1; return; }
        if (hipOccupancyMaxActiveBlocksPerMultiprocessor(&per_cu, (const void*)hybrid_fwd, 512, LDS_BYTES) != hipSuccess || per_cu < 1) { fprintf(stderr, "kernel_launch: occupancy query says %d\n", per_cu); per_cu = 1; }
        (void)hipGetLastError();
        grid = cus;
        if (grid != 256) fprintf(stderr, "kernel_launch: %d CUs; this kernel's work deals assume 256\n", grid);
    }
    if (grid < 0) return;
    Args a{};
    a.x = (const float*)d_in[0]; a.pos = (const int*)d_in[1]; a.w_in = (const float*)d_in[2]; a.g_q = (const float*)d_in[3]; a.w_uq = (const float*)d_in[4]; a.g_kv = (const float*)d_in[5];
    a.w_ukv = (const float*)d_in[6]; a.g_oa = (const float*)d_in[7]; a.g_ob = (const float*)d_in[8]; a.w_out = (const float*)d_in[9]; a.ln_g = (const float*)d_in[10]; a.ln_b = (const float*)d_in[11];
    a.out = (float*)d_out; a.ws = (unsigned char*)d_ws;
    (void)hipMemsetAsync(d_ws, 0, 4096 + 256 * 256, stream);
#if MK_N_LAUNCHES == 1
    a.ph_lo = 0; a.ph_hi = N_PHASES;
    void* args[] = {&a};
    hipError_t e = hipLaunchCooperativeKernel((const void*)hybrid_fwd, dim3(grid), dim3(512), args, LDS_BYTES, stream);
    if (e != hipSuccess) fprintf(stderr, "kernel_launch: cooperative launch failed: %s (grid %d)\n", hipGetErrorString(e), grid);
#else
    for (int p = 0; p < N_PHASES; ++p) {
        a.ph_lo = p; a.ph_hi = p + 1;
        for (int rep = 0; rep < ((p == PROBE_PHASE) ? 2 : 1); ++rep) hipLaunchKernelGGL(hybrid_fwd, dim3(grid), dim3(512), LDS_BYTES, stream, a);
    }
#endif
}
```
